# Optimizing an MI355X kernel written in HIP

```python
import math
import jax, jax.numpy as jnp
from jax import lax
import numpy as np

D_MODEL = 1024
BATCH = 8
SEQ = 2048
DEPTH = 1
DEC_BATCH = 128
DEC_SEQ = 4
PAST_LEN = 16384
PAGE_SIZE = 128

D_MIX = D_MODEL
D_SSD = D_MIX // 2
SSD_HEAD_DIM = 64
SSD_HEADS = D_SSD // SSD_HEAD_DIM
SSD_GROUPS = 2
SSD_STATE = 128
SSD_CONV_W = 4
SSD_CHUNK = 128
SSD_CONV_DIM = D_SSD + 2 * SSD_GROUPS * SSD_STATE
D_S5 = D_MIX - D_SSD
S5_CH = 16
S5_GROUPS = D_S5 // S5_CH
S5_STATE = 64
S5_DT_MIN = 0.001
S5_DT_MAX = 0.1
SSD_DT_MIN = 0.001
SSD_DT_MAX = 0.1
D_FF = -(-8 * D_MODEL // (3 * 256)) * 256
IN_PROJ = D_SSD + SSD_CONV_DIM + SSD_HEADS + D_S5
N_ADA = 6
EPS = 1e-6

kernel_name = "hymba_ssd_s5_adaln_decode_step"


def _rmsnorm(x, g):
    xf = x.astype(jnp.float32)
    y = xf * lax.rsqrt(jnp.mean(xf * xf, axis=-1, keepdims=True) + EPS)
    return (y * g.astype(jnp.float32)).astype(x.dtype)


def _segsum(a):
    T = a.shape[-1]
    aa = jnp.broadcast_to(a[..., None], a.shape + (T,))
    aa = jnp.where(jnp.tril(jnp.ones((T, T), bool), -1), aa, 0.0)
    ss = jnp.cumsum(aa, axis=-2)
    return jnp.where(jnp.tril(jnp.ones((T, T), bool)), ss, -jnp.inf)


def _ssd_chunked(X, dA, Bm, Cm, h0):
    b, L, H, P = X.shape
    N = Bm.shape[-1]
    T = min(SSD_CHUNK, L)
    nc = L // T
    X = X.reshape(b, nc, T, H, P)
    Bm = Bm.reshape(b, nc, T, H, N)
    Cm = Cm.reshape(b, nc, T, H, N)
    A = dA.reshape(b, nc, T, H).transpose(0, 3, 1, 2)
    A_cs = jnp.cumsum(A, axis=-1)
    Lmat = jnp.exp(_segsum(A))
    scores = jnp.einsum("bclhn,bcshn->bhcls", Cm, Bm) * Lmat
    y_diag = jnp.einsum("bhcls,bcshp->bclhp", scores, X)
    decay_states = jnp.exp(A_cs[..., -1:] - A_cs).transpose(0, 2, 3, 1)
    states = jnp.einsum("bclhn,bclhp->bchpn", Bm * decay_states[..., None], X)
    states = jnp.concatenate([h0[:, None], states], axis=1)
    chunk_tot = jnp.pad(A_cs[..., -1], ((0, 0), (0, 0), (1, 0)))
    decay_chunk = jnp.exp(_segsum(chunk_tot))
    new_states = jnp.einsum("bhzc,bchpn->bzhpn", decay_chunk, states)
    y_off = jnp.einsum("bclhn,bchpn->bclhp", Cm, new_states[:, :-1]) * \
        jnp.exp(A_cs).transpose(0, 2, 3, 1)[..., None]
    y = (y_diag + y_off).reshape(b, L, H, P)
    return y, new_states[:, -1]


def _ssd_mixer(z, xbc, dt_raw, conv_buf, h0, conv_w, conv_b, dt_bias, A_log, D_skip, norm_g):
    b, L, _ = xbc.shape
    xbc_full = jnp.concatenate([conv_buf.astype(xbc.dtype), xbc], axis=1)
    conv = conv_b + sum(xbc_full[:, k:k + L] * conv_w[k] for k in range(SSD_CONV_W))
    conv_new = xbc_full[:, L:]
    act = jax.nn.silu(conv.astype(jnp.float32))
    xs = act[..., :D_SSD].reshape(b, L, SSD_HEADS, SSD_HEAD_DIM)
    rep = SSD_HEADS // SSD_GROUPS
    Bs = jnp.repeat(act[..., D_SSD:D_SSD + SSD_GROUPS * SSD_STATE].reshape(b, L, SSD_GROUPS, SSD_STATE), rep, axis=2)
    Cs = jnp.repeat(act[..., D_SSD + SSD_GROUPS * SSD_STATE:].reshape(b, L, SSD_GROUPS, SSD_STATE), rep, axis=2)
    dt = jax.nn.softplus(dt_raw.astype(jnp.float32) + dt_bias.astype(jnp.float32))
    A = -jnp.exp(A_log.astype(jnp.float32))
    y, h_new = _ssd_chunked(xs * dt[..., None], dt * A, Bs, Cs, h0.astype(jnp.float32))
    y = y + D_skip.astype(jnp.float32)[:, None] * xs
    y = y.reshape(b, L, D_SSD) * jax.nn.silu(z.astype(jnp.float32))
    yg = y.reshape(b, L, SSD_GROUPS, D_SSD // SSD_GROUPS)
    yg = yg * lax.rsqrt(jnp.mean(yg * yg, axis=-1, keepdims=True) + EPS)
    y = yg.reshape(b, L, D_SSD) * norm_g.astype(jnp.float32)
    return y, h_new, conv_new


def _s5_combine(e1, e2):
    a1r, a1i, b1r, b1i = e1
    a2r, a2i, b2r, b2i = e2
    return (a2r * a1r - a2i * a1i,
            a2r * a1i + a2i * a1r,
            a2r * b1r - a2i * b1i + b2r,
            a2r * b1i + a2i * b1r + b2i)


def _s5_mixer(u5, h0_re, h0_im, A_re, A_im, log_step, B_re, B_im, C_re, C_im, D_skip, w_glu, b_glu):
    b, L, _ = u5.shape
    f32 = jnp.float32
    uc = u5.astype(f32).reshape(b, L, S5_GROUPS, S5_CH)
    lr, li = A_re.astype(f32), A_im.astype(f32)
    step = jnp.exp(log_step.astype(f32))[:, None]
    mag = jnp.exp(lr * step)
    ab_re, ab_im = mag * jnp.cos(li * step), mag * jnp.sin(li * step)
    nr, ni = ab_re - 1.0, ab_im
    den = lr * lr + li * li
    f_re = (nr * lr + ni * li) / den
    f_im = (ni * lr - nr * li) / den
    Br, Bi = B_re.astype(f32), B_im.astype(f32)
    Bb_re = f_re[..., None] * Br - f_im[..., None] * Bi
    Bb_im = f_re[..., None] * Bi + f_im[..., None] * Br
    bu_re = jnp.einsum("gpc,blgc->blgp", Bb_re, uc)
    bu_im = jnp.einsum("gpc,blgc->blgp", Bb_im, uc)
    a_re = jnp.broadcast_to(ab_re, bu_re.shape)
    a_im = jnp.broadcast_to(ab_im, bu_im.shape)
    Ar, Ai, Hr, Hi = lax.associative_scan(_s5_combine, (a_re, a_im, bu_re, bu_im), axis=1)
    r0, i0 = h0_re.astype(f32)[:, None], h0_im.astype(f32)[:, None]
    h_re = Hr + Ar * r0 - Ai * i0
    h_im = Hi + Ar * i0 + Ai * r0
    y = jnp.einsum("gcp,blgp->blgc", C_re.astype(f32), h_re) - \
        jnp.einsum("gcp,blgp->blgc", C_im.astype(f32), h_im)
    y = y.reshape(b, L, D_S5) + D_skip.astype(f32) * uc.reshape(b, L, D_S5)
    g = jax.nn.gelu(y, approximate=False)
    out = g * jax.nn.sigmoid(g @ w_glu.astype(f32) + b_glu.astype(f32))
    return out, h_re[:, -1], h_im[:, -1]


def _layer(x, c, conv_buf, h_ssd0, s5_re0, s5_im0,
           w_ada, b_ada, norm1_g, w_in, conv_w, conv_b, ssd_dt_bias, ssd_A_log, ssd_D, ssd_norm_g,
           s5_A_re, s5_A_im, s5_log_step, s5_B_re, s5_B_im, s5_C_re, s5_C_im, s5_D, w_glu, b_glu,
           w_out, norm2_g, w_ffn_gate, w_ffn_up, w_ffn_down):
    mod = (jax.nn.silu(c) @ w_ada + b_ada)[:, None, :]
    sh1, sc1, g1, sh2, sc2, g2 = jnp.split(mod, N_ADA, axis=-1)
    u = _rmsnorm(x, norm1_g) * (1 + sc1) + sh1
    proj = u @ w_in
    o1 = D_SSD
    o2 = o1 + SSD_CONV_DIM
    o3 = o2 + SSD_HEADS
    y_ssd, h_ssd, conv_new = _ssd_mixer(proj[..., :o1], proj[..., o1:o2], proj[..., o2:o3], conv_buf, h_ssd0,
                                        conv_w, conv_b, ssd_dt_bias, ssd_A_log, ssd_D, ssd_norm_g)
    y_s5, re_new, im_new = _s5_mixer(proj[..., o3:], s5_re0, s5_im0, s5_A_re, s5_A_im, s5_log_step,
                                     s5_B_re, s5_B_im, s5_C_re, s5_C_im, s5_D, w_glu, b_glu)
    mix = jnp.concatenate([y_ssd, y_s5], axis=-1).astype(x.dtype)
    x = x + g1 * (mix @ w_out)
    v = _rmsnorm(x, norm2_g) * (1 + sc2) + sh2
    ff = (jax.nn.silu(v @ w_ffn_gate) * (v @ w_ffn_up)) @ w_ffn_down
    x = x + g2 * ff
    return x, h_ssd, conv_new, re_new, im_new


def setup_inputs(seed: int = 0) -> dict:
    key = jax.random.key(seed)
    ks = iter(jax.random.split(key, 48))

    def nrm(shape, scale):
        return jax.random.normal(next(ks), shape, jnp.float32) * scale

    def unif(shape, lo, hi):
        return jax.random.uniform(next(ks), shape, jnp.float32, lo, hi)

    Dp = DEPTH
    d = {}
    d["x_prompt"] = nrm((BATCH, SEQ, D_MODEL), 1.0)
    d["x_sample"] = nrm((DEC_BATCH, DEC_SEQ, D_MODEL), 1.0)
    d["c_prompt"] = nrm((BATCH, D_MODEL), 1.0)
    d["c_sample"] = nrm((DEC_BATCH, D_MODEL), 1.0)
    d["state_ssd"] = nrm((Dp, DEC_BATCH, SSD_HEADS, SSD_HEAD_DIM, SSD_STATE), 0.1)
    d["state_conv"] = nrm((Dp, DEC_BATCH, SSD_CONV_W - 1, SSD_CONV_DIM), 1.0)
    d["state_s5_re"] = nrm((Dp, DEC_BATCH, S5_GROUPS, S5_STATE), 0.1)
    d["state_s5_im"] = nrm((Dp, DEC_BATCH, S5_GROUPS, S5_STATE), 0.1)
    d["w_ada"] = nrm((Dp, D_MODEL, N_ADA * D_MODEL), 0.5 * D_MODEL ** -0.5)
    d["b_ada"] = nrm((Dp, N_ADA * D_MODEL), 0.02)
    d["norm1_g"] = 1.0 + nrm((Dp, D_MODEL), 0.02)
    d["w_in"] = nrm((Dp, D_MODEL, IN_PROJ), D_MODEL ** -0.5)
    d["conv_w"] = nrm((Dp, SSD_CONV_W, SSD_CONV_DIM), SSD_CONV_W ** -0.5)
    d["conv_b"] = nrm((Dp, SSD_CONV_DIM), 0.02)
    dt0 = jnp.exp(unif((Dp, SSD_HEADS), math.log(SSD_DT_MIN), math.log(SSD_DT_MAX)))
    d["ssd_dt_bias"] = dt0 + jnp.log(-jnp.expm1(-dt0))
    d["ssd_A_log"] = jnp.log(unif((Dp, SSD_HEADS), 1.0, 16.0))
    d["ssd_D"] = 1.0 + nrm((Dp, SSD_HEADS), 0.02)
    d["ssd_norm_g"] = 1.0 + nrm((Dp, D_SSD), 0.02)
    n_idx = jnp.arange(S5_STATE, dtype=jnp.float32)
    d["s5_A_re"] = -0.5 + nrm((Dp, S5_GROUPS, S5_STATE), 0.01)
    d["s5_A_im"] = jnp.broadcast_to(math.pi * n_idx, (Dp, S5_GROUPS, S5_STATE)) + nrm((Dp, S5_GROUPS, S5_STATE), 0.01)
    d["s5_log_step"] = unif((Dp, S5_GROUPS), math.log(S5_DT_MIN), math.log(S5_DT_MAX))
    d["s5_B_re"] = nrm((Dp, S5_GROUPS, S5_STATE, S5_CH), (2.0 * S5_CH) ** -0.5)
    d["s5_B_im"] = nrm((Dp, S5_GROUPS, S5_STATE, S5_CH), (2.0 * S5_CH) ** -0.5)
    d["s5_C_re"] = nrm((Dp, S5_GROUPS, S5_CH, S5_STATE), (2.0 * S5_STATE) ** -0.5)
    d["s5_C_im"] = nrm((Dp, S5_GROUPS, S5_CH, S5_STATE), (2.0 * S5_STATE) ** -0.5)
    d["s5_D"] = nrm((Dp, D_S5), 1.0)
    d["w_glu"] = nrm((Dp, D_S5, D_S5), D_S5 ** -0.5)
    d["b_glu"] = nrm((Dp, D_S5), 0.02)
    d["w_out"] = nrm((Dp, D_MIX, D_MODEL), D_MIX ** -0.5)
    d["norm2_g"] = 1.0 + nrm((Dp, D_MODEL), 0.02)
    d["w_ffn_gate"] = nrm((Dp, D_MODEL, D_FF), D_MODEL ** -0.5)
    d["w_ffn_up"] = nrm((Dp, D_MODEL, D_FF), D_MODEL ** -0.5)
    d["w_ffn_down"] = nrm((Dp, D_FF, D_MODEL), D_FF ** -0.5)
    d["w_ada_f"] = nrm((D_MODEL, 2 * D_MODEL), 0.5 * D_MODEL ** -0.5)
    d["b_ada_f"] = nrm((2 * D_MODEL,), 0.02)
    d["normf_g"] = 1.0 + nrm((D_MODEL,), 0.02)
    return d


def reference(x_prompt, x_sample, c_prompt, c_sample, state_ssd, state_conv, state_s5_re, state_s5_im,
              w_ada, b_ada, norm1_g, w_in, conv_w, conv_b, ssd_dt_bias, ssd_A_log, ssd_D, ssd_norm_g,
              s5_A_re, s5_A_im, s5_log_step, s5_B_re, s5_B_im, s5_C_re, s5_C_im, s5_D, w_glu, b_glu,
              w_out, norm2_g, w_ffn_gate, w_ffn_up, w_ffn_down, w_ada_f, b_ada_f, normf_g):
    layer_w = (w_ada, b_ada, norm1_g, w_in, conv_w, conv_b, ssd_dt_bias, ssd_A_log, ssd_D, ssd_norm_g,
               s5_A_re, s5_A_im, s5_log_step, s5_B_re, s5_B_im, s5_C_re, s5_C_im, s5_D, w_glu, b_glu,
               w_out, norm2_g, w_ffn_gate, w_ffn_up, w_ffn_down)

    def run(x, c, ssd0, conv0, re0, im0):
        ssd_n, conv_n, re_n, im_n = [], [], [], []
        for l in range(DEPTH):
            x, h, cb, r, i = _layer(x, c, conv0[l], ssd0[l], re0[l], im0[l], *[w[l] for w in layer_w])
            ssd_n.append(h)
            conv_n.append(cb)
            re_n.append(r)
            im_n.append(i)
        mod = (jax.nn.silu(c) @ w_ada_f + b_ada_f)[:, None, :]
        shf, scf = jnp.split(mod, 2, axis=-1)
        y = _rmsnorm(x, normf_g) * (1 + scf) + shf
        return y, jnp.stack(ssd_n), jnp.stack(conv_n), jnp.stack(re_n), jnp.stack(im_n)

    bp = x_prompt.shape[0]
    f32 = jnp.float32
    y_prompt, ssd_p, conv_p, re_p, im_p = run(
        x_prompt, c_prompt,
        jnp.zeros((DEPTH, bp, SSD_HEADS, SSD_HEAD_DIM, SSD_STATE), f32),
        jnp.zeros((DEPTH, bp, SSD_CONV_W - 1, SSD_CONV_DIM), x_prompt.dtype),
        jnp.zeros((DEPTH, bp, S5_GROUPS, S5_STATE), f32),
        jnp.zeros((DEPTH, bp, S5_GROUPS, S5_STATE), f32))
    y_sample, ssd_s, conv_s, re_s, im_s = run(
        x_sample, c_sample, state_ssd, state_conv, state_s5_re, state_s5_im)
    return (y_prompt, y_sample, ssd_p, ssd_s, conv_p, conv_s, re_p, re_s, im_p, im_s)
```

```cpp
#include <hip/hip_runtime.h>
#include <cstdio>
#include <cstdint>

constexpr int D = 1024, NP = 8, LP = 2048, NS = 128, LS = 4, NSEQ = NP + NS;
constexpr int MP = NP * LP, MS = NS * LS, M = MP + MS;
constexpr int H = 8, PD = 64, NST = 128, NG = 2, DSSD = 512, CONVD = 1024;
constexpr int G5 = 32, CH5 = 16, P5 = 64, DS5 = 512;
constexpr int DFF = 2816, INP = 2056, O1 = 512, O2 = 1536, O3 = 1544;
constexpr int NMOD = 8192;
constexpr float EPS = 1e-6f;
constexpr size_t OUT_Y = 0, OUT_SSDP = (size_t)M * D, OUT_SSDS = OUT_SSDP + (size_t)NP * H * PD * NST, OUT_CONVP = OUT_SSDS + (size_t)NS * H * PD * NST,
                 OUT_CONVS = OUT_CONVP + (size_t)NP * 3 * CONVD, OUT_REP = OUT_CONVS + (size_t)NS * 3 * CONVD, OUT_RES = OUT_REP + (size_t)NP * G5 * P5,
                 OUT_IMP = OUT_RES + (size_t)NS * G5 * P5, OUT_IMS = OUT_IMP + (size_t)NP * G5 * P5, OUT_END = OUT_IMS + (size_t)NS * G5 * P5;

__device__ __forceinline__ int seq_of_row(int r) { return r < MP ? r / LP : NP + (r - MP) / LS; }
__device__ __forceinline__ float siluf(float v) { return v / (1.f + expf(-v)); }
__device__ __forceinline__ float softplusf(float v) { return v > 20.f ? v : log1pf(expf(v)); }

__global__ void nv_ada(const float* cp, const float* cs, const float* w, const float* b, float* mod, int N, int off) {
    const int j = blockIdx.x * 256 + threadIdx.x, s = blockIdx.y;
    const float* c = s < NP ? cp + (size_t)s * D : cs + (size_t)(s - NP) * D;
    float acc = 0.f;
    for (int k = 0; k < D; ++k) acc += siluf(c[k]) * w[(size_t)k * N + j];
    mod[(size_t)s * NMOD + off + j] = acc + b[j];
}
__global__ void nv_modnorm(const float* xa, const float* xb, const float* g, const float* mod, int sh_off, int sc_off, float* out) {
    const int row = blockIdx.x, t = threadIdx.x, s = seq_of_row(row);
    const float* x = row < MP ? xa + (size_t)row * D : xb + (size_t)(row - MP) * D;
    __shared__ float red[256];
    float v[4], ss = 0.f;
    for (int i = 0; i < 4; ++i) { v[i] = x[t + 256 * i]; ss += v[i] * v[i]; }
    red[t] = ss; __syncthreads();
    for (int o = 128; o > 0; o >>= 1) { if (t < o) red[t] += red[t + o]; __syncthreads(); }
    const float inv = rsqrtf(red[0] / D + EPS);
    for (int i = 0; i < 4; ++i) { const int c = t + 256 * i; out[(size_t)row * D + c] = v[i] * inv * g[c] * (1.f + mod[(size_t)s * NMOD + sc_off + c]) + mod[(size_t)s * NMOD + sh_off + c]; }
}
struct GemmP { const float* A; int lda; const float* B; const float* B2; int ldb; int Mr, N, K;
               float* C; int ldc; const float* aux; const float* aux2; const float* mod; int mod_off; const float* bias; };
template <int MODE> __global__ void __launch_bounds__(256) nv_gemm(GemmP p) {
    __shared__ float As[16][65], Bs[16][65], Bs2[MODE == 3 ? 16 : 1][65];
    const int tx = threadIdx.x % 16, ty = threadIdx.x / 16, m0 = blockIdx.y * 64, n0 = blockIdx.x * 64;
    float acc[4][4] = {}, acc2[4][4] = {};
    for (int k0 = 0; k0 < p.K; k0 += 16) {
        for (int e = threadIdx.x; e < 64 * 16; e += 256) { const int mm = e / 16, kk = e % 16; As[kk][mm] = p.A[(size_t)(m0 + mm) * p.lda + k0 + kk]; }
        for (int e = threadIdx.x; e < 16 * 64; e += 256) { const int kk = e / 64, nn = e % 64; const int n = n0 + nn;
            Bs[kk][nn] = n < p.N ? p.B[(size_t)(k0 + kk) * p.ldb + n] : 0.f; if (MODE == 3) Bs2[kk][nn] = n < p.N ? p.B2[(size_t)(k0 + kk) * p.ldb + n] : 0.f; }
        __syncthreads();
        for (int kk = 0; kk < 16; ++kk) {
            float a[4], b[4], b2[4];
            for (int i = 0; i < 4; ++i) { a[i] = As[kk][ty * 4 + i]; b[i] = Bs[kk][tx * 4 + i]; if (MODE == 3) b2[i] = Bs2[kk][tx * 4 + i]; }
            for (int i = 0; i < 4; ++i) for (int j = 0; j < 4; ++j) { acc[i][j] += a[i] * b[j]; if (MODE == 3) acc2[i][j] += a[i] * b2[j]; }
        }
        __syncthreads();
    }
    for (int i = 0; i < 4; ++i) for (int j = 0; j < 4; ++j) {
        const int m = m0 + ty * 4 + i, n = n0 + tx * 4 + j; if (n >= p.N) continue;
        const float v = acc[i][j];
        if (MODE == 0) p.C[(size_t)m * p.ldc + n] = v;
        if (MODE == 1) { const float gy = p.aux[(size_t)m * DS5 + n]; p.C[(size_t)m * p.ldc + n] = gy / (1.f + expf(-(v + p.bias[n]))); }
        if (MODE == 2) { const float* res = m < MP ? p.aux + (size_t)m * D : p.aux2 + (size_t)(m - MP) * D;
                         p.C[(size_t)m * p.ldc + n] = res[n] + p.mod[(size_t)seq_of_row(m) * NMOD + p.mod_off + n] * v; }
        if (MODE == 3) p.C[(size_t)m * p.ldc + n] = siluf(v) * acc2[i][j];
    }
}
__device__ __forceinline__ float xbcf(const float* proj, const float* sconv, int s, int i, int ch) {
    if (i < 3) return s < NP ? 0.f : sconv[((size_t)(s - NP) * 3 + i) * CONVD + ch];
    const int row = s < NP ? s * LP + (i - 3) : MP + (s - NP) * LS + (i - 3);
    return proj[(size_t)row * INP + O1 + ch];
}
__global__ void nv_convnew(const float* proj, const float* sconv, float* out) {
    const int s = blockIdx.x, L = s < NP ? LP : LS;
    float* o = s < NP ? out + OUT_CONVP + (size_t)s * 3 * CONVD : out + OUT_CONVS + (size_t)(s - NP) * 3 * CONVD;
    for (int e = threadIdx.x; e < 3 * CONVD; e += blockDim.x) o[e] = xbcf(proj, sconv, s, L + e / CONVD, e % CONVD);
}
__global__ void nv_ssd(const float* proj, const float* sconv, const float* sssd, const float* convw, const float* convb, const float* dtb, const float* Alog, const float* Dsk,
                       float* yssd, float* out) {
    const int s = blockIdx.x / H, h = blockIdx.x % H, g = h / (H / NG), tid = threadIdx.x, p = tid / 8, nq = tid % 8;
    const int L = s < NP ? LP : LS, row0 = s < NP ? s * LP : MP + (s - NP) * LS;
    __shared__ float sx[PD], sB[NST], sC[NST];
    float st[16];
    for (int j = 0; j < 16; ++j) st[j] = s < NP ? 0.f : sssd[(((size_t)(s - NP) * H + h) * PD + p) * NST + nq * 16 + j];
    const float A = -expf(Alog[h]), Dh = Dsk[h], bias = dtb[h];
    for (int t = 0; t < L; ++t) {
        if (tid < PD + 2 * NST) {
            const int ch = tid < PD ? h * PD + tid : (tid < PD + NST ? DSSD + g * NST + (tid - PD) : DSSD + NG * NST + g * NST + (tid - PD - NST));
            float c = convb[ch];
            for (int k = 0; k < 4; ++k) c += xbcf(proj, sconv, s, t + k, ch) * convw[k * CONVD + ch];
            c = siluf(c);
            if (tid < PD) sx[tid] = c; else if (tid < PD + NST) sB[tid - PD] = c; else sC[tid - PD - NST] = c;
        }
        __syncthreads();
        const float dt = softplusf(proj[(size_t)(row0 + t) * INP + O2 + h] + bias), dA = expf(dt * A), xv = sx[p], dx = dt * xv;
        float y = 0.f;
        for (int j = 0; j < 16; ++j) { st[j] = st[j] * dA + dx * sB[nq * 16 + j]; y += sC[nq * 16 + j] * st[j]; }
        y += __shfl_xor(y, 1); y += __shfl_xor(y, 2); y += __shfl_xor(y, 4);
        if (nq == 0) yssd[(size_t)(row0 + t) * DSSD + h * PD + p] = y + Dh * xv;
        __syncthreads();
    }
    float* o = s < NP ? out + OUT_SSDP + (((size_t)s * H + h) * PD + p) * NST : out + OUT_SSDS + (((size_t)(s - NP) * H + h) * PD + p) * NST;
    for (int j = 0; j < 16; ++j) o[nq * 16 + j] = st[j];
}
__global__ void nv_ssdnorm(const float* yssd, const float* proj, const float* ng, float* mix) {
    const int row = blockIdx.x, t = threadIdx.x;
    __shared__ float red[2][256];
    float v[2];
    for (int gi = 0; gi < 2; ++gi) { const int c = gi * 256 + t; v[gi] = yssd[(size_t)row * DSSD + c] * siluf(proj[(size_t)row * INP + c]); red[gi][t] = v[gi] * v[gi]; }
    __syncthreads();
    for (int o = 128; o > 0; o >>= 1) { if (t < o) { red[0][t] += red[0][t + o]; red[1][t] += red[1][t + o]; } __syncthreads(); }
    for (int gi = 0; gi < 2; ++gi) { const int c = gi * 256 + t; mix[(size_t)row * D + c] = v[gi] * rsqrtf(red[gi][0] / 256.f + EPS) * ng[c]; }
}
__global__ void nv_s5(const float* proj, const float* s0re, const float* s0im, const float* Are, const float* Aim, const float* lstep, const float* Bre, const float* Bim,
                      const float* Cre, const float* Cim, const float* Dsk, float* y5, float* out) {
    const int s = blockIdx.x / G5, g = blockIdx.x % G5, p = threadIdx.x;
    const int L = s < NP ? LP : LS, row0 = s < NP ? s * LP : MP + (s - NP) * LS;
    const float lr = Are[g * P5 + p], li = Aim[g * P5 + p], step = expf(lstep[g]);
    const float mag = expf(lr * step), abr = mag * cosf(li * step), abi = mag * sinf(li * step);
    const float nr = abr - 1.f, ni = abi, den = lr * lr + li * li, fr = (nr * lr + ni * li) / den, fi = (ni * lr - nr * li) / den;
    float bbr[CH5], bbi[CH5], cr[CH5], ci[CH5];
    for (int c = 0; c < CH5; ++c) { const float br = Bre[((size_t)g * P5 + p) * CH5 + c], bi = Bim[((size_t)g * P5 + p) * CH5 + c];
        bbr[c] = fr * br - fi * bi; bbi[c] = fr * bi + fi * br; cr[c] = Cre[((size_t)g * CH5 + c) * P5 + p]; ci[c] = Cim[((size_t)g * CH5 + c) * P5 + p]; }
    float hr = s < NP ? 0.f : s0re[((size_t)(s - NP) * G5 + g) * P5 + p], hi = s < NP ? 0.f : s0im[((size_t)(s - NP) * G5 + g) * P5 + p];
    for (int t = 0; t < L; ++t) {
        const float* u = proj + (size_t)(row0 + t) * INP + O3 + g * CH5;
        float br = 0.f, bi = 0.f, uv[CH5];
        for (int c = 0; c < CH5; ++c) { uv[c] = u[c]; br += bbr[c] * uv[c]; bi += bbi[c] * uv[c]; }
        const float nhr = abr * hr - abi * hi + br, nhi = abr * hi + abi * hr + bi; hr = nhr; hi = nhi;
        float mine = 0.f;
        for (int c = 0; c < CH5; ++c) { float v = cr[c] * hr - ci[c] * hi;
            for (int o = 1; o < 64; o <<= 1) v += __shfl_xor(v, o);
            if (p == c) mine = v + Dsk[g * CH5 + c] * uv[c]; }
        if (p < CH5) y5[(size_t)(row0 + t) * DS5 + g * CH5 + p] = 0.5f * mine * (1.f + erff(mine * 0.70710678118654752f));
    }
    float* ore = s < NP ? out + OUT_REP + ((size_t)s * G5 + g) * P5 : out + OUT_RES + ((size_t)(s - NP) * G5 + g) * P5;
    float* oim = s < NP ? out + OUT_IMP + ((size_t)s * G5 + g) * P5 : out + OUT_IMS + ((size_t)(s - NP) * G5 + g) * P5;
    ore[p] = hr; oim[p] = hi;
}

extern "C" void kernel_launch(void* const* d_in, const int* in_sizes, int n_in, void* d_out, int out_size, void* d_ws, size_t ws_size, hipStream_t stream) {
    const float* const* in = (const float* const*)d_in;
    const float *x_p = in[0], *x_s = in[1], *c_p = in[2], *c_s = in[3], *s_ssd = in[4], *s_conv = in[5], *s_re = in[6], *s_im = in[7], *w_ada = in[8], *b_ada = in[9], *n1g = in[10], *w_in = in[11],
                *conv_w = in[12], *conv_b = in[13], *dt_bias = in[14], *A_log = in[15], *ssd_D = in[16], *ssd_ng = in[17], *A_re = in[18], *A_im = in[19], *lstep = in[20], *B_re = in[21], *B_im = in[22],
                *C_re = in[23], *C_im = in[24], *s5_D = in[25], *w_glu = in[26], *b_glu = in[27], *w_out = in[28], *n2g = in[29], *w_gate = in[30], *w_up = in[31], *w_down = in[32], *w_ada_f = in[33],
                *b_ada_f = in[34], *nfg = in[35];
    float* out = (float*)d_out; char* ws = (char*)d_ws;
    constexpr size_t MiB = 1u << 20;
    float* mod = (float*)(ws + 0);
    float* proj = (float*)(ws + 8 * MiB);
    float* mix = (float*)(ws + 141 * MiB);
    float* yssd = (float*)(ws + 207 * MiB);
    float* x1 = proj;
    float* hff = (float*)(ws + 74 * MiB);
    float* uv = out + OUT_Y;
    float* y5 = out + OUT_Y;

    nv_ada<<<dim3(6144 / 256, NSEQ), 256, 0, stream>>>(c_p, c_s, w_ada, b_ada, mod, 6144, 0);
    nv_ada<<<dim3(2048 / 256, NSEQ), 256, 0, stream>>>(c_p, c_s, w_ada_f, b_ada_f, mod, 2048, 6144);
    nv_modnorm<<<M, 256, 0, stream>>>(x_p, x_s, n1g, mod, 3 * 0 + 0, 1024, uv);
    { GemmP p{}; p.A = uv; p.lda = D; p.B = w_in; p.ldb = INP; p.Mr = M; p.N = INP; p.K = D; p.C = proj; p.ldc = INP;
      nv_gemm<0><<<dim3((INP + 63) / 64, M / 64), 256, 0, stream>>>(p); }
    nv_convnew<<<NSEQ, 256, 0, stream>>>(proj, s_conv, out);
    nv_ssd<<<NSEQ * H, 512, 0, stream>>>(proj, s_conv, s_ssd, conv_w, conv_b, dt_bias, A_log, ssd_D, yssd, out);
    nv_ssdnorm<<<M, 256, 0, stream>>>(yssd, proj, ssd_ng, mix);
    nv_s5<<<NSEQ * G5, 64, 0, stream>>>(proj, s_re, s_im, A_re, A_im, lstep, B_re, B_im, C_re, C_im, s5_D, y5, out);
    { GemmP p{}; p.A = y5; p.lda = DS5; p.B = w_glu; p.ldb = DS5; p.Mr = M; p.N = DS5; p.K = DS5; p.C = mix + DSSD; p.ldc = D; p.aux = y5; p.bias = b_glu;
      nv_gemm<1><<<dim3(DS5 / 64, M / 64), 256, 0, stream>>>(p); }
    { GemmP p{}; p.A = mix; p.lda = D; p.B = w_out; p.ldb = D; p.Mr = M; p.N = D; p.K = D; p.C = x1; p.ldc = D; p.aux = x_p; p.aux2 = x_s; p.mod = mod; p.mod_off = 2048;
      nv_gemm<2><<<dim3(D / 64, M / 64), 256, 0, stream>>>(p); }
    nv_modnorm<<<M, 256, 0, stream>>>(x1, x1 + (size_t)MP * D, n2g, mod, 3072, 4096, uv);
    { GemmP p{}; p.A = uv; p.lda = D; p.B = w_gate; p.B2 = w_up; p.ldb = DFF; p.Mr = M; p.N = DFF; p.K = D; p.C = hff; p.ldc = DFF;
      nv_gemm<3><<<dim3(DFF / 64, M / 64), 256, 0, stream>>>(p); }
    { GemmP p{}; p.A = hff; p.lda = DFF; p.B = w_down; p.ldb = D; p.Mr = M; p.N = D; p.K = DFF; p.C = x1; p.ldc = D; p.aux = x1; p.aux2 = x1 + (size_t)MP * D; p.mod = mod; p.mod_off = 5120;
      nv_gemm<2><<<dim3(D / 64, M / 64), 256, 0, stream>>>(p); }
    nv_modnorm<<<M, 256, 0, stream>>>(x1, x1 + (size_t)MP * D, nfg, mod, 6144, 6144 + 1024, out + OUT_Y);
}
```

```cpp
#include <hip/hip_runtime.h>
#include <hip/hip_cooperative_groups.h>
#include <cstdio>
#include <cstdint>
namespace cg = cooperative_groups;

constexpr int D = 1024, NP = 8, LP = 2048, NS = 128, LS = 4, NSEQ = NP + NS;
constexpr int MP = NP * LP, MS = NS * LS, M = MP + MS;
constexpr int H = 8, PD = 64, NST = 128, NG = 2, DSSD = 512, CONVD = 1024;
constexpr int G5 = 32, CH5 = 16, P5 = 64, DS5 = 512;
constexpr int DFF = 2816, INP = 2056, O1 = 512, O2 = 1536, O3 = 1544;
constexpr int NPROJ = 2048;
constexpr int NMOD = 8192;
constexpr float EPS = 1e-6f;
constexpr size_t OUT_Y = 0, OUT_SSDP = (size_t)M * D, OUT_SSDS = OUT_SSDP + (size_t)NP * H * PD * NST, OUT_CONVP = OUT_SSDS + (size_t)NS * H * PD * NST,
                 OUT_CONVS = OUT_CONVP + (size_t)NP * 3 * CONVD, OUT_REP = OUT_CONVS + (size_t)NS * 3 * CONVD, OUT_RES = OUT_REP + (size_t)NP * G5 * P5,
                 OUT_IMP = OUT_RES + (size_t)NS * G5 * P5, OUT_IMS = OUT_IMP + (size_t)NP * G5 * P5, OUT_END = OUT_IMS + (size_t)NS * G5 * P5;
constexpr size_t MiB = 1u << 20;
constexpr size_t WS_CTL = 0, WS_MOD = 1 * MiB, WS_DT = 6 * MiB, WS_BB = 7 * MiB, WS_CC = WS_BB + 256 * 1024, WS_AB = WS_CC + 256 * 1024, WS_ACS = 8 * MiB, WS_S5E = 9 * MiB,
                 WS_WIN = 12 * MiB, WS_WGLU = 16 * MiB, WS_WOUT = 17 * MiB, WS_WUP = 19 * MiB, WS_WDOWN = 30 * MiB,
                 WS_U = 36 * MiB, WS_CS = 36 * MiB, WS_PROJ = 69 * MiB, WS_XC = 135 * MiB, WS_HFF = 69 * MiB, WS_MIX = 168 * MiB, WS_GY = 201 * MiB, WS_G = 218 * MiB, WS_END = 256 * MiB;
static_assert(WS_MOD + (size_t)NSEQ * NMOD * 4 <= WS_DT && WS_DT + (size_t)M * 8 * 4 <= WS_BB && WS_WDOWN + (size_t)D * DFF * 2 <= WS_U && WS_U + (size_t)M * D * 2 <= WS_PROJ, "ws map 1");
static_assert(WS_PROJ + (size_t)M * NPROJ * 2 <= WS_XC && WS_XC + (size_t)M * CONVD * 2 <= WS_MIX && WS_HFF + (size_t)M * DFF * 2 <= WS_MIX && WS_MIX + (size_t)M * D * 2 <= WS_GY && WS_GY + (size_t)M * DS5 * 2 <= WS_G, "ws map 2");

typedef unsigned short bf16;
__device__ __host__ __forceinline__ int seq_of_row(int r) { return r < MP ? r / LP : NP + (r - MP) / LS; }
__device__ __forceinline__ float siluf(float v) { return v / (1.f + expf(-v)); }
__device__ __forceinline__ float softplusf(float v) { return v > 20.f ? v : log1pf(expf(v)); }
__device__ __forceinline__ float bf2f(bf16 b) { return __uint_as_float(((unsigned)b) << 16); }
__device__ __forceinline__ unsigned f2bf(float f) { unsigned u = __float_as_uint(f); return (u + 0x7fffu + ((u >> 16) & 1u)) >> 16; }
__device__ __forceinline__ unsigned pk2(float lo, float hi) { return f2bf(lo) | (f2bf(hi) << 16); }
__device__ __forceinline__ float fast_sigmoid(float v) { return __builtin_amdgcn_rcpf(1.f + __expf(-v)); }

namespace pg8 {
#define PG8_LAS __attribute__((address_space(3)))
typedef unsigned short bf16_t;
typedef short bf16x8 __attribute__((ext_vector_type(8)));
typedef float f32x4 __attribute__((ext_vector_type(4)));
typedef unsigned u32x4 __attribute__((ext_vector_type(4)));
constexpr int BM = 256, BK = 64, HALF = 128, HTB = HALF * BK * 2  , STAGE_BYTES = 8 * HTB, NXCD = 8, WGM = 8;

__host__ __device__ __forceinline__ int lds_byte(int r, int c) { const int st = (r >> 4) * 2 + (c >> 5), rr = r & 15, cc = c & 31, ob = rr * 64 + cc * 2; return st * 1024 + (ob ^ (((ob >> 9) & 1) << 5)); }
__host__ __device__ __forceinline__ void stage_rc(int b, int& R, int& C) { const int st = b / 1024, sb = b % 1024, swz = sb ^ (((sb >> 9) & 1) << 5); R = (st >> 1) * 16 + swz / 64; C = (st & 1) * 32 + (swz % 64) / 2; }
__host__ __device__ __forceinline__ int perm32(int rho) { const int n = rho >> 4, i = rho & 15; return 8 * (i >> 2) + 4 * n + (i & 3); }

struct Unit { int pm, pn; };
struct Gemm { const bf16_t* A; const bf16_t* Bt; int M, N, K; };

struct StaticOrder {
    int nM, nN, nwg, G, c;
    __host__ __device__ void init(int M, int N, int G_, int c_) { nM = M / BM; nN = N / BM; nwg = nM * nN; G = G_; c = c_; }
    __host__ __device__ bool next(int i, Unit& u) const {
        const long L = (long)i * G + c; if (L >= nwg) return false;
        int wgid = (int)L; { const int q = nwg / NXCD, r = nwg % NXCD, xcd = wgid % NXCD, off = wgid / NXCD; wgid = (xcd < r ? xcd * (q + 1) : r * (q + 1) + (xcd - r) * q) + off; }
        const int nig = WGM * nN, gid = wgid / nig, fm = gid * WGM, gsz = (nM - fm) < WGM ? (nM - fm) : WGM;
        u.pm = fm + ((wgid % nig) % gsz); u.pn = (wgid % nig) / gsz; return true;
    }
    __device__ __forceinline__ void a_ready(const Unit&) const {}
    __device__ __forceinline__ void done(const Unit&) const {}
};
__device__ __forceinline__ unsigned cvt_pk_bf16(float lo, float hi) { unsigned r; asm volatile("v_cvt_pk_bf16_f32 %0, %1, %2" : "=v"(r) : "v"(lo), "v"(hi)); return r; }
struct EpiBf16 {
    static constexpr bool PERM = true, AFTER_DRAIN = false;
    bf16_t* O; int ldc;
    __device__ __forceinline__ void operator()(const f32x4 (&acc)[2][2][4][2], const Unit& u, int wr, int wc, int fr, int fq) const {
        const int row0 = u.pm * BM + wr * 64 + fr, col0 = u.pn * BM + wc * 32 + 8 * fq;
#pragma unroll
        for (int ai = 0; ai < 2; ++ai)
#pragma unroll
            for (int m = 0; m < 4; ++m) { bf16_t* rowp = O + (size_t)(row0 + ai * HALF + m * 16) * ldc + col0;
#pragma unroll
                for (int bj = 0; bj < 2; ++bj) { const f32x4 v0 = acc[ai][bj][m][0], v1 = acc[ai][bj][m][1];
                    u32x4 w; w.x = cvt_pk_bf16(v0[0], v0[1]); w.y = cvt_pk_bf16(v0[2], v0[3]); w.z = cvt_pk_bf16(v1[0], v1[1]); w.w = cvt_pk_bf16(v1[2], v1[3]);
                    *(u32x4*)(rowp + bj * HALF) = w; } }
    }
};
__device__ __forceinline__ float bflo(unsigned w) { return __uint_as_float(w << 16); }
__device__ __forceinline__ float bfhi(unsigned w) { return __uint_as_float(w & 0xffff0000u); }
__device__ __forceinline__ float sigm(float v) { return __builtin_amdgcn_rcpf(1.f + __expf(-v)); }
struct EpiGlu {
    static constexpr bool PERM = true, AFTER_DRAIN = false;
    const bf16_t* GY; bf16_t* MIX; const float* bias;
    __device__ __forceinline__ void operator()(const f32x4 (&acc)[2][2][4][2], const Unit& u, int wr, int wc, int fr, int fq) const {
        const int row0 = u.pm * BM + wr * 64 + fr, col0 = u.pn * BM + wc * 32 + 8 * fq;
#pragma unroll
        for (int bj = 0; bj < 2; ++bj) { const int col = col0 + bj * HALF; const f32x4 b0 = *(const f32x4*)(bias + col), b1 = *(const f32x4*)(bias + col + 4);
#pragma unroll
            for (int ai = 0; ai < 2; ++ai)
#pragma unroll
                for (int m = 0; m < 4; ++m) { const size_t row = (size_t)(row0 + ai * HALF + m * 16);
                    const u32x4 g = *(const u32x4*)(GY + row * 512 + col); const f32x4 v0 = acc[ai][bj][m][0] + b0, v1 = acc[ai][bj][m][1] + b1;
                    u32x4 w; w.x = cvt_pk_bf16(bflo(g.x) * sigm(v0[0]), bfhi(g.x) * sigm(v0[1])); w.y = cvt_pk_bf16(bflo(g.y) * sigm(v0[2]), bfhi(g.y) * sigm(v0[3]));
                             w.z = cvt_pk_bf16(bflo(g.z) * sigm(v1[0]), bfhi(g.z) * sigm(v1[1])); w.w = cvt_pk_bf16(bflo(g.w) * sigm(v1[2]), bfhi(g.w) * sigm(v1[3]));
                    *(u32x4*)(MIX + row * 1024 + 512 + col) = w; } }
    }
};
struct EpiResid {
    static constexpr bool PERM = false, AFTER_DRAIN = false;
    const float* xa; const float* xb; float* out; const float* gate;
    static constexpr int MPROWS = 16384, NMODS = 8192;
    __device__ __forceinline__ void operator()(const f32x4 (&acc)[2][2][4][2], const Unit& u, int wr, int wc, int fr, int fq) const {
        const int row0 = u.pm * BM + wr * 64 + fr, col0 = u.pn * BM + wc * 32 + 4 * fq;
#pragma unroll
        for (int ai = 0; ai < 2; ++ai)
#pragma unroll
            for (int m = 0; m < 4; ++m) { const int row = row0 + ai * HALF + m * 16; const int s = row < MPROWS ? row / 2048 : 8 + (row - MPROWS) / 4;
                const float* res = row < MPROWS ? xa + (size_t)row * 1024 : xb + (size_t)(row - MPROWS) * 1024; const float* gp = gate + (size_t)s * NMODS; float* op = out + (size_t)row * 1024;
#pragma unroll
                for (int bj = 0; bj < 2; ++bj)
#pragma unroll
                    for (int n = 0; n < 2; ++n) { const int col = col0 + bj * HALF + n * 16; const f32x4 r = *(const f32x4*)(res + col), g = *(const f32x4*)(gp + col);
                        *(f32x4*)(op + col) = r + g * acc[ai][bj][m][n]; } }
    }
};
struct EpiSwiglu {
    static constexpr bool PERM = true, AFTER_DRAIN = false;
    bf16_t* Hf; int ldc;
    __device__ __forceinline__ void operator()(const f32x4 (&acc)[2][2][4][2], const Unit& u, int wr, int wc, int fr, int fq) const {
        const int row0 = u.pm * BM + wr * 64 + fr, col0 = u.pn * HALF + wc * 32 + 8 * fq;
#pragma unroll
        for (int ai = 0; ai < 2; ++ai)
#pragma unroll
            for (int m = 0; m < 4; ++m) { const f32x4 g0 = acc[ai][0][m][0], g1 = acc[ai][0][m][1], u0 = acc[ai][1][m][0], u1 = acc[ai][1][m][1];
                u32x4 w; w.x = cvt_pk_bf16(g0[0] * sigm(g0[0]) * u0[0], g0[1] * sigm(g0[1]) * u0[1]); w.y = cvt_pk_bf16(g0[2] * sigm(g0[2]) * u0[2], g0[3] * sigm(g0[3]) * u0[3]);
                         w.z = cvt_pk_bf16(g1[0] * sigm(g1[0]) * u1[0], g1[1] * sigm(g1[1]) * u1[1]); w.w = cvt_pk_bf16(g1[2] * sigm(g1[2]) * u1[2], g1[3] * sigm(g1[3]) * u1[3]);
                *(u32x4*)(Hf + (size_t)(row0 + ai * HALF + m * 16) * ldc + col0) = w; }
    }
};

template <class Epi, class Sched, bool ALIGN_EPI = false, bool SP2 = false>
__device__ __forceinline__ void gemm_phase(PG8_LAS unsigned char* lds, const Gemm g, const Sched& S, const Epi& E) {
    const int tid = threadIdx.x, wid = __builtin_amdgcn_readfirstlane(tid >> 6), lane = tid & 63, wr = wid >> 2, wc = wid & 3, fr = lane & 15, fq = lane >> 4;
    const int K = g.K, nt = K / BK;
    unsigned voffA[2], voffB[2];
#pragma unroll
    for (int i = 0; i < 2; ++i) { int R, C; stage_rc(tid * 16 + i * 8192, R, C); const int Rb = Epi::PERM ? ((R & ~31) + perm32(R & 31)) : R;
        voffA[i] = (unsigned)(R * K + C) * 2u; voffB[i] = (unsigned)(Rb * K + C) * 2u; }
    const size_t kstep = (size_t)(BK * 2);
    const size_t hstep = (size_t)HALF * K * 2;
    const size_t tstep = 2 * hstep;
    const unsigned ldsw = (unsigned)wid * 1024u;
    const int aoff = lds_byte(wr * 64 + fr, fq * 8), boff = lds_byte(wc * 32 + fr, fq * 8);
#define PG8_SA(b, h) (((b) * 2 + (h)) * HTB)
#define PG8_SB(b, h) ((4 + (b) * 2 + (h)) * HTB)
#define PG8_STAGE(bufoff, gbase, voff) do { _Pragma("unroll") for (int _i = 0; _i < 2; ++_i) \
        __builtin_amdgcn_global_load_lds((const unsigned*)((const char*)(gbase) + (voff)[_i]), (PG8_LAS unsigned*)(lds + (bufoff) + ldsw + _i * 8192), 16, 0, 0); } while (0)
#define PG8_LDA(dst, b, h) do { _Pragma("unroll") for (int m = 0; m < 4; ++m) _Pragma("unroll") for (int k = 0; k < 2; ++k) dst[m][k] = *(const PG8_LAS bf16x8*)(lds + PG8_SA(b, h) + aoff + m * 2048 + k * 1024); } while (0)
#define PG8_LDB(dst, b, h) do { _Pragma("unroll") for (int n = 0; n < 2; ++n) _Pragma("unroll") for (int k = 0; k < 2; ++k) dst[n][k] = *(const PG8_LAS bf16x8*)(lds + PG8_SB(b, h) + boff + n * 2048 + k * 1024); } while (0)
#define PG8_MMA(ai, bj, At, Bt) do { __builtin_amdgcn_s_setprio(1); _Pragma("unroll") for (int m = 0; m < 4; ++m) _Pragma("unroll") for (int n = 0; n < 2; ++n) _Pragma("unroll") for (int k = 0; k < 2; ++k) \
        acc[ai][bj][m][n] = __builtin_amdgcn_mfma_f32_16x16x32_bf16(Bt[n][k], At[m][k], acc[ai][bj][m][n], 0, 0, 0); __builtin_amdgcn_s_setprio(0); } while (0)
#define PG8_WAIT_V(n) asm volatile("s_waitcnt vmcnt(" #n ")" ::: "memory")
#define PG8_WAIT_L(n) asm volatile("s_waitcnt lgkmcnt(" #n ")" ::: "memory")
#define PG8_BAR __builtin_amdgcn_s_barrier()
#define PG8_SCHED __builtin_amdgcn_sched_barrier(0)
    Unit cur, nxt; int ui = 0;
    if (!S.next(0, cur)) return;
    f32x4 acc[2][2][4][2];
#pragma unroll
    for (int a = 0; a < 2; ++a)
#pragma unroll
        for (int b = 0; b < 2; ++b)
#pragma unroll
            for (int m = 0; m < 4; ++m)
#pragma unroll
                for (int n = 0; n < 2; ++n) acc[a][b][m][n] = (f32x4){0.f, 0.f, 0.f, 0.f};
    bf16x8 At[4][2], B0[2][2], B1[2][2];
    const char* cA = (const char*)g.A + (size_t)cur.pm * tstep; const char* cB = (const char*)g.Bt + (size_t)cur.pn * tstep;
    S.a_ready(cur);
    if constexpr (SP2) {
        PG8_STAGE(PG8_SB(0, 0), cB, voffB); PG8_STAGE(PG8_SB(0, 1), cB + hstep, voffB); PG8_STAGE(PG8_SA(0, 0), cA, voffA); PG8_STAGE(PG8_SA(0, 1), cA + hstep, voffA);
        if (wr == 1) PG8_BAR;
        PG8_WAIT_V(2); PG8_BAR;
        PG8_STAGE(PG8_SB(1, 0), cB + kstep, voffB); PG8_STAGE(PG8_SA(1, 0), cA + kstep, voffA); PG8_STAGE(PG8_SB(1, 1), cB + hstep + kstep, voffB);
        PG8_WAIT_V(6); PG8_BAR;
    } else {
        PG8_STAGE(PG8_SB(0, 0), cB, voffB); PG8_STAGE(PG8_SA(0, 0), cA, voffA); PG8_STAGE(PG8_SB(0, 1), cB + hstep, voffB); PG8_STAGE(PG8_SA(0, 1), cA + hstep, voffA);
        if (wr == 1) PG8_BAR;
        PG8_WAIT_V(4); PG8_BAR;
        PG8_STAGE(PG8_SB(1, 0), cB + kstep, voffB); PG8_STAGE(PG8_SA(1, 0), cA + kstep, voffA); PG8_STAGE(PG8_SB(1, 1), cB + hstep + kstep, voffB);
        PG8_WAIT_V(6); PG8_BAR;
    }
    for (;;) {
        const bool has_next = S.next(ui + 1, nxt);
        const char* nA = has_next ? (const char*)g.A + (size_t)nxt.pm * tstep : cA; const char* nB = has_next ? (const char*)g.Bt + (size_t)nxt.pn * tstep : cB;
        for (int t = 0; t < nt; t += 2) {
            const bool last = (t == nt - 2);
            const char* a1 = cA + (size_t)(t + 1) * kstep;
            const char* a2 = last ? nA : cA + (size_t)(t + 2) * kstep; const char* b2 = last ? nB : cB + (size_t)(t + 2) * kstep;
            const char* a3 = a2 + kstep; const char* b3 = b2 + kstep;
            if (last && has_next) S.a_ready(nxt);
            if constexpr (SP2) {
            PG8_LDB(B0, 0, 0); PG8_LDB(B1, 0, 1); PG8_SCHED; PG8_LDA(At, 0, 0); PG8_STAGE(PG8_SA(1, 1), a1 + hstep, voffA);
            PG8_WAIT_V(8); PG8_WAIT_L(0); PG8_BAR; PG8_MMA(0, 0, At, B0); PG8_MMA(0, 1, At, B1); PG8_BAR; PG8_SCHED;
            PG8_LDA(At, 0, 1); PG8_STAGE(PG8_SB(0, 0), b2, voffB); PG8_STAGE(PG8_SB(0, 1), b2 + hstep, voffB); PG8_STAGE(PG8_SA(0, 0), a2, voffA);
            PG8_WAIT_V(8); PG8_WAIT_L(0); PG8_BAR; PG8_MMA(1, 0, At, B0); PG8_MMA(1, 1, At, B1); PG8_BAR; PG8_SCHED;
            PG8_LDB(B0, 1, 0); PG8_LDB(B1, 1, 1); PG8_SCHED; PG8_LDA(At, 1, 0); PG8_STAGE(PG8_SA(0, 1), a2 + hstep, voffA);
            PG8_WAIT_V(8); PG8_WAIT_L(0); PG8_BAR; PG8_MMA(0, 0, At, B0); PG8_MMA(0, 1, At, B1); PG8_BAR; PG8_SCHED;
            PG8_LDA(At, 1, 1); PG8_STAGE(PG8_SB(1, 0), b3, voffB); PG8_STAGE(PG8_SB(1, 1), b3 + hstep, voffB); PG8_STAGE(PG8_SA(1, 0), a3, voffA);
            PG8_WAIT_V(8); PG8_WAIT_L(0); PG8_BAR; PG8_MMA(1, 0, At, B0); PG8_MMA(1, 1, At, B1); PG8_BAR; PG8_SCHED;
            } else {
            PG8_LDB(B0, 0, 0); PG8_SCHED; PG8_LDA(At, 0, 0); PG8_STAGE(PG8_SA(1, 1), a1 + hstep, voffA);
            PG8_WAIT_L(8); PG8_BAR; PG8_WAIT_L(0); PG8_MMA(0, 0, At, B0); PG8_BAR; PG8_SCHED;
            PG8_LDB(B1, 0, 1); PG8_STAGE(PG8_SB(0, 0), b2, voffB);
            PG8_BAR; PG8_WAIT_L(0); PG8_MMA(0, 1, At, B1); PG8_BAR;
            PG8_LDA(At, 0, 1); PG8_STAGE(PG8_SA(0, 0), a2, voffA);
            PG8_BAR; PG8_WAIT_L(0); PG8_MMA(1, 0, At, B0); PG8_BAR; PG8_SCHED;
            PG8_STAGE(PG8_SB(0, 1), b2 + hstep, voffB);
            PG8_WAIT_V(6); PG8_BAR; PG8_MMA(1, 1, At, B1); PG8_BAR;
            PG8_LDB(B0, 1, 0); PG8_SCHED; PG8_LDA(At, 1, 0); PG8_STAGE(PG8_SA(0, 1), a2 + hstep, voffA);
            PG8_WAIT_L(8); PG8_BAR; PG8_WAIT_L(0); PG8_MMA(0, 0, At, B0); PG8_BAR; PG8_SCHED;
            PG8_LDB(B1, 1, 1); PG8_STAGE(PG8_SB(1, 0), b3, voffB);
            PG8_BAR; PG8_WAIT_L(0); PG8_MMA(0, 1, At, B1); PG8_BAR;
            PG8_LDA(At, 1, 1); PG8_STAGE(PG8_SA(1, 0), a3, voffA);
            PG8_BAR; PG8_WAIT_L(0); PG8_MMA(1, 0, At, B0); PG8_BAR; PG8_SCHED;
            PG8_STAGE(PG8_SB(1, 1), b3 + hstep, voffB);
            PG8_WAIT_V(6); PG8_BAR; PG8_MMA(1, 1, At, B1); PG8_BAR;
            }
        }
        if constexpr (ALIGN_EPI) { if (wr == 0) PG8_BAR; }
        if constexpr (!Epi::AFTER_DRAIN) { E(acc, cur, wr, wc, fr, fq); S.done(cur); }
        if (!has_next) break;
#pragma unroll
        for (int a = 0; a < 2; ++a)
#pragma unroll
            for (int b = 0; b < 2; ++b)
#pragma unroll
                for (int m = 0; m < 4; ++m)
#pragma unroll
                    for (int n = 0; n < 2; ++n) acc[a][b][m][n] = (f32x4){0.f, 0.f, 0.f, 0.f};
        cur = nxt; cA = nA; cB = nB; ++ui;
        if constexpr (ALIGN_EPI) { if (wr == 1) PG8_BAR; }
    }
    PG8_WAIT_V(0);
    if constexpr (!ALIGN_EPI) { if (wr == 0) PG8_BAR; }
    PG8_BAR;
    if constexpr (Epi::AFTER_DRAIN) { E.fused(acc, cur, wr, wc, fr, fq, lds, wid, lane); S.done(cur); }
#undef PG8_SA
#undef PG8_SB
#undef PG8_STAGE
#undef PG8_LDA
#undef PG8_LDB
#undef PG8_MMA
#undef PG8_WAIT_V
#undef PG8_WAIT_L
#undef PG8_BAR
#undef PG8_SCHED
}
}
#define LAS __attribute__((address_space(3)))
typedef unsigned v4u __attribute__((ext_vector_type(4)));
typedef float f32x4 __attribute__((ext_vector_type(4)));
typedef float f32x2 __attribute__((ext_vector_type(2)));
typedef unsigned u32x2 __attribute__((ext_vector_type(2)));
typedef short bf16x8 __attribute__((ext_vector_type(8)));
constexpr int NWAVES = 8, NTHR = 512;
constexpr int LDS_BYTES = 147456;
#define LDS_WAIT() asm volatile("s_waitcnt lgkmcnt(0)" ::: "memory")

struct Args { const float* in[36]; float* out; unsigned char* ws; int ph_lo, ph_hi; };
enum { I_XP = 0, I_XS, I_CP, I_CS, I_SSSD, I_SCONV, I_SRE, I_SIM, I_WADA, I_BADA, I_N1G, I_WIN, I_CONVW, I_CONVB, I_DTB, I_ALOG, I_SSDD, I_SSDNG, I_ARE, I_AIM, I_LSTEP, I_BRE, I_BIM,
       I_CRE, I_CIM, I_S5D, I_WGLU, I_BGLU, I_WOUT, I_N2G, I_WGATE, I_WUP, I_WDOWN, I_WADAF, I_BADAF, I_NFG };

__device__ __forceinline__ float wave_sum(float v) {
#pragma unroll
    for (int o = 1; o < 64; o <<= 1) v += __shfl_xor(v, o);
    return v;
}
__device__ __forceinline__ void transpose_item(const float* W, int ldw, int col0, int k0, bf16* WT, int row0, int K, LAS float* scr, int lane) {
#pragma unroll 8
    for (int i = 0; i < 32; ++i) { const int kk = 2 * i + (lane >> 5); scr[kk * 33 + (lane & 31)] = W[(size_t)(k0 + kk) * ldw + col0 + (lane & 31)]; }
    LDS_WAIT();
    const int c = lane & 7;
#pragma unroll
    for (int j = 0; j < 4; ++j) { const int n = (lane >> 3) + 8 * j; const LAS float* s = scr + (8 * c) * 33 + n;
        v4u o; o.x = pk2(s[0 * 33], s[1 * 33]); o.y = pk2(s[2 * 33], s[3 * 33]); o.z = pk2(s[4 * 33], s[5 * 33]); o.w = pk2(s[6 * 33], s[7 * 33]);
        *(v4u*)(WT + (size_t)(row0 + n) * K + k0 + 8 * c) = o; }
    LDS_WAIT();
}

__device__ __forceinline__ void phase_prep(const Args& a, LAS unsigned char* lds, int tid, int lane, int wave) {
    unsigned char* ws = a.ws;
    LAS float* scr = (LAS float*)(lds + wave * 16384);
    const int gw = blockIdx.x * NWAVES + wave, NGW = gridDim.x * NWAVES;
    constexpr int I0 = 16 * 64, I1 = 8 * 16, I2 = 16 * 32, I3 = 16 * 176, I4 = 44 * 32, NIT = I0 + I1 + I2 + I3 + I4;
    for (int it = gw; it < NIT; it += NGW) {
        int r = it;
        if (r < I0) { const int kb = r / 64, nb = r % 64; transpose_item(a.in[I_WIN], INP, 32 * nb + (nb >= 48 ? 8 : 0), 64 * kb, (bf16*)(ws + WS_WIN), 32 * nb, 1024, scr, lane); continue; } r -= I0;
        if (r < I1) { const int kb = r / 16, nb = r % 16; transpose_item(a.in[I_WGLU], 512, 32 * nb, 64 * kb, (bf16*)(ws + WS_WGLU), 32 * nb, 512, scr, lane); continue; } r -= I1;
        if (r < I2) { const int kb = r / 32, nb = r % 32; transpose_item(a.in[I_WOUT], 1024, 32 * nb, 64 * kb, (bf16*)(ws + WS_WOUT), 32 * nb, 1024, scr, lane); continue; } r -= I2;
        if (r < I3) { const int kb = r / 176, nb = r % 176, tile = nb >> 3, sub = nb & 7;
                      transpose_item(sub < 4 ? a.in[I_WGATE] : a.in[I_WUP], DFF, 128 * tile + 32 * (sub & 3), 64 * kb, (bf16*)(ws + WS_WUP), 32 * nb, 1024, scr, lane); continue; } r -= I3;
        { const int kb = r / 32, nb = r % 32; transpose_item(a.in[I_WDOWN], 1024, 32 * nb, 64 * kb, (bf16*)(ws + WS_WDOWN), 32 * nb, DFF, scr, lane); }
    }
    { const int gp = blockIdx.x * NTHR + tid;
      if (gp < G5 * P5) { const int g = gp / P5, p = gp % P5;
        const float lr = a.in[I_ARE][gp], li = a.in[I_AIM][gp], step = expf(a.in[I_LSTEP][g]);
        const float mag = expf(lr * step), abr = mag * cosf(li * step), abi = mag * sinf(li * step);
        const float nr = abr - 1.f, ni = abi, den = lr * lr + li * li, fr = (nr * lr + ni * li) / den, fi = (ni * lr - nr * li) / den;
        float* AB = (float*)(ws + WS_AB); AB[2 * gp] = abr; AB[2 * gp + 1] = abi;
        float pr = abr, pi = abi;
#pragma unroll
        for (int q = 0; q < 7; ++q) { const float t = pr * pr - pi * pi; pi = 2.f * pr * pi; pr = t; }
        AB[2 * G5 * P5 + 2 * gp] = pr; AB[2 * G5 * P5 + 2 * gp + 1] = pi;
        bf16* BB = (bf16*)(ws + WS_BB) + ((size_t)g * 128 + 2 * p) * 16; bf16* CC = (bf16*)(ws + WS_CC) + (size_t)g * 16 * 128 + 2 * p;
        for (int c = 0; c < CH5; ++c) { const float br = a.in[I_BRE][(size_t)gp * CH5 + c], bi = a.in[I_BIM][(size_t)gp * CH5 + c];
            BB[c] = (bf16)f2bf(fr * br - fi * bi); BB[16 + c] = (bf16)f2bf(fr * bi + fi * br);
            CC[c * 128] = (bf16)f2bf(a.in[I_CRE][((size_t)g * CH5 + c) * P5 + p]); CC[c * 128 + 1] = (bf16)f2bf(-a.in[I_CIM][((size_t)g * CH5 + c) * P5 + p]); } } }
    __syncthreads();
    for (int wb = blockIdx.x; wb < NMOD / 32; wb += gridDim.x) {
        const int j0 = 32 * wb; const bool fin = j0 >= 6144; const float* W = fin ? a.in[I_WADAF] : a.in[I_WADA]; const int ldw = fin ? 2048 : 6144, jc = fin ? j0 - 6144 : j0;
        const float* bias = (fin ? a.in[I_BADAF] : a.in[I_BADA]) + jc;
        const int kq = wave & 3, nt = wave >> 2, fr = lane & 15, fq = lane >> 4;
        f32x4 acc[9];
#pragma unroll
        for (int mt = 0; mt < 9; ++mt) acc[mt] = (f32x4){0.f, 0.f, 0.f, 0.f};
        for (int kk = 0; kk < 8; ++kk) {
            const int k0 = 256 * kq + 32 * kk + 8 * fq;
            bf16x8 bfr;
#pragma unroll
            for (int j = 0; j < 8; ++j) bfr[j] = (short)f2bf(W[(size_t)(k0 + j) * ldw + jc + 16 * nt + fr]);
#pragma unroll
            for (int mt = 0; mt < 9; ++mt) { const int s = 16 * mt + fr; bf16x8 afr;
                if (s < NSEQ) { const float* c = (s < NP ? a.in[I_CP] + (size_t)s * D : a.in[I_CS] + (size_t)(s - NP) * D) + k0;
                    const f32x4 c0 = *(const f32x4*)c, c1 = *(const f32x4*)(c + 4);
#pragma unroll
                    for (int j = 0; j < 4; ++j) { afr[j] = (short)f2bf(siluf(c0[j])); afr[4 + j] = (short)f2bf(siluf(c1[j])); } }
                else {
#pragma unroll
                    for (int j = 0; j < 8; ++j) afr[j] = 0; }
                acc[mt] = __builtin_amdgcn_mfma_f32_16x16x32_bf16(afr, bfr, acc[mt], 0, 0, 0); }
        }
        LAS float* part = (LAS float*)lds;
#pragma unroll
        for (int mt = 0; mt < 9; ++mt)
#pragma unroll
            for (int r = 0; r < 4; ++r) part[((kq * 2 + nt) * 144 + 16 * mt + 4 * fq + r) * 16 + fr] = acc[mt][r];
        __syncthreads();
        for (int e = tid; e < NSEQ * 32; e += NTHR) { const int s = e >> 5, c = e & 31, ntt = c >> 4, cc = c & 15; float v = bias[c];
#pragma unroll
            for (int q = 0; q < 4; ++q) v += part[((q * 2 + ntt) * 144 + s) * 16 + cc];
            ((float*)(ws + WS_MOD))[(size_t)s * NMOD + j0 + c] = v; }
        __syncthreads();
    }
}

template <int MODE> __device__ __forceinline__ void phase_modnorm(const Args& a, LAS unsigned char* lds, int tid, int lane, int wave) {
    unsigned char* ws = a.ws; const float* mod = (const float*)(ws + WS_MOD);
    const int sh_off = MODE == 0 ? 0 : (MODE == 1 ? 3072 : 6144), sc_off = sh_off + 1024;
    const float* gam = a.in[MODE == 0 ? I_N1G : (MODE == 1 ? I_N2G : I_NFG)];
    LAS float* wdt = (LAS float*)lds;
    if (MODE == 0) { for (int e = tid; e < 8192; e += NTHR) { const int k = e >> 3, h = e & 7; wdt[h * 1024 + k] = a.in[I_WIN][(size_t)k * INP + O2 + h]; } __syncthreads(); }
    const int gw = blockIdx.x * NWAVES + wave, NGW = gridDim.x * NWAVES;
    for (int row = gw; row < M; row += NGW) {
        const int s = seq_of_row(row);
        const float* x = MODE == 0 ? (row < MP ? a.in[I_XP] + (size_t)row * D : a.in[I_XS] + (size_t)(row - MP) * D) : a.out + OUT_Y + (size_t)row * D;
        f32x4 v[4]; float ss = 0.f;
#pragma unroll
        for (int j = 0; j < 4; ++j) { v[j] = *(const f32x4*)(x + 4 * lane + 256 * j); ss += (v[j][0] * v[j][0] + v[j][1] * v[j][1]) + (v[j][2] * v[j][2] + v[j][3] * v[j][3]); }
        const float inv = rsqrtf(wave_sum(ss) * (1.f / D) + EPS);
        const float* ms = mod + (size_t)s * NMOD;
#pragma unroll
        for (int j = 0; j < 4; ++j) { const int c = 4 * lane + 256 * j; const f32x4 g = *(const f32x4*)(gam + c), sc = *(const f32x4*)(ms + sc_off + c), sh = *(const f32x4*)(ms + sh_off + c);
            v[j] = v[j] * inv * g * (sc + 1.f) + sh; }
        if (MODE == 2) {
#pragma unroll
            for (int j = 0; j < 4; ++j) *(f32x4*)(a.out + OUT_Y + (size_t)row * D + 4 * lane + 256 * j) = v[j];
        } else {
            bf16* o = (bf16*)(ws + WS_U) + (size_t)row * D;
#pragma unroll
            for (int j = 0; j < 4; ++j) { u32x2 w; w.x = pk2(v[j][0], v[j][1]); w.y = pk2(v[j][2], v[j][3]); *(u32x2*)(o + 4 * lane + 256 * j) = w; }
        }
        if (MODE == 0) {
            float mine = 0.f;
#pragma unroll
            for (int h = 0; h < 8; ++h) { float d = 0.f;
#pragma unroll
                for (int j = 0; j < 4; ++j) { const f32x4 w = *(const LAS f32x4*)(wdt + h * 1024 + 4 * lane + 256 * j); d += (v[j][0] * w[0] + v[j][1] * w[1]) + (v[j][2] * w[2] + v[j][3] * w[3]); }
                d = wave_sum(d); if (lane == h) mine = d; }
            if (lane < 8) ((float*)(ws + WS_DT))[(size_t)row * 8 + lane] = mine;
        }
    }
}

__device__ __forceinline__ float xbcf(const bf16* proj, const float* sconv, int s, int i, int ch) {
    if (i < 3) return s < NP ? 0.f : sconv[((size_t)(s - NP) * 3 + i) * CONVD + ch];
    const int row = s < NP ? s * LP + (i - 3) : MP + (s - NP) * LS + (i - 3);
    return bf2f(proj[(size_t)row * NPROJ + O1 + ch]);
}
__global__ void nv_convnew(const bf16* proj, const float* sconv, float* out) {
    const int s = blockIdx.x, L = s < NP ? LP : LS;
    float* o = s < NP ? out + OUT_CONVP + (size_t)s * 3 * CONVD : out + OUT_CONVS + (size_t)(s - NP) * 3 * CONVD;
    for (int e = threadIdx.x; e < 3 * CONVD; e += blockDim.x) o[e] = xbcf(proj, sconv, s, L + e / CONVD, e % CONVD);
}
__global__ void __launch_bounds__(512) nv_ssd(const bf16* proj, const float* dtraw, const float* sconv, const float* sssd, const float* convw, const float* convb, const float* dtb, const float* Alog,
                                              const float* Dsk, float* yssd, float* out) {
    const int s = blockIdx.x / H, h = blockIdx.x % H, g = h / (H / NG), tid = threadIdx.x, p = tid / 8, nq = tid % 8;
    const int L = s < NP ? LP : LS, row0 = s < NP ? s * LP : MP + (s - NP) * LS;
    __shared__ float sx[PD], sB[NST], sC[NST];
    float st[16];
    for (int j = 0; j < 16; ++j) st[j] = s < NP ? 0.f : sssd[(((size_t)(s - NP) * H + h) * PD + p) * NST + nq * 16 + j];
    const float A = -expf(Alog[h]), Dh = Dsk[h], bias = dtb[h];
    for (int t = 0; t < L; ++t) {
        if (tid < PD + 2 * NST) {
            const int ch = tid < PD ? h * PD + tid : (tid < PD + NST ? DSSD + g * NST + (tid - PD) : DSSD + NG * NST + g * NST + (tid - PD - NST));
            float c = convb[ch];
            for (int k = 0; k < 4; ++k) c += xbcf(proj, sconv, s, t + k, ch) * convw[k * CONVD + ch];
            c = siluf(c);
            if (tid < PD) sx[tid] = c; else if (tid < PD + NST) sB[tid - PD] = c; else sC[tid - PD - NST] = c;
        }
        __syncthreads();
        const float dt = softplusf(dtraw[(size_t)(row0 + t) * 8 + h] + bias), dA = expf(dt * A), xv = sx[p], dx = dt * xv;
        float y = 0.f;
        for (int j = 0; j < 16; ++j) { st[j] = st[j] * dA + dx * sB[nq * 16 + j]; y += sC[nq * 16 + j] * st[j]; }
        y += __shfl_xor(y, 1); y += __shfl_xor(y, 2); y += __shfl_xor(y, 4);
        if (nq == 0) yssd[(size_t)(row0 + t) * DSSD + h * PD + p] = y + Dh * xv;
        __syncthreads();
    }
    float* o = s < NP ? out + OUT_SSDP + (((size_t)s * H + h) * PD + p) * NST : out + OUT_SSDS + (((size_t)(s - NP) * H + h) * PD + p) * NST;
    for (int j = 0; j < 16; ++j) o[nq * 16 + j] = st[j];
}
__global__ void nv_ssdnorm(const float* yssd, const bf16* proj, const float* ng, bf16* mix) {
    const int row = blockIdx.x, t = threadIdx.x;
    __shared__ float red[2][256];
    float v[2];
    for (int gi = 0; gi < 2; ++gi) { const int c = gi * 256 + t; v[gi] = yssd[(size_t)row * DSSD + c] * siluf(bf2f(proj[(size_t)row * NPROJ + c])); red[gi][t] = v[gi] * v[gi]; }
    __syncthreads();
    for (int o = 128; o > 0; o >>= 1) { if (t < o) { red[0][t] += red[0][t + o]; red[1][t] += red[1][t + o]; } __syncthreads(); }
    for (int gi = 0; gi < 2; ++gi) { const int c = gi * 256 + t; mix[(size_t)row * D + c] = (bf16)f2bf(v[gi] * rsqrtf(red[gi][0] / 256.f + EPS) * ng[c]); }
}
__global__ void nv_s5(const bf16* proj, const float* s0re, const float* s0im, const float* Are, const float* Aim, const float* lstep, const float* Bre, const float* Bim,
                      const float* Cre, const float* Cim, const float* Dsk, bf16* gy, float* out) {
    const int s = blockIdx.x / G5, g = blockIdx.x % G5, p = threadIdx.x;
    const int L = s < NP ? LP : LS, row0 = s < NP ? s * LP : MP + (s - NP) * LS;
    const float lr = Are[g * P5 + p], li = Aim[g * P5 + p], step = expf(lstep[g]);
    const float mag = expf(lr * step), abr = mag * cosf(li * step), abi = mag * sinf(li * step);
    const float nr = abr - 1.f, ni = abi, den = lr * lr + li * li, fr = (nr * lr + ni * li) / den, fi = (ni * lr - nr * li) / den;
    float bbr[CH5], bbi[CH5], cr[CH5], ci[CH5];
    for (int c = 0; c < CH5; ++c) { const float br = Bre[((size_t)g * P5 + p) * CH5 + c], bi = Bim[((size_t)g * P5 + p) * CH5 + c];
        bbr[c] = fr * br - fi * bi; bbi[c] = fr * bi + fi * br; cr[c] = Cre[((size_t)g * CH5 + c) * P5 + p]; ci[c] = Cim[((size_t)g * CH5 + c) * P5 + p]; }
    float hr = s < NP ? 0.f : s0re[((size_t)(s - NP) * G5 + g) * P5 + p], hi = s < NP ? 0.f : s0im[((size_t)(s - NP) * G5 + g) * P5 + p];
    for (int t = 0; t < L; ++t) {
        const bf16* u = proj + (size_t)(row0 + t) * NPROJ + 1536 + g * CH5;
        float br = 0.f, bi = 0.f, uv[CH5];
        for (int c = 0; c < CH5; ++c) { uv[c] = bf2f(u[c]); br += bbr[c] * uv[c]; bi += bbi[c] * uv[c]; }
        const float nhr = abr * hr - abi * hi + br, nhi = abr * hi + abi * hr + bi; hr = nhr; hi = nhi;
        float mine = 0.f;
        for (int c = 0; c < CH5; ++c) { float v = cr[c] * hr - ci[c] * hi;
            for (int o = 1; o < 64; o <<= 1) v += __shfl_xor(v, o);
            if (p == c) mine = v + Dsk[g * CH5 + c] * uv[c]; }
        if (p < CH5) gy[(size_t)(row0 + t) * DS5 + g * CH5 + p] = (bf16)f2bf(0.5f * mine * (1.f + erff(mine * 0.70710678118654752f)));
    }
    float* ore = s < NP ? out + OUT_REP + ((size_t)s * G5 + g) * P5 : out + OUT_RES + ((size_t)(s - NP) * G5 + g) * P5;
    float* oim = s < NP ? out + OUT_IMP + ((size_t)s * G5 + g) * P5 : out + OUT_IMS + ((size_t)(s - NP) * G5 + g) * P5;
    ore[p] = hr; oim[p] = hi;
}
__global__ void nv_ada(const float* cp, const float* cs, const float* w, const float* b, float* mod, int N, int off) {
    const int j = blockIdx.x * 256 + threadIdx.x, s = blockIdx.y;
    const float* c = s < NP ? cp + (size_t)s * D : cs + (size_t)(s - NP) * D;
    float acc = 0.f;
    for (int k = 0; k < D; ++k) acc += siluf(c[k]) * w[(size_t)k * N + j];
    mod[(size_t)s * NMOD + off + j] = acc + b[j];
}

constexpr int NPHASE = 12;
__global__ void __launch_bounds__(NTHR, 2) fwd_mega(Args a) {
    extern __shared__ __attribute__((aligned(16))) unsigned char lds_raw[];
    LAS unsigned char* lds = (LAS unsigned char*)lds_raw;
    cg::grid_group grid = cg::this_grid();
    const int tid = threadIdx.x, lane = tid & 63, wave = __builtin_amdgcn_readfirstlane(tid >> 6);
    unsigned char* ws = a.ws;
    const int lo = a.ph_lo, hi = a.ph_hi, G = gridDim.x;
#define IN(k) (lo <= (k) && (k) < hi)
#define SEAM(k) do { if (IN(k) && IN((k) + 1)) grid.sync(); } while (0)
    if (IN(0)) phase_prep(a, lds, tid, lane, wave);
    SEAM(0);
    if (IN(1)) phase_modnorm<0>(a, lds, tid, lane, wave);
    SEAM(1);
    if (IN(2)) { pg8::Gemm g{(const bf16*)(ws + WS_U), (const bf16*)(ws + WS_WIN), M, NPROJ, D}; pg8::StaticOrder S; S.init(M, NPROJ, G, (int)blockIdx.x);
                 pg8::EpiBf16 E{(bf16*)(ws + WS_PROJ), NPROJ}; pg8::gemm_phase<pg8::EpiBf16, pg8::StaticOrder, true, true>(lds, g, S, E); }
    SEAM(2);
    SEAM(3); SEAM(4); SEAM(5);
    if (IN(6)) { pg8::Gemm g{(const bf16*)(ws + WS_GY), (const bf16*)(ws + WS_WGLU), M, DS5, DS5}; pg8::StaticOrder S; S.init(M, DS5, G, (int)blockIdx.x);
                 pg8::EpiGlu E{(const bf16*)(ws + WS_GY), (bf16*)(ws + WS_MIX), a.in[I_BGLU]}; pg8::gemm_phase<pg8::EpiGlu, pg8::StaticOrder, true, true>(lds, g, S, E); }
    SEAM(6);
    if (IN(7)) { pg8::Gemm g{(const bf16*)(ws + WS_MIX), (const bf16*)(ws + WS_WOUT), M, D, D}; pg8::StaticOrder S; S.init(M, D, G, (int)blockIdx.x);
                 pg8::EpiResid E{a.in[I_XP], a.in[I_XS], a.out + OUT_Y, (const float*)(ws + WS_MOD) + 2048}; pg8::gemm_phase<pg8::EpiResid, pg8::StaticOrder, true, true>(lds, g, S, E); }
    SEAM(7);
    if (IN(8)) phase_modnorm<1>(a, lds, tid, lane, wave);
    SEAM(8);
    if (IN(9)) { pg8::Gemm g{(const bf16*)(ws + WS_U), (const bf16*)(ws + WS_WUP), M, 2 * DFF, D}; pg8::StaticOrder S; S.init(M, 2 * DFF, G, (int)blockIdx.x);
                 pg8::EpiSwiglu E{(bf16*)(ws + WS_HFF), DFF}; pg8::gemm_phase<pg8::EpiSwiglu, pg8::StaticOrder, true, true>(lds, g, S, E); }
    SEAM(9);
    if (IN(10)) { pg8::Gemm g{(const bf16*)(ws + WS_HFF), (const bf16*)(ws + WS_WDOWN), M, D, DFF}; pg8::StaticOrder S; S.init(M, D, G, (int)blockIdx.x);
                  pg8::EpiResid E{a.out + OUT_Y, a.out + OUT_Y + (size_t)MP * D, a.out + OUT_Y, (const float*)(ws + WS_MOD) + 5120}; pg8::gemm_phase<pg8::EpiResid, pg8::StaticOrder, true, true>(lds, g, S, E); }
    SEAM(10);
    if (IN(11)) phase_modnorm<2>(a, lds, tid, lane, wave);
#undef IN
#undef SEAM
}

extern "C" void kernel_launch(void* const* d_in, const int* in_sizes, int n_in, void* d_out, int out_size, void* d_ws, size_t ws_size, hipStream_t stream) {
    static int grid = 0;
    if (grid == 0) {
        int dev = 0, cus = 0, per_cu = 0;
        (void)hipGetDevice(&dev); (void)hipDeviceGetAttribute(&cus, hipDeviceAttributeMultiprocessorCount, dev);
        (void)hipFuncSetAttribute((const void*)fwd_mega, hipFuncAttributeMaxDynamicSharedMemorySize, LDS_BYTES);
        (void)hipOccupancyMaxActiveBlocksPerMultiprocessor(&per_cu, (const void*)fwd_mega, NTHR, LDS_BYTES);
        grid = cus * (per_cu < 1 ? 1 : 1);
        if (n_in != 36 || ws_size < WS_END || out_size != (int)OUT_END) fprintf(stderr, "kernel_launch: unexpected sizes n_in %d ws %zu out %d\n", n_in, ws_size, out_size);
    }
    Args a{};
    for (int i = 0; i < 36; ++i) a.in[i] = (const float*)d_in[i];
    a.out = (float*)d_out; a.ws = (unsigned char*)d_ws;
    const float* const* in = a.in; unsigned char* ws = a.ws; float* out = a.out;
    auto run = [&](int lo, int hi) { a.ph_lo = lo; a.ph_hi = hi; hipLaunchKernelGGL(fwd_mega, dim3(grid), dim3(NTHR), LDS_BYTES, stream, a); };
    run(0, 1); run(1, 2); run(2, 3);
    float* yssd = (float*)(ws + WS_XC);
    nv_convnew<<<NSEQ, 256, 0, stream>>>((const bf16*)(ws + WS_PROJ), in[I_SCONV], out);
    nv_ssd<<<NSEQ * H, 512, 0, stream>>>((const bf16*)(ws + WS_PROJ), (const float*)(ws + WS_DT), in[I_SCONV], in[I_SSSD], in[I_CONVW], in[I_CONVB], in[I_DTB], in[I_ALOG], in[I_SSDD], yssd, out);
    nv_ssdnorm<<<M, 256, 0, stream>>>(yssd, (const bf16*)(ws + WS_PROJ), in[I_SSDNG], (bf16*)(ws + WS_MIX));
    nv_s5<<<NSEQ * G5, 64, 0, stream>>>((const bf16*)(ws + WS_PROJ), in[I_SRE], in[I_SIM], in[I_ARE], in[I_AIM], in[I_LSTEP], in[I_BRE], in[I_BIM], in[I_CRE], in[I_CIM], in[I_S5D], (bf16*)(ws + WS_GY), out);
    run(6, 7); run(7, 8); run(8, 9); run(9, 10); run(10, 11); run(11, 12);
}
```

```cpp
#include <hip/hip_runtime.h>
#include <hip/hip_cooperative_groups.h>
#include <cstdio>
#include <cstdint>
namespace cg = cooperative_groups;
#ifndef DBG_FLAGS
#define DBG_FLAGS 3
#endif

constexpr int D = 1024, NP = 8, LP = 2048, NS = 128, LS = 4, NSEQ = NP + NS;
constexpr int MP = NP * LP, MS = NS * LS, M = MP + MS;
constexpr int H = 8, PD = 64, NST = 128, NG = 2, DSSD = 512, CONVD = 1024;
constexpr int G5 = 32, CH5 = 16, P5 = 64, DS5 = 512;
constexpr int DFF = 2816, INP = 2056, O1 = 512, O2 = 1536, O3 = 1544;
constexpr int NPROJ = 2048;
constexpr int NMOD = 8192;
constexpr float EPS = 1e-6f;
constexpr size_t OUT_Y = 0, OUT_SSDP = (size_t)M * D, OUT_SSDS = OUT_SSDP + (size_t)NP * H * PD * NST, OUT_CONVP = OUT_SSDS + (size_t)NS * H * PD * NST,
                 OUT_CONVS = OUT_CONVP + (size_t)NP * 3 * CONVD, OUT_REP = OUT_CONVS + (size_t)NS * 3 * CONVD, OUT_RES = OUT_REP + (size_t)NP * G5 * P5,
                 OUT_IMP = OUT_RES + (size_t)NS * G5 * P5, OUT_IMS = OUT_IMP + (size_t)NP * G5 * P5, OUT_END = OUT_IMS + (size_t)NS * G5 * P5;
constexpr size_t MiB = 1u << 20;
constexpr size_t WS_CTL = 0, WS_MOD = 1 * MiB, WS_DT = 6 * MiB, WS_BB = 7 * MiB, WS_CC = WS_BB + 256 * 1024, WS_AB = WS_CC + 256 * 1024, WS_ACS = 8 * MiB, WS_S5E = 9 * MiB,
                 WS_WIN = 12 * MiB, WS_WGLU = 16 * MiB, WS_WOUT = 17 * MiB, WS_WUP = 19 * MiB, WS_WDOWN = 30 * MiB,
                 WS_U = 36 * MiB, WS_CS = 36 * MiB, WS_PROJ = 69 * MiB, WS_XC = 135 * MiB, WS_HFF = 69 * MiB, WS_MIX = 168 * MiB, WS_GY = 201 * MiB, WS_G = 218 * MiB, WS_END = 256 * MiB;
static_assert(WS_MOD + (size_t)NSEQ * NMOD * 4 <= WS_DT && WS_DT + (size_t)M * 8 * 4 <= WS_BB && WS_WDOWN + (size_t)D * DFF * 2 <= WS_U && WS_U + (size_t)M * D * 2 <= WS_PROJ, "ws map 1");
static_assert(WS_PROJ + (size_t)M * NPROJ * 2 <= WS_XC && WS_XC + (size_t)M * CONVD * 2 <= WS_MIX && WS_HFF + (size_t)M * DFF * 2 <= WS_MIX && WS_MIX + (size_t)M * D * 2 <= WS_GY && WS_GY + (size_t)M * DS5 * 2 <= WS_G, "ws map 2");

typedef unsigned short bf16;
__device__ __host__ __forceinline__ int seq_of_row(int r) { return r < MP ? r / LP : NP + (r - MP) / LS; }
__device__ __forceinline__ float siluf(float v) { return v / (1.f + expf(-v)); }
__device__ __forceinline__ float softplusf(float v) { return v > 20.f ? v : log1pf(expf(v)); }
__device__ __forceinline__ float bf2f(bf16 b) { return __uint_as_float(((unsigned)b) << 16); }
__device__ __forceinline__ unsigned f2bf(float f) { unsigned u = __float_as_uint(f); return (u + 0x7fffu + ((u >> 16) & 1u)) >> 16; }
__device__ __forceinline__ unsigned pk2(float lo, float hi) { return f2bf(lo) | (f2bf(hi) << 16); }
__device__ __forceinline__ float bflo(unsigned w) { return __uint_as_float(w << 16); }
__device__ __forceinline__ float bfhi(unsigned w) { return __uint_as_float(w & 0xffff0000u); }
__device__ __forceinline__ float sigm(float v) { return __builtin_amdgcn_rcpf(1.f + __expf(-v)); }

namespace pg8 {
#define PG8_LAS __attribute__((address_space(3)))
typedef unsigned short bf16_t;
typedef short bf16x8 __attribute__((ext_vector_type(8)));
typedef float f32x4 __attribute__((ext_vector_type(4)));
typedef unsigned u32x4 __attribute__((ext_vector_type(4)));
constexpr int BM = 256, BK = 64, HALF = 128, HTB = HALF * BK * 2  , STAGE_BYTES = 8 * HTB, NXCD = 8, WGM = 8;

__host__ __device__ __forceinline__ int lds_byte(int r, int c) { const int st = (r >> 4) * 2 + (c >> 5), rr = r & 15, cc = c & 31, ob = rr * 64 + cc * 2; return st * 1024 + (ob ^ (((ob >> 9) & 1) << 5)); }
__host__ __device__ __forceinline__ void stage_rc(int b, int& R, int& C) { const int st = b / 1024, sb = b % 1024, swz = sb ^ (((sb >> 9) & 1) << 5); R = (st >> 1) * 16 + swz / 64; C = (st & 1) * 32 + (swz % 64) / 2; }
__host__ __device__ __forceinline__ int perm32(int rho) { const int n = rho >> 4, i = rho & 15; return 8 * (i >> 2) + 4 * n + (i & 3); }

struct Unit { int pm, pn; };
struct Gemm { const bf16_t* A; const bf16_t* Bt; int M, N, K; };

struct StaticOrder {
    int nM, nN, nwg, G, c;
    __host__ __device__ void init(int M, int N, int G_, int c_) { nM = M / BM; nN = N / BM; nwg = nM * nN; G = G_; c = c_; }
    __host__ __device__ bool next(int i, Unit& u) const {
        const long L = (long)i * G + c; if (L >= nwg) return false;
        int wgid = (int)L; { const int q = nwg / NXCD, r = nwg % NXCD, xcd = wgid % NXCD, off = wgid / NXCD; wgid = (xcd < r ? xcd * (q + 1) : r * (q + 1) + (xcd - r) * q) + off; }
        const int nig = WGM * nN, gid = wgid / nig, fm = gid * WGM, gsz = (nM - fm) < WGM ? (nM - fm) : WGM;
        u.pm = fm + ((wgid % nig) % gsz); u.pn = (wgid % nig) / gsz; return true;
    }
    __device__ __forceinline__ void a_ready(const Unit&) const {}
    __device__ __forceinline__ void done(const Unit&) const {}
};
__device__ __forceinline__ unsigned cvt_pk_bf16(float lo, float hi) { unsigned r; asm volatile("v_cvt_pk_bf16_f32 %0, %1, %2" : "=v"(r) : "v"(lo), "v"(hi)); return r; }
struct EpiBf16 {
    static constexpr bool PERM = true, AFTER_DRAIN = false;
    bf16_t* O; int ldc;
    __device__ __forceinline__ void operator()(const f32x4 (&acc)[2][2][4][2], const Unit& u, int wr, int wc, int fr, int fq) const {
        const int row0 = u.pm * BM + wr * 64 + fr, col0 = u.pn * BM + wc * 32 + 8 * fq;
#pragma unroll
        for (int ai = 0; ai < 2; ++ai)
#pragma unroll
            for (int m = 0; m < 4; ++m) { bf16_t* rowp = O + (size_t)(row0 + ai * HALF + m * 16) * ldc + col0;
#pragma unroll
                for (int bj = 0; bj < 2; ++bj) { const f32x4 v0 = acc[ai][bj][m][0], v1 = acc[ai][bj][m][1];
                    u32x4 w; w.x = cvt_pk_bf16(v0[0], v0[1]); w.y = cvt_pk_bf16(v0[2], v0[3]); w.z = cvt_pk_bf16(v1[0], v1[1]); w.w = cvt_pk_bf16(v1[2], v1[3]);
                    *(u32x4*)(rowp + bj * HALF) = w; } }
    }
};
struct EpiGlu {
    static constexpr bool PERM = true, AFTER_DRAIN = false;
    const bf16_t* GY; bf16_t* MIX; const float* bias;
    __device__ __forceinline__ void operator()(const f32x4 (&acc)[2][2][4][2], const Unit& u, int wr, int wc, int fr, int fq) const {
        const int row0 = u.pm * BM + wr * 64 + fr, col0 = u.pn * BM + wc * 32 + 8 * fq;
#pragma unroll
        for (int bj = 0; bj < 2; ++bj) { const int col = col0 + bj * HALF; const f32x4 b0 = *(const f32x4*)(bias + col), b1 = *(const f32x4*)(bias + col + 4);
#pragma unroll
            for (int ai = 0; ai < 2; ++ai)
#pragma unroll
                for (int m = 0; m < 4; ++m) { const size_t row = (size_t)(row0 + ai * HALF + m * 16);
                    const u32x4 g = *(const u32x4*)(GY + row * 512 + col); const f32x4 v0 = acc[ai][bj][m][0] + b0, v1 = acc[ai][bj][m][1] + b1;
                    u32x4 w; w.x = cvt_pk_bf16(bflo(g.x) * sigm(v0[0]), bfhi(g.x) * sigm(v0[1])); w.y = cvt_pk_bf16(bflo(g.y) * sigm(v0[2]), bfhi(g.y) * sigm(v0[3]));
                             w.z = cvt_pk_bf16(bflo(g.z) * sigm(v1[0]), bfhi(g.z) * sigm(v1[1])); w.w = cvt_pk_bf16(bflo(g.w) * sigm(v1[2]), bfhi(g.w) * sigm(v1[3]));
                    *(u32x4*)(MIX + row * 1024 + 512 + col) = w; } }
    }
};
struct EpiResid {
    static constexpr bool PERM = false, AFTER_DRAIN = false;
    const float* xa; const float* xb; float* out; const float* gate;
    static constexpr int MPROWS = 16384, NMODS = 8192;
    __device__ __forceinline__ void operator()(const f32x4 (&acc)[2][2][4][2], const Unit& u, int wr, int wc, int fr, int fq) const {
        const int row0 = u.pm * BM + wr * 64 + fr, col0 = u.pn * BM + wc * 32 + 4 * fq;
#pragma unroll
        for (int ai = 0; ai < 2; ++ai)
#pragma unroll
            for (int m = 0; m < 4; ++m) { const int row = row0 + ai * HALF + m * 16; const int s = row < MPROWS ? row / 2048 : 8 + (row - MPROWS) / 4;
                const float* res = row < MPROWS ? xa + (size_t)row * 1024 : xb + (size_t)(row - MPROWS) * 1024; const float* gp = gate + (size_t)s * NMODS; float* op = out + (size_t)row * 1024;
#pragma unroll
                for (int bj = 0; bj < 2; ++bj)
#pragma unroll
                    for (int n = 0; n < 2; ++n) { const int col = col0 + bj * HALF + n * 16; const f32x4 r = *(const f32x4*)(res + col), g = *(const f32x4*)(gp + col);
                        *(f32x4*)(op + col) = r + g * acc[ai][bj][m][n]; } }
    }
};
struct EpiSwiglu {
    static constexpr bool PERM = true, AFTER_DRAIN = false;
    bf16_t* Hf; int ldc;
    __device__ __forceinline__ void operator()(const f32x4 (&acc)[2][2][4][2], const Unit& u, int wr, int wc, int fr, int fq) const {
        const int row0 = u.pm * BM + wr * 64 + fr, col0 = u.pn * HALF + wc * 32 + 8 * fq;
#pragma unroll
        for (int ai = 0; ai < 2; ++ai)
#pragma unroll
            for (int m = 0; m < 4; ++m) { const f32x4 g0 = acc[ai][0][m][0], g1 = acc[ai][0][m][1], u0 = acc[ai][1][m][0], u1 = acc[ai][1][m][1];
                u32x4 w; w.x = cvt_pk_bf16(g0[0] * sigm(g0[0]) * u0[0], g0[1] * sigm(g0[1]) * u0[1]); w.y = cvt_pk_bf16(g0[2] * sigm(g0[2]) * u0[2], g0[3] * sigm(g0[3]) * u0[3]);
                         w.z = cvt_pk_bf16(g1[0] * sigm(g1[0]) * u1[0], g1[1] * sigm(g1[1]) * u1[1]); w.w = cvt_pk_bf16(g1[2] * sigm(g1[2]) * u1[2], g1[3] * sigm(g1[3]) * u1[3]);
                *(u32x4*)(Hf + (size_t)(row0 + ai * HALF + m * 16) * ldc + col0) = w; }
    }
};

template <class Epi, class Sched, bool ALIGN_EPI = false, bool SP2 = false>
__device__ __forceinline__ void gemm_phase(PG8_LAS unsigned char* lds, const Gemm g, const Sched& S, const Epi& E) {
    const int tid = threadIdx.x, wid = __builtin_amdgcn_readfirstlane(tid >> 6), lane = tid & 63, wr = wid >> 2, wc = wid & 3, fr = lane & 15, fq = lane >> 4;
    const int K = g.K, nt = K / BK;
    unsigned voffA[2], voffB[2];
#pragma unroll
    for (int i = 0; i < 2; ++i) { int R, C; stage_rc(tid * 16 + i * 8192, R, C); const int Rb = Epi::PERM ? ((R & ~31) + perm32(R & 31)) : R;
        voffA[i] = (unsigned)(R * K + C) * 2u; voffB[i] = (unsigned)(Rb * K + C) * 2u; }
    const size_t kstep = (size_t)(BK * 2);
    const size_t hstep = (size_t)HALF * K * 2;
    const size_t tstep = 2 * hstep;
    const unsigned ldsw = (unsigned)wid * 1024u;
    const int aoff = lds_byte(wr * 64 + fr, fq * 8), boff = lds_byte(wc * 32 + fr, fq * 8);
#define PG8_SA(b, h) (((b) * 2 + (h)) * HTB)
#define PG8_SB(b, h) ((4 + (b) * 2 + (h)) * HTB)
#define PG8_STAGE(bufoff, gbase, voff) do { _Pragma("unroll") for (int _i = 0; _i < 2; ++_i) \
        __builtin_amdgcn_global_load_lds((const unsigned*)((const char*)(gbase) + (voff)[_i]), (PG8_LAS unsigned*)(lds + (bufoff) + ldsw + _i * 8192), 16, 0, 0); } while (0)
#define PG8_LDA(dst, b, h) do { _Pragma("unroll") for (int m = 0; m < 4; ++m) _Pragma("unroll") for (int k = 0; k < 2; ++k) dst[m][k] = *(const PG8_LAS bf16x8*)(lds + PG8_SA(b, h) + aoff + m * 2048 + k * 1024); } while (0)
#define PG8_LDB(dst, b, h) do { _Pragma("unroll") for (int n = 0; n < 2; ++n) _Pragma("unroll") for (int k = 0; k < 2; ++k) dst[n][k] = *(const PG8_LAS bf16x8*)(lds + PG8_SB(b, h) + boff + n * 2048 + k * 1024); } while (0)
#define PG8_MMA(ai, bj, At, Bt) do { __builtin_amdgcn_s_setprio(1); _Pragma("unroll") for (int m = 0; m < 4; ++m) _Pragma("unroll") for (int n = 0; n < 2; ++n) _Pragma("unroll") for (int k = 0; k < 2; ++k) \
        acc[ai][bj][m][n] = __builtin_amdgcn_mfma_f32_16x16x32_bf16(Bt[n][k], At[m][k], acc[ai][bj][m][n], 0, 0, 0); __builtin_amdgcn_s_setprio(0); } while (0)
#define PG8_WAIT_V(n) asm volatile("s_waitcnt vmcnt(" #n ")" ::: "memory")
#define PG8_WAIT_L(n) asm volatile("s_waitcnt lgkmcnt(" #n ")" ::: "memory")
#define PG8_BAR __builtin_amdgcn_s_barrier()
#define PG8_SCHED __builtin_amdgcn_sched_barrier(0)
    Unit cur, nxt; int ui = 0;
    if (!S.next(0, cur)) return;
    f32x4 acc[2][2][4][2];
#pragma unroll
    for (int a = 0; a < 2; ++a)
#pragma unroll
        for (int b = 0; b < 2; ++b)
#pragma unroll
            for (int m = 0; m < 4; ++m)
#pragma unroll
                for (int n = 0; n < 2; ++n) acc[a][b][m][n] = (f32x4){0.f, 0.f, 0.f, 0.f};
    bf16x8 At[4][2], B0[2][2], B1[2][2];
    const char* cA = (const char*)g.A + (size_t)cur.pm * tstep; const char* cB = (const char*)g.Bt + (size_t)cur.pn * tstep;
    S.a_ready(cur);
    if constexpr (SP2) {
        PG8_STAGE(PG8_SB(0, 0), cB, voffB); PG8_STAGE(PG8_SB(0, 1), cB + hstep, voffB); PG8_STAGE(PG8_SA(0, 0), cA, voffA); PG8_STAGE(PG8_SA(0, 1), cA + hstep, voffA);
        if (wr == 1) PG8_BAR;
        PG8_WAIT_V(2); PG8_BAR;
        PG8_STAGE(PG8_SB(1, 0), cB + kstep, voffB); PG8_STAGE(PG8_SA(1, 0), cA + kstep, voffA); PG8_STAGE(PG8_SB(1, 1), cB + hstep + kstep, voffB);
        PG8_WAIT_V(6); PG8_BAR;
    } else {
        PG8_STAGE(PG8_SB(0, 0), cB, voffB); PG8_STAGE(PG8_SA(0, 0), cA, voffA); PG8_STAGE(PG8_SB(0, 1), cB + hstep, voffB); PG8_STAGE(PG8_SA(0, 1), cA + hstep, voffA);
        if (wr == 1) PG8_BAR;
        PG8_WAIT_V(4); PG8_BAR;
        PG8_STAGE(PG8_SB(1, 0), cB + kstep, voffB); PG8_STAGE(PG8_SA(1, 0), cA + kstep, voffA); PG8_STAGE(PG8_SB(1, 1), cB + hstep + kstep, voffB);
        PG8_WAIT_V(6); PG8_BAR;
    }
    for (;;) {
        const bool has_next = S.next(ui + 1, nxt);
        const char* nA = has_next ? (const char*)g.A + (size_t)nxt.pm * tstep : cA; const char* nB = has_next ? (const char*)g.Bt + (size_t)nxt.pn * tstep : cB;
        for (int t = 0; t < nt; t += 2) {
            const bool last = (t == nt - 2);
            const char* a1 = cA + (size_t)(t + 1) * kstep;
            const char* a2 = last ? nA : cA + (size_t)(t + 2) * kstep; const char* b2 = last ? nB : cB + (size_t)(t + 2) * kstep;
            const char* a3 = a2 + kstep; const char* b3 = b2 + kstep;
            if (last && has_next) S.a_ready(nxt);
            if constexpr (SP2) {
            PG8_LDB(B0, 0, 0); PG8_LDB(B1, 0, 1); PG8_SCHED; PG8_LDA(At, 0, 0); PG8_STAGE(PG8_SA(1, 1), a1 + hstep, voffA);
            PG8_WAIT_V(8); PG8_WAIT_L(0); PG8_BAR; PG8_MMA(0, 0, At, B0); PG8_MMA(0, 1, At, B1); PG8_BAR; PG8_SCHED;
            PG8_LDA(At, 0, 1); PG8_STAGE(PG8_SB(0, 0), b2, voffB); PG8_STAGE(PG8_SB(0, 1), b2 + hstep, voffB); PG8_STAGE(PG8_SA(0, 0), a2, voffA);
            PG8_WAIT_V(8); PG8_WAIT_L(0); PG8_BAR; PG8_MMA(1, 0, At, B0); PG8_MMA(1, 1, At, B1); PG8_BAR; PG8_SCHED;
            PG8_LDB(B0, 1, 0); PG8_LDB(B1, 1, 1); PG8_SCHED; PG8_LDA(At, 1, 0); PG8_STAGE(PG8_SA(0, 1), a2 + hstep, voffA);
            PG8_WAIT_V(8); PG8_WAIT_L(0); PG8_BAR; PG8_MMA(0, 0, At, B0); PG8_MMA(0, 1, At, B1); PG8_BAR; PG8_SCHED;
            PG8_LDA(At, 1, 1); PG8_STAGE(PG8_SB(1, 0), b3, voffB); PG8_STAGE(PG8_SB(1, 1), b3 + hstep, voffB); PG8_STAGE(PG8_SA(1, 0), a3, voffA);
            PG8_WAIT_V(8); PG8_WAIT_L(0); PG8_BAR; PG8_MMA(1, 0, At, B0); PG8_MMA(1, 1, At, B1); PG8_BAR; PG8_SCHED;
            } else {
            PG8_LDB(B0, 0, 0); PG8_SCHED; PG8_LDA(At, 0, 0); PG8_STAGE(PG8_SA(1, 1), a1 + hstep, voffA);
            PG8_WAIT_L(8); PG8_BAR; PG8_WAIT_L(0); PG8_MMA(0, 0, At, B0); PG8_BAR; PG8_SCHED;
            PG8_LDB(B1, 0, 1); PG8_STAGE(PG8_SB(0, 0), b2, voffB);
            PG8_BAR; PG8_WAIT_L(0); PG8_MMA(0, 1, At, B1); PG8_BAR;
            PG8_LDA(At, 0, 1); PG8_STAGE(PG8_SA(0, 0), a2, voffA);
            PG8_BAR; PG8_WAIT_L(0); PG8_MMA(1, 0, At, B0); PG8_BAR; PG8_SCHED;
            PG8_STAGE(PG8_SB(0, 1), b2 + hstep, voffB);
            PG8_WAIT_V(6); PG8_BAR; PG8_MMA(1, 1, At, B1); PG8_BAR;
            PG8_LDB(B0, 1, 0); PG8_SCHED; PG8_LDA(At, 1, 0); PG8_STAGE(PG8_SA(0, 1), a2 + hstep, voffA);
            PG8_WAIT_L(8); PG8_BAR; PG8_WAIT_L(0); PG8_MMA(0, 0, At, B0); PG8_BAR; PG8_SCHED;
            PG8_LDB(B1, 1, 1); PG8_STAGE(PG8_SB(1, 0), b3, voffB);
            PG8_BAR; PG8_WAIT_L(0); PG8_MMA(0, 1, At, B1); PG8_BAR;
            PG8_LDA(At, 1, 1); PG8_STAGE(PG8_SA(1, 0), a3, voffA);
            PG8_BAR; PG8_WAIT_L(0); PG8_MMA(1, 0, At, B0); PG8_BAR; PG8_SCHED;
            PG8_STAGE(PG8_SB(1, 1), b3 + hstep, voffB);
            PG8_WAIT_V(6); PG8_BAR; PG8_MMA(1, 1, At, B1); PG8_BAR;
            }
        }
        if constexpr (ALIGN_EPI) { if (wr == 0) PG8_BAR; }
        if constexpr (!Epi::AFTER_DRAIN) { E(acc, cur, wr, wc, fr, fq); S.done(cur); }
        if (!has_next) break;
#pragma unroll
        for (int a = 0; a < 2; ++a)
#pragma unroll
            for (int b = 0; b < 2; ++b)
#pragma unroll
                for (int m = 0; m < 4; ++m)
#pragma unroll
                    for (int n = 0; n < 2; ++n) acc[a][b][m][n] = (f32x4){0.f, 0.f, 0.f, 0.f};
        cur = nxt; cA = nA; cB = nB; ++ui;
        if constexpr (ALIGN_EPI) { if (wr == 1) PG8_BAR; }
    }
    PG8_WAIT_V(0);
    if constexpr (!ALIGN_EPI) { if (wr == 0) PG8_BAR; }
    PG8_BAR;
    if constexpr (Epi::AFTER_DRAIN) { E.fused(acc, cur, wr, wc, fr, fq, lds, wid, lane); S.done(cur); }
#undef PG8_SA
#undef PG8_SB
#undef PG8_STAGE
#undef PG8_LDA
#undef PG8_LDB
#undef PG8_MMA
#undef PG8_WAIT_V
#undef PG8_WAIT_L
#undef PG8_BAR
#undef PG8_SCHED
}
}
#define LAS __attribute__((address_space(3)))
typedef unsigned v4u __attribute__((ext_vector_type(4)));
typedef float f32x4 __attribute__((ext_vector_type(4)));
typedef float f32x2 __attribute__((ext_vector_type(2)));
typedef unsigned u32x2 __attribute__((ext_vector_type(2)));
typedef short bf16x8 __attribute__((ext_vector_type(8)));
constexpr int NWAVES = 8, NTHR = 512;
constexpr int LDS_BYTES = 147456;
#define LDS_WAIT() asm volatile("s_waitcnt lgkmcnt(0)" ::: "memory")

struct Args { const float* in[36]; float* out; unsigned char* ws; int ph_lo, ph_hi, flags, pad; };
enum { I_XP = 0, I_XS, I_CP, I_CS, I_SSSD, I_SCONV, I_SRE, I_SIM, I_WADA, I_BADA, I_N1G, I_WIN, I_CONVW, I_CONVB, I_DTB, I_ALOG, I_SSDD, I_SSDNG, I_ARE, I_AIM, I_LSTEP, I_BRE, I_BIM,
       I_CRE, I_CIM, I_S5D, I_WGLU, I_BGLU, I_WOUT, I_N2G, I_WGATE, I_WUP, I_WDOWN, I_WADAF, I_BADAF, I_NFG };

__device__ __forceinline__ float wave_sum(float v) {
#pragma unroll
    for (int o = 1; o < 64; o <<= 1) v += __shfl_xor(v, o);
    return v;
}
__device__ __forceinline__ void transpose_item(const float* W, int ldw, int col0, int k0, bf16* WT, int row0, int K, LAS float* scr, int lane) {
#pragma unroll 8
    for (int i = 0; i < 32; ++i) { const int kk = 2 * i + (lane >> 5); scr[kk * 33 + (lane & 31)] = W[(size_t)(k0 + kk) * ldw + col0 + (lane & 31)]; }
    LDS_WAIT();
    const int c = lane & 7;
#pragma unroll
    for (int j = 0; j < 4; ++j) { const int n = (lane >> 3) + 8 * j; const LAS float* s = scr + (8 * c) * 33 + n;
        v4u o; o.x = pk2(s[0 * 33], s[1 * 33]); o.y = pk2(s[2 * 33], s[3 * 33]); o.z = pk2(s[4 * 33], s[5 * 33]); o.w = pk2(s[6 * 33], s[7 * 33]);
        *(v4u*)(WT + (size_t)(row0 + n) * K + k0 + 8 * c) = o; }
    LDS_WAIT();
}

__device__ __forceinline__ void phase_prep(const Args& a, LAS unsigned char* lds, int tid, int lane, int wave) {
    unsigned char* ws = a.ws;
    LAS float* scr = (LAS float*)(lds + wave * 16384);
    const int gw = blockIdx.x * NWAVES + wave, NGW = gridDim.x * NWAVES;
    constexpr int I0 = 16 * 64, I1 = 8 * 16, I2 = 16 * 32, I3 = 16 * 176, I4 = 44 * 32, NIT = I0 + I1 + I2 + I3 + I4;
    for (int it = gw; it < NIT; it += NGW) {
        int r = it;
        if (r < I0) { const int kb = r / 64, nb = r % 64; transpose_item(a.in[I_WIN], INP, 32 * nb + (nb >= 48 ? 8 : 0), 64 * kb, (bf16*)(ws + WS_WIN), 32 * nb, 1024, scr, lane); continue; } r -= I0;
        if (r < I1) { const int kb = r / 16, nb = r % 16; transpose_item(a.in[I_WGLU], 512, 32 * nb, 64 * kb, (bf16*)(ws + WS_WGLU), 32 * nb, 512, scr, lane); continue; } r -= I1;
        if (r < I2) { const int kb = r / 32, nb = r % 32; transpose_item(a.in[I_WOUT], 1024, 32 * nb, 64 * kb, (bf16*)(ws + WS_WOUT), 32 * nb, 1024, scr, lane); continue; } r -= I2;
        if (r < I3) { const int kb = r / 176, nb = r % 176, tile = nb >> 3, sub = nb & 7;
                      transpose_item(sub < 4 ? a.in[I_WGATE] : a.in[I_WUP], DFF, 128 * tile + 32 * (sub & 3), 64 * kb, (bf16*)(ws + WS_WUP), 32 * nb, 1024, scr, lane); continue; } r -= I3;
        { const int kb = r / 32, nb = r % 32; transpose_item(a.in[I_WDOWN], 1024, 32 * nb, 64 * kb, (bf16*)(ws + WS_WDOWN), 32 * nb, DFF, scr, lane); }
    }
    { const int gp = blockIdx.x * NTHR + tid;
      if (gp < G5 * P5) { const int g = gp / P5, p = gp % P5;
        const float lr = a.in[I_ARE][gp], li = a.in[I_AIM][gp], step = expf(a.in[I_LSTEP][g]);
        const float mag = expf(lr * step), abr = mag * cosf(li * step), abi = mag * sinf(li * step);
        const float nr = abr - 1.f, ni = abi, den = lr * lr + li * li, fr = (nr * lr + ni * li) / den, fi = (ni * lr - nr * li) / den;
        float* AB = (float*)(ws + WS_AB); AB[2 * gp] = abr; AB[2 * gp + 1] = abi;
        float pr = abr, pi = abi;
#pragma unroll
        for (int q = 0; q < 7; ++q) { const float t = pr * pr - pi * pi; pi = 2.f * pr * pi; pr = t; }
        AB[2 * G5 * P5 + 2 * gp] = pr; AB[2 * G5 * P5 + 2 * gp + 1] = pi;
        bf16* BB = (bf16*)(ws + WS_BB) + ((size_t)g * 128 + 2 * p) * 16; bf16* CC = (bf16*)(ws + WS_CC) + (size_t)g * 16 * 128 + 2 * p;
        for (int c = 0; c < CH5; ++c) { const float br = a.in[I_BRE][(size_t)gp * CH5 + c], bi = a.in[I_BIM][(size_t)gp * CH5 + c];
            BB[c] = (bf16)f2bf(fr * br - fi * bi); BB[16 + c] = (bf16)f2bf(fr * bi + fi * br);
            CC[c * 128] = (bf16)f2bf(a.in[I_CRE][((size_t)g * CH5 + c) * P5 + p]); CC[c * 128 + 1] = (bf16)f2bf(-a.in[I_CIM][((size_t)g * CH5 + c) * P5 + p]); } } }
    __syncthreads();
    for (int wb = blockIdx.x; wb < NMOD / 32; wb += gridDim.x) {
        const int j0 = 32 * wb; const bool fin = j0 >= 6144; const float* W = fin ? a.in[I_WADAF] : a.in[I_WADA]; const int ldw = fin ? 2048 : 6144, jc = fin ? j0 - 6144 : j0;
        const float* bias = (fin ? a.in[I_BADAF] : a.in[I_BADA]) + jc;
        const int kq = wave & 3, nt = wave >> 2, fr = lane & 15, fq = lane >> 4;
        f32x4 acc[9];
#pragma unroll
        for (int mt = 0; mt < 9; ++mt) acc[mt] = (f32x4){0.f, 0.f, 0.f, 0.f};
        for (int kk = 0; kk < 8; ++kk) {
            const int k0 = 256 * kq + 32 * kk + 8 * fq;
            bf16x8 bfr;
#pragma unroll
            for (int j = 0; j < 8; ++j) bfr[j] = (short)f2bf(W[(size_t)(k0 + j) * ldw + jc + 16 * nt + fr]);
#pragma unroll
            for (int mt = 0; mt < 9; ++mt) { const int s = 16 * mt + fr; bf16x8 afr;
                if (s < NSEQ) { const float* c = (s < NP ? a.in[I_CP] + (size_t)s * D : a.in[I_CS] + (size_t)(s - NP) * D) + k0;
                    const f32x4 c0 = *(const f32x4*)c, c1 = *(const f32x4*)(c + 4);
#pragma unroll
                    for (int j = 0; j < 4; ++j) { afr[j] = (short)f2bf(siluf(c0[j])); afr[4 + j] = (short)f2bf(siluf(c1[j])); } }
                else {
#pragma unroll
                    for (int j = 0; j < 8; ++j) afr[j] = 0; }
                acc[mt] = __builtin_amdgcn_mfma_f32_16x16x32_bf16(afr, bfr, acc[mt], 0, 0, 0); }
        }
        LAS float* part = (LAS float*)lds;
#pragma unroll
        for (int mt = 0; mt < 9; ++mt)
#pragma unroll
            for (int r = 0; r < 4; ++r) part[((kq * 2 + nt) * 144 + 16 * mt + 4 * fq + r) * 16 + fr] = acc[mt][r];
        __syncthreads();
        for (int e = tid; e < NSEQ * 32; e += NTHR) { const int s = e >> 5, c = e & 31, ntt = c >> 4, cc = c & 15; float v = bias[c];
#pragma unroll
            for (int q = 0; q < 4; ++q) v += part[((q * 2 + ntt) * 144 + s) * 16 + cc];
            ((float*)(ws + WS_MOD))[(size_t)s * NMOD + j0 + c] = v; }
        __syncthreads();
    }
}

template <int MODE> __device__ __forceinline__ void phase_modnorm(const Args& a, LAS unsigned char* lds, int tid, int lane, int wave) {
    unsigned char* ws = a.ws; const float* mod = (const float*)(ws + WS_MOD);
    const int sh_off = MODE == 0 ? 0 : (MODE == 1 ? 3072 : 6144), sc_off = sh_off + 1024;
    const float* gam = a.in[MODE == 0 ? I_N1G : (MODE == 1 ? I_N2G : I_NFG)];
    LAS float* wdt = (LAS float*)lds;
    if (MODE == 0) { for (int e = tid; e < 8192; e += NTHR) { const int k = e >> 3, h = e & 7; wdt[h * 1024 + k] = a.in[I_WIN][(size_t)k * INP + O2 + h]; } __syncthreads(); }
    const int gw = blockIdx.x * NWAVES + wave, NGW = gridDim.x * NWAVES;
    for (int row = gw; row < M; row += NGW) {
        const int s = seq_of_row(row);
        const float* x = MODE == 0 ? (row < MP ? a.in[I_XP] + (size_t)row * D : a.in[I_XS] + (size_t)(row - MP) * D) : a.out + OUT_Y + (size_t)row * D;
        f32x4 v[4]; float ss = 0.f;
#pragma unroll
        for (int j = 0; j < 4; ++j) { v[j] = *(const f32x4*)(x + 4 * lane + 256 * j); ss += (v[j][0] * v[j][0] + v[j][1] * v[j][1]) + (v[j][2] * v[j][2] + v[j][3] * v[j][3]); }
        const float inv = rsqrtf(wave_sum(ss) * (1.f / D) + EPS);
        const float* ms = mod + (size_t)s * NMOD;
#pragma unroll
        for (int j = 0; j < 4; ++j) { const int c = 4 * lane + 256 * j; const f32x4 g = *(const f32x4*)(gam + c), sc = *(const f32x4*)(ms + sc_off + c), sh = *(const f32x4*)(ms + sh_off + c);
            v[j] = v[j] * inv * g * (sc + 1.f) + sh; }
        if (MODE == 2) {
#pragma unroll
            for (int j = 0; j < 4; ++j) *(f32x4*)(a.out + OUT_Y + (size_t)row * D + 4 * lane + 256 * j) = v[j];
        } else {
            bf16* o = (bf16*)(ws + WS_U) + (size_t)row * D;
#pragma unroll
            for (int j = 0; j < 4; ++j) { u32x2 w; w.x = pk2(v[j][0], v[j][1]); w.y = pk2(v[j][2], v[j][3]); *(u32x2*)(o + 4 * lane + 256 * j) = w; }
        }
        if (MODE == 0) {
            float mine = 0.f;
#pragma unroll
            for (int h = 0; h < 8; ++h) { float d = 0.f;
#pragma unroll
                for (int j = 0; j < 4; ++j) { const f32x4 w = *(const LAS f32x4*)(wdt + h * 1024 + 4 * lane + 256 * j); d += (v[j][0] * w[0] + v[j][1] * w[1]) + (v[j][2] * w[2] + v[j][3] * w[3]); }
                d = wave_sum(d); if (lane == h) mine = d; }
            if (lane < 8) ((float*)(ws + WS_DT))[(size_t)row * 8 + lane] = mine;
        }
    }
}

constexpr int PT = 136;
typedef float f32x16 __attribute__((ext_vector_type(16)));
__device__ __forceinline__ f32x4 mfma16(bf16x8 a, bf16x8 b, f32x4 c) { return __builtin_amdgcn_mfma_f32_16x16x32_bf16(a, b, c, 0, 0, 0); }
__device__ __forceinline__ bf16x8 ldfrag(const LAS bf16* base, int row, int k) { return *(const LAS bf16x8*)(base + row * PT + k); }
__device__ __forceinline__ float fsilu(float v) { return v * __builtin_amdgcn_rcpf(1.f + __expf(-v)); }

struct ConvPair {
    float w0[4], w1[4], b0, b1, h0[3], h1[3];
    __device__ __forceinline__ void init(const Args& a, int ch) {
#pragma unroll
        for (int k = 0; k < 4; ++k) { const f32x2 w = *(const f32x2*)(a.in[I_CONVW] + k * CONVD + ch); w0[k] = w.x; w1[k] = w.y; }
        const f32x2 b = *(const f32x2*)(a.in[I_CONVB] + ch); b0 = b.x; b1 = b.y;
    }
    __device__ __forceinline__ void hist(int i, unsigned pr) { h0[i] = bflo(pr); h1[i] = bfhi(pr); }
    __device__ __forceinline__ void step(unsigned pr, float& o0, float& o1) {
        const float x0 = bflo(pr), x1 = bfhi(pr);
        o0 = fsilu(b0 + w0[0] * h0[0] + w0[1] * h0[1] + w0[2] * h0[2] + w0[3] * x0);
        o1 = fsilu(b1 + w1[0] * h1[0] + w1[1] * h1[1] + w1[2] * h1[2] + w1[3] * x1);
        h0[0] = h0[1]; h0[1] = h0[2]; h0[2] = x0; h1[0] = h1[1]; h1[1] = h1[2]; h1[2] = x1;
    }
};

__device__ __forceinline__ void ssd_pass1_unit(const Args& a, LAS unsigned char* lds, int tid, int lane, int wave, int b, int c, int g) {
    unsigned char* ws = a.ws;
    const bf16* PROJ = (const bf16*)(ws + WS_PROJ); bf16* XC = (bf16*)(ws + WS_XC);
    const int r0 = b * LP + c * 128, fr = lane & 15, fq = lane >> 4;
    LAS bf16* Bn = (LAS bf16*)lds;
    LAS bf16* Cn = Bn + 128 * PT;
    LAS bf16* Xt = (LAS bf16*)lds;
    LAS bf16* Bt = (LAS bf16*)(lds + 69632);
    LAS float* sAcs = (LAS float*)(lds + 104448);
    LAS float* sW = sAcs + 512;
    if (wave < 4) {
        const int h = 4 * g + wave; const float A = -expf(a.in[I_ALOG][h]), bias = a.in[I_DTB][h];
        const float* dtr = (const float*)(ws + WS_DT);
        const float d0 = softplusf(dtr[(size_t)(r0 + lane) * 8 + h] + bias), d1 = softplusf(dtr[(size_t)(r0 + 64 + lane) * 8 + h] + bias);
        float s0 = d0 * A, s1 = d1 * A;
#pragma unroll
        for (int o = 1; o < 64; o <<= 1) { const float t0 = __shfl_up(s0, o), t1 = __shfl_up(s1, o); if (lane >= o) { s0 += t0; s1 += t1; } }
        s1 += __shfl(s0, 63); const float last = __shfl(s1, 63);
        sAcs[wave * 128 + lane] = s0; sAcs[wave * 128 + 64 + lane] = s1;
        sW[wave * 128 + lane] = d0 * expf(last - s0); sW[wave * 128 + 64 + lane] = d1 * expf(last - s1);
        float* rec = (float*)(ws + WS_ACS) + ((size_t)(b * 16 + c) * H + h) * 256;
        rec[lane] = s0; rec[64 + lane] = s1; rec[128 + lane] = d0; rec[192 + lane] = d1;
    }
    {
        const int cp = tid & 127, tr = tid >> 7, c2 = 2 * cp;
        const int ch = c2 < 128 ? DSSD + NST * g + c2 : DSSD + NG * NST + NST * g + (c2 - 128);
        ConvPair cv; cv.init(a, ch);
        const bf16* src = PROJ + (size_t)(r0 + 32 * tr) * NPROJ + O1 + ch;
        if (c == 0 && tr == 0) { cv.hist(0, 0u); cv.hist(1, 0u); cv.hist(2, 0u); }
        else {
#pragma unroll
            for (int i = 0; i < 3; ++i) cv.hist(i, *(const unsigned*)(src + (ptrdiff_t)(i - 3) * NPROJ)); }
        LAS bf16* nat = c2 < 128 ? Bn + c2 : Cn + (c2 - 128);
        for (int blk = 0; blk < 4; ++blk) {
            unsigned pr[8]; float o0[8], o1[8];
#pragma unroll
            for (int i = 0; i < 8; ++i) pr[i] = *(const unsigned*)(src + (size_t)(8 * blk + i) * NPROJ);
#pragma unroll
            for (int i = 0; i < 8; ++i) cv.step(pr[i], o0[i], o1[i]);
            const int l0 = 32 * tr + 8 * blk;
#pragma unroll
            for (int i = 0; i < 8; ++i) *(LAS unsigned*)(nat + (l0 + i) * PT) = pk2(o0[i], o1[i]);
            if (c2 >= 128) {
#pragma unroll
                for (int i = 0; i < 8; ++i) *(unsigned*)(XC + (size_t)(r0 + l0 + i) * CONVD + ch) = pk2(o0[i], o1[i]);
            } else {
                v4u t0, t1; t0.x = pk2(o0[0], o0[1]); t0.y = pk2(o0[2], o0[3]); t0.z = pk2(o0[4], o0[5]); t0.w = pk2(o0[6], o0[7]);
                t1.x = pk2(o1[0], o1[1]); t1.y = pk2(o1[2], o1[3]); t1.z = pk2(o1[4], o1[5]); t1.w = pk2(o1[6], o1[7]);
                *(LAS v4u*)(Bt + c2 * PT + l0) = t0; *(LAS v4u*)(Bt + (c2 + 1) * PT + l0) = t1;
            }
        }
    }
    __syncthreads();
    {
        bf16x8 cf[4];
#pragma unroll
        for (int kk = 0; kk < 4; ++kk) cf[kk] = ldfrag(Cn, 16 * wave + fr, 32 * kk + 8 * fq);
        bf16* Gg = (bf16*)(ws + WS_G) + (size_t)((b * 16 + c) * NG + g) * 128 * 128;
        for (int st = 0; st <= wave; ++st) {
            f32x4 acc = (f32x4){0.f, 0.f, 0.f, 0.f};
#pragma unroll
            for (int kk = 0; kk < 4; ++kk) acc = mfma16(ldfrag(Bn, 16 * st + fr, 32 * kk + 8 * fq), cf[kk], acc);
            u32x2 w; w.x = pk2(acc[0], acc[1]); w.y = pk2(acc[2], acc[3]);
            *(u32x2*)(Gg + (size_t)(16 * wave + fr) * 128 + 16 * st + 4 * fq) = w;
        }
    }
    __syncthreads();
    {
        const int cp = tid & 127, tr = tid >> 7, c2 = 2 * cp, ch = 256 * g + c2, hh = c2 >> 6;
        ConvPair cv; cv.init(a, ch);
        const bf16* src = PROJ + (size_t)(r0 + 32 * tr) * NPROJ + O1 + ch;
        if (c == 0 && tr == 0) { cv.hist(0, 0u); cv.hist(1, 0u); cv.hist(2, 0u); }
        else {
#pragma unroll
            for (int i = 0; i < 3; ++i) cv.hist(i, *(const unsigned*)(src + (ptrdiff_t)(i - 3) * NPROJ)); }
        for (int blk = 0; blk < 4; ++blk) {
            unsigned pr[8]; float o0[8], o1[8];
#pragma unroll
            for (int i = 0; i < 8; ++i) pr[i] = *(const unsigned*)(src + (size_t)(8 * blk + i) * NPROJ);
#pragma unroll
            for (int i = 0; i < 8; ++i) cv.step(pr[i], o0[i], o1[i]);
            const int l0 = 32 * tr + 8 * blk;
#pragma unroll
            for (int i = 0; i < 8; ++i) *(unsigned*)(XC + (size_t)(r0 + l0 + i) * CONVD + ch) = pk2(o0[i], o1[i]);
            const f32x4 wa = *(const LAS f32x4*)(sW + hh * 128 + l0), wb = *(const LAS f32x4*)(sW + hh * 128 + l0 + 4);
            v4u t0, t1; t0.x = pk2(o0[0] * wa[0], o0[1] * wa[1]); t0.y = pk2(o0[2] * wa[2], o0[3] * wa[3]); t0.z = pk2(o0[4] * wb[0], o0[5] * wb[1]); t0.w = pk2(o0[6] * wb[2], o0[7] * wb[3]);
            t1.x = pk2(o1[0] * wa[0], o1[1] * wa[1]); t1.y = pk2(o1[2] * wa[2], o1[3] * wa[3]); t1.z = pk2(o1[4] * wb[0], o1[5] * wb[1]); t1.w = pk2(o1[6] * wb[2], o1[7] * wb[3]);
            *(LAS v4u*)(Xt + c2 * PT + l0) = t0; *(LAS v4u*)(Xt + (c2 + 1) * PT + l0) = t1;
        }
    }
    __syncthreads();
    {
        const int hh = wave >> 1, nt0 = 4 * (wave & 1);
        f32x4 acc[4][4];
#pragma unroll
        for (int i = 0; i < 4; ++i)
#pragma unroll
            for (int j = 0; j < 4; ++j) acc[i][j] = (f32x4){0.f, 0.f, 0.f, 0.f};
#pragma unroll
        for (int kk = 0; kk < 4; ++kk) { bf16x8 bfr[4], xfr[4];
#pragma unroll
            for (int i = 0; i < 4; ++i) { bfr[i] = ldfrag(Bt, 16 * (nt0 + i) + fr, 32 * kk + 8 * fq); xfr[i] = ldfrag(Xt, 64 * hh + 16 * i + fr, 32 * kk + 8 * fq); }
#pragma unroll
            for (int i = 0; i < 4; ++i)
#pragma unroll
                for (int j = 0; j < 4; ++j) acc[i][j] = mfma16(bfr[i], xfr[j], acc[i][j]); }
        float* CSp = (float*)(ws + WS_CS) + ((size_t)((b * 16 + c) * H + 4 * g + hh)) * PD * NST;
#pragma unroll
        for (int i = 0; i < 4; ++i)
#pragma unroll
            for (int j = 0; j < 4; ++j) *(f32x4*)(CSp + (size_t)(16 * j + fr) * NST + 16 * (nt0 + i) + 4 * fq) = acc[i][j];
    }
    __syncthreads();
}

__device__ __forceinline__ void ssd_sample_unit(const Args& a, LAS unsigned char* lds, int tid, int lane, int wave, int bs, int g) {
    unsigned char* ws = a.ws; const bf16* PROJ = (const bf16*)(ws + WS_PROJ);
    const int r0 = MP + 4 * bs;
    LAS float* sx = (LAS float*)lds;
    LAS float* sB = sx + 1024;
    LAS float* sC = sB + 512;
    LAS float* sdt = sC + 512;
    LAS float* yp = sdt + 32;
    LAS float* red = yp + 2048;
    {   const int idx = tid, ch = idx < 256 ? 256 * g + idx : (idx < 384 ? DSSD + NST * g + (idx - 256) : DSSD + NG * NST + NST * g + (idx - 384));
        float w[4], hs[7];
#pragma unroll
        for (int k = 0; k < 4; ++k) w[k] = a.in[I_CONVW][k * CONVD + ch];
        const float bb = a.in[I_CONVB][ch];
#pragma unroll
        for (int i = 0; i < 3; ++i) hs[i] = a.in[I_SCONV][((size_t)bs * 3 + i) * CONVD + ch];
#pragma unroll
        for (int i = 0; i < 4; ++i) hs[3 + i] = bf2f(PROJ[(size_t)(r0 + i) * NPROJ + O1 + ch]);
#pragma unroll
        for (int t = 0; t < 4; ++t) { const float v = fsilu(bb + w[0] * hs[t] + w[1] * hs[t + 1] + w[2] * hs[t + 2] + w[3] * hs[t + 3]);
            if (idx < 256) sx[t * 256 + idx] = v; else if (idx < 384) sB[t * 128 + idx - 256] = v; else sC[t * 128 + idx - 384] = v; }
    }
    if (tid < 16) { const int t = tid >> 2, hh = tid & 3, h = 4 * g + hh; const float dt = softplusf(((const float*)(ws + WS_DT))[(size_t)(r0 + t) * 8 + h] + a.in[I_DTB][h]);
        sdt[t * 4 + hh] = dt; sdt[16 + t * 4 + hh] = expf(-dt * expf(a.in[I_ALOG][h])); }
    __syncthreads();
    {   const int hh = wave >> 1, nh = wave & 1, h = 4 * g + hh, p = lane;
        const float* s0 = a.in[I_SSSD] + (((size_t)bs * H + h) * PD + p) * NST + 64 * nh;
        f32x4 st[16];
#pragma unroll
        for (int j = 0; j < 16; ++j) st[j] = *(const f32x4*)(s0 + 4 * j);
#pragma unroll
        for (int t = 0; t < 4; ++t) { const float dA = sdt[16 + t * 4 + hh], dx = sdt[t * 4 + hh] * sx[t * 256 + 64 * hh + p]; float y = 0.f;
#pragma unroll
            for (int j = 0; j < 16; ++j) { const f32x4 Bv = *(const LAS f32x4*)(sB + t * 128 + 64 * nh + 4 * j), Cv = *(const LAS f32x4*)(sC + t * 128 + 64 * nh + 4 * j);
                st[j] = st[j] * dA + Bv * dx; y += (Cv[0] * st[j][0] + Cv[1] * st[j][1]) + (Cv[2] * st[j][2] + Cv[3] * st[j][3]); }
            yp[(nh * 4 + t) * 256 + 64 * hh + p] = y; }
        float* o = a.out + OUT_SSDS + (((size_t)bs * H + h) * PD + p) * NST + 64 * nh;
#pragma unroll
        for (int j = 0; j < 16; ++j) *(f32x4*)(o + 4 * j) = st[j];
    }
    __syncthreads();
    {   const int ch = tid & 255, t0 = tid >> 8; float v[2];
#pragma unroll
        for (int i = 0; i < 2; ++i) { const int t = t0 + 2 * i; const float y = yp[t * 256 + ch] + yp[(4 + t) * 256 + ch] + a.in[I_SSDD][4 * g + (ch >> 6)] * sx[t * 256 + ch];
            v[i] = y * fsilu(bf2f(PROJ[(size_t)(r0 + t) * NPROJ + 256 * g + ch])); }
        const float q0 = wave_sum(v[0] * v[0]), q1 = wave_sum(v[1] * v[1]);
        if (lane == 0) { red[wave * 2] = q0; red[wave * 2 + 1] = q1; }
        __syncthreads();
        const int wb = (wave >> 2) * 4; const float ngv = a.in[I_SSDNG][256 * g + ch];
#pragma unroll
        for (int i = 0; i < 2; ++i) { const float tot = (red[(wb + 0) * 2 + i] + red[(wb + 1) * 2 + i]) + (red[(wb + 2) * 2 + i] + red[(wb + 3) * 2 + i]);
            ((bf16*)(ws + WS_MIX))[(size_t)(r0 + t0 + 2 * i) * D + 256 * g + ch] = (bf16)f2bf(v[i] * rsqrtf(tot * (1.f / 256.f) + EPS) * ngv); }
    }
    __syncthreads();
}

template <int MODE> __device__ __forceinline__ void s5_unit(const Args& a, LAS unsigned char* ldsw, int lane, int unit) {
    unsigned char* ws = a.ws; const bf16* PROJ = (const bf16*)(ws + WS_PROJ);
    const int g = unit & 31, q = unit >> 5;
    const int b = q >> 4, c = q & 15;
    const int row0 = MODE == 2 ? MP + 32 * q : b * LP + 128 * c, nsub = MODE == 2 ? 1 : 4;
    const float* AB = (const float*)(ws + WS_AB);
    const float abr = AB[2 * (g * P5 + lane)], abi = AB[2 * (g * P5 + lane) + 1];
    LAS float* BUs = (LAS float*)ldsw;
    bf16x8 bfr[4];
#pragma unroll
    for (int cb = 0; cb < 4; ++cb) bfr[cb] = *(const bf16x8*)((const bf16*)(ws + WS_BB) + ((size_t)g * 128 + 32 * cb + (lane & 31)) * 16 + 8 * (lane >> 5));
    bf16x8 cfr[4];
    if (MODE >= 1) {
#pragma unroll
        for (int kk = 0; kk < 4; ++kk) cfr[kk] = *(const bf16x8*)((const bf16*)(ws + WS_CC) + ((size_t)g * 16 + (lane & 15)) * 128 + 32 * kk + 8 * (lane >> 4)); }
    float hr = 0.f, hi = 0.f;
    if (MODE == 1) { const float pr = AB[2 * G5 * P5 + 2 * (g * P5 + lane)], pi = AB[2 * G5 * P5 + 2 * (g * P5 + lane) + 1];
        for (int cc = 0; cc < c; ++cc) { const f32x2 e = *(const f32x2*)((const float*)(ws + WS_S5E) + ((size_t)((b * 16 + cc) * G5 + g)) * 128 + 2 * lane);
            const float nr = pr * hr - pi * hi + e.x, ni = pr * hi + pi * hr + e.y; hr = nr; hi = ni; } }
    for (int sub = 0; sub < nsub; ++sub) {
        const int rb = row0 + 32 * sub;
        const bf16x8 afr = *(const bf16x8*)(PROJ + (size_t)(rb + (lane & 31)) * NPROJ + 1536 + 16 * g + 8 * (lane >> 5));
#pragma unroll
        for (int cb = 0; cb < 4; ++cb) { f32x16 d;
#pragma unroll
            for (int i = 0; i < 16; ++i) d[i] = 0.f;
            d = __builtin_amdgcn_mfma_f32_32x32x16_bf16(afr, bfr[cb], d, 0, 0, 0);
#pragma unroll
            for (int i = 0; i < 16; ++i) BUs[((i & 3) + 8 * (i >> 2) + 4 * (lane >> 5)) * 132 + 32 * cb + (lane & 31)] = d[i]; }
        LDS_WAIT();
#pragma unroll 4
        for (int t = 0; t < 32; ++t) {
            if (MODE == 2 && (t & 3) == 0) { const int bs = (rb - MP + t) >> 2; hr = a.in[I_SRE][((size_t)bs * G5 + g) * P5 + lane]; hi = a.in[I_SIM][((size_t)bs * G5 + g) * P5 + lane]; }
            const f32x2 bu = *(const LAS f32x2*)(BUs + t * 132 + 2 * lane);
            const float nr = abr * hr - abi * hi + bu.x, ni = abr * hi + abi * hr + bu.y; hr = nr; hi = ni;
            if (MODE >= 1) *(LAS unsigned*)((LAS bf16*)(BUs + t * 132) + 2 * lane) = pk2(hr, hi);
            if (MODE == 2 && (t & 3) == 3) { const int bs = (rb - MP + t) >> 2; a.out[OUT_RES + ((size_t)bs * G5 + g) * P5 + lane] = hr; a.out[OUT_IMS + ((size_t)bs * G5 + g) * P5 + lane] = hi; }
        }
        if (MODE >= 1) {
            LDS_WAIT();
            const int fr = lane & 15, fq = lane >> 4;
#pragma unroll
            for (int tt = 0; tt < 2; ++tt) { f32x4 y = (f32x4){0.f, 0.f, 0.f, 0.f};
#pragma unroll
                for (int kk = 0; kk < 4; ++kk) y = mfma16(cfr[kk], *(const LAS bf16x8*)((const LAS bf16*)(BUs + (16 * tt + fr) * 132) + 32 * kk + 8 * fq), y);
                const int row = rb + 16 * tt + fr, co = 16 * g + 4 * fq;
                const u32x2 uu = *(const u32x2*)(PROJ + (size_t)row * NPROJ + 1536 + co); const f32x4 dk = *(const f32x4*)(a.in[I_S5D] + co);
                float v[4] = {y[0] + dk[0] * bflo(uu.x), y[1] + dk[1] * bfhi(uu.x), y[2] + dk[2] * bflo(uu.y), y[3] + dk[3] * bfhi(uu.y)};
#pragma unroll
                for (int r = 0; r < 4; ++r) v[r] = 0.5f * v[r] * (1.f + erff(v[r] * 0.70710678118654752f));
                u32x2 w; w.x = pk2(v[0], v[1]); w.y = pk2(v[2], v[3]);
                *(u32x2*)((bf16*)(ws + WS_GY) + (size_t)row * DS5 + co) = w; }
            LDS_WAIT();
        }
    }
    if (MODE == 0) { f32x2 e; e.x = hr; e.y = hi; *(f32x2*)((float*)(ws + WS_S5E) + ((size_t)((b * 16 + c) * G5 + g)) * 128 + 2 * lane) = e; }
    if (MODE == 1 && c == 15) { a.out[OUT_REP + ((size_t)b * G5 + g) * P5 + lane] = hr; a.out[OUT_IMP + ((size_t)b * G5 + g) * P5 + lane] = hi; }
}

__device__ __forceinline__ void phase_mix1(const Args& a, LAS unsigned char* lds, int tid, int lane, int wave) {
    unsigned char* ws = a.ws;
    if (a.flags & 1) {
    for (int u = blockIdx.x; u < NP * 16 * NG; u += gridDim.x) ssd_pass1_unit(a, lds, tid, lane, wave, u >> 5, (u >> 1) & 15, u & 1);
    for (int u = blockIdx.x; u < NS * NG; u += gridDim.x) ssd_sample_unit(a, lds, tid, lane, wave, u >> 1, u & 1);
    }
    const int gw = blockIdx.x * NWAVES + wave, NGW = gridDim.x * NWAVES;
    LAS unsigned char* ldsw = lds + wave * 16896;
    if (a.flags & 2) {
    for (int u = gw; u < NP * 16 * G5; u += NGW) s5_unit<0>(a, ldsw, lane, u);
    for (int u = gw; u < (MS / 32) * G5; u += NGW) s5_unit<2>(a, ldsw, lane, u);
    }
    const bf16* PROJ = (const bf16*)(ws + WS_PROJ);
    for (int e = blockIdx.x * NTHR + tid; e < NSEQ * 3 * CONVD; e += gridDim.x * NTHR) {
        const int s = e / (3 * CONVD), i = (e / CONVD) % 3, ch = e % CONVD;
        const int row = s < NP ? s * LP + LP - 3 + i : MP + (s - NP) * LS + 1 + i;
        a.out[OUT_CONVP + e] = bf2f(PROJ[(size_t)row * NPROJ + O1 + ch]); }
    __syncthreads();
}
__device__ __forceinline__ void phase_chunkscan(const Args& a, int tid) {
    unsigned char* ws = a.ws; float* CS = (float*)(ws + WS_CS); const float* ACS = (const float*)(ws + WS_ACS);
    if (!(a.flags & 1)) return;
    for (int e = blockIdx.x * NTHR + tid; e < NP * H * PD * NST / 4; e += gridDim.x * NTHR) {
        const int b = e >> 14, h = (e >> 11) & 7, pn = e & 2047;
        f32x4 v[16]; float dec[16];
#pragma unroll
        for (int c = 0; c < 16; ++c) { v[c] = *(const f32x4*)(CS + ((size_t)((b * 16 + c) * H + h)) * 8192 + 4 * pn); dec[c] = expf(ACS[((size_t)(b * 16 + c) * H + h) * 256 + 127]); }
        f32x4 run = (f32x4){0.f, 0.f, 0.f, 0.f};
#pragma unroll
        for (int c = 0; c < 16; ++c) { *(f32x4*)(CS + ((size_t)((b * 16 + c) * H + h)) * 8192 + 4 * pn) = run; run = run * dec[c] + v[c]; }
        *(f32x4*)(a.out + OUT_SSDP + ((size_t)(b * H + h)) * 8192 + 4 * pn) = run;
    }
}
__device__ __forceinline__ void ssd_pass2_unit(const Args& a, LAS unsigned char* lds, int tid, int lane, int wave, int b, int c, int g) {
    unsigned char* ws = a.ws; const bf16* PROJ = (const bf16*)(ws + WS_PROJ); const bf16* XC = (const bf16*)(ws + WS_XC);
    const int r0 = b * LP + c * 128, fr = lane & 15, fq = lane >> 4;
    LAS bf16* Cn = (LAS bf16*)lds;
    LAS bf16* Gs = Cn + 128 * PT;
    LAS bf16* Xt = Gs + 128 * PT;
    LAS bf16* Ib = Xt + 64 * PT;
    LAS float* sAcs = (LAS float*)(Ib + 64 * PT);
    LAS float* sDt = sAcs + 512;
    const bf16* Gg = (const bf16*)(ws + WS_G) + (size_t)((b * 16 + c) * NG + g) * 128 * 128;
    for (int e = tid; e < 128 * 16; e += NTHR) { const int l = e >> 4, k8 = (e & 15) * 8;
        *(LAS v4u*)(Cn + l * PT + k8) = *(const v4u*)(XC + (size_t)(r0 + l) * CONVD + DSSD + NG * NST + NST * g + k8);
        *(LAS v4u*)(Gs + l * PT + k8) = *(const v4u*)(Gg + (size_t)l * 128 + k8); }
    for (int e = tid; e < 1024; e += NTHR) { const int hh = e >> 8, i = e & 255; sAcs[(i >> 7) * 512 + hh * 128 + (i & 127)] = ((const float*)(ws + WS_ACS))[((size_t)(b * 16 + c) * H + 4 * g + hh) * 256 + i]; }
    float ssq = 0.f;
    const int l = 16 * wave + fr, row = r0 + l;
    bf16* mixrow = (bf16*)(ws + WS_MIX) + (size_t)row * D + 256 * g;
#pragma unroll 1
    for (int hh = 0; hh < 4; ++hh) {
        __syncthreads();
        {   const int pp = tid & 31, sb = tid >> 5, chl = 64 * hh + 2 * pp; unsigned pr[8];
#pragma unroll
            for (int i = 0; i < 8; ++i) pr[i] = *(const unsigned*)(XC + (size_t)(r0 + 8 * sb + i) * CONVD + 256 * g + chl);
            const f32x4 da = *(const LAS f32x4*)(sDt + hh * 128 + 8 * sb), db = *(const LAS f32x4*)(sDt + hh * 128 + 8 * sb + 4);
            v4u t0, t1; t0.x = pk2(bflo(pr[0]) * da[0], bflo(pr[1]) * da[1]); t0.y = pk2(bflo(pr[2]) * da[2], bflo(pr[3]) * da[3]); t0.z = pk2(bflo(pr[4]) * db[0], bflo(pr[5]) * db[1]); t0.w = pk2(bflo(pr[6]) * db[2], bflo(pr[7]) * db[3]);
            t1.x = pk2(bfhi(pr[0]) * da[0], bfhi(pr[1]) * da[1]); t1.y = pk2(bfhi(pr[2]) * da[2], bfhi(pr[3]) * da[3]); t1.z = pk2(bfhi(pr[4]) * db[0], bfhi(pr[5]) * db[1]); t1.w = pk2(bfhi(pr[6]) * db[2], bfhi(pr[7]) * db[3]);
            *(LAS v4u*)(Xt + (2 * pp) * PT + 8 * sb) = t0; *(LAS v4u*)(Xt + (2 * pp + 1) * PT + 8 * sb) = t1;
            const float* CSp = (const float*)(ws + WS_CS) + ((size_t)((b * 16 + c) * H + 4 * g + hh)) * PD * NST;
#pragma unroll
            for (int i = 0; i < 4; ++i) { const int e = tid + NTHR * i, p = e >> 5, n4 = (e & 31) * 4; const f32x4 v = *(const f32x4*)(CSp + (size_t)p * NST + n4);
                u32x2 w; w.x = pk2(v[0], v[1]); w.y = pk2(v[2], v[3]); *(LAS u32x2*)(Ib + p * PT + n4) = w; }
        }
        __syncthreads();
        f32x4 ad[4], ao[4];
#pragma unroll
        for (int pt = 0; pt < 4; ++pt) { ad[pt] = (f32x4){0.f, 0.f, 0.f, 0.f}; ao[pt] = (f32x4){0.f, 0.f, 0.f, 0.f}; }
        const float acl = sAcs[hh * 128 + l];
        for (int kk = 0; kk <= (wave >> 1); ++kk) {
            const bf16x8 gf = ldfrag(Gs, l, 32 * kk + 8 * fq);
            const f32x4 a0 = *(const LAS f32x4*)(sAcs + hh * 128 + 32 * kk + 8 * fq), a1 = *(const LAS f32x4*)(sAcs + hh * 128 + 32 * kk + 8 * fq + 4);
            bf16x8 pf;
#pragma unroll
            for (int j = 0; j < 8; ++j) { const int s = 32 * kk + 8 * fq + j; const float as = j < 4 ? a0[j & 3] : a1[j & 3];
                const float pv = s <= l ? bf2f((bf16)gf[j]) * __expf(acl - as) : 0.f; pf[j] = (short)f2bf(pv); }
#pragma unroll
            for (int pt = 0; pt < 4; ++pt) ad[pt] = mfma16(ldfrag(Xt, 16 * pt + fr, 32 * kk + 8 * fq), pf, ad[pt]);
        }
#pragma unroll
        for (int kk = 0; kk < 4; ++kk) { const bf16x8 cf = ldfrag(Cn, l, 32 * kk + 8 * fq);
#pragma unroll
            for (int pt = 0; pt < 4; ++pt) ao[pt] = mfma16(ldfrag(Ib, 16 * pt + fr, 32 * kk + 8 * fq), cf, ao[pt]); }
        const float el = __expf(acl), Dh = a.in[I_SSDD][4 * g + hh];
#pragma unroll
        for (int pt = 0; pt < 4; ++pt) { const int chl = 64 * hh + 16 * pt + 4 * fq;
            const u32x2 xx = *(const u32x2*)(XC + (size_t)row * CONVD + 256 * g + chl), zz = *(const u32x2*)(PROJ + (size_t)row * NPROJ + 256 * g + chl);
            const float xv[4] = {bflo(xx.x), bfhi(xx.x), bflo(xx.y), bfhi(xx.y)}, zv[4] = {bflo(zz.x), bfhi(zz.x), bflo(zz.y), bfhi(zz.y)};
            float v[4];
#pragma unroll
            for (int r = 0; r < 4; ++r) { const float y = ad[pt][r] + el * ao[pt][r] + Dh * xv[r]; v[r] = y * fsilu(zv[r]); ssq += v[r] * v[r]; }
            u32x2 w; w.x = pk2(v[0], v[1]); w.y = pk2(v[2], v[3]); *(u32x2*)(mixrow + chl) = w; }
    }
    ssq += __shfl_xor(ssq, 16); ssq += __shfl_xor(ssq, 32);
    const float scale = rsqrtf(ssq * (1.f / 256.f) + EPS);
#pragma unroll 1
    for (int hp = 0; hp < 16; ++hp) { const int chl = 16 * hp + 4 * fq; const f32x4 ng = *(const f32x4*)(a.in[I_SSDNG] + 256 * g + chl);
        const u32x2 vv = *(const u32x2*)(mixrow + chl);
        u32x2 w; w.x = pk2(bflo(vv.x) * scale * ng[0], bfhi(vv.x) * scale * ng[1]); w.y = pk2(bflo(vv.y) * scale * ng[2], bfhi(vv.y) * scale * ng[3]);
        *(u32x2*)(mixrow + chl) = w; }
    __syncthreads();
}
__device__ __forceinline__ void phase_mix2(const Args& a, LAS unsigned char* lds, int tid, int lane, int wave) {
    if (a.flags & 1) for (int u = blockIdx.x; u < NP * 16 * NG; u += gridDim.x) ssd_pass2_unit(a, lds, tid, lane, wave, u >> 5, (u >> 1) & 15, u & 1);
    const int gw = blockIdx.x * NWAVES + wave, NGW = gridDim.x * NWAVES;
    LAS unsigned char* ldsw = lds + wave * 16896;
    if (a.flags & 2) for (int u = gw; u < NP * 16 * G5; u += NGW) s5_unit<1>(a, ldsw, lane, u);
    __syncthreads();
}

__device__ __forceinline__ float xbcf(const bf16* proj, const float* sconv, int s, int i, int ch) {
    if (i < 3) return s < NP ? 0.f : sconv[((size_t)(s - NP) * 3 + i) * CONVD + ch];
    const int row = s < NP ? s * LP + (i - 3) : MP + (s - NP) * LS + (i - 3);
    return bf2f(proj[(size_t)row * NPROJ + O1 + ch]);
}
__global__ void nv_convnew(const bf16* proj, const float* sconv, float* out) {
    const int s = blockIdx.x, L = s < NP ? LP : LS;
    float* o = s < NP ? out + OUT_CONVP + (size_t)s * 3 * CONVD : out + OUT_CONVS + (size_t)(s - NP) * 3 * CONVD;
    for (int e = threadIdx.x; e < 3 * CONVD; e += blockDim.x) o[e] = xbcf(proj, sconv, s, L + e / CONVD, e % CONVD);
}
__global__ void __launch_bounds__(512) nv_ssd(const bf16* proj, const float* dtraw, const float* sconv, const float* sssd, const float* convw, const float* convb, const float* dtb, const float* Alog,
                                              const float* Dsk, float* yssd, float* out) {
    const int s = blockIdx.x / H, h = blockIdx.x % H, g = h / (H / NG), tid = threadIdx.x, p = tid / 8, nq = tid % 8;
    const int L = s < NP ? LP : LS, row0 = s < NP ? s * LP : MP + (s - NP) * LS;
    __shared__ float sx[PD], sB[NST], sC[NST];
    float st[16];
    for (int j = 0; j < 16; ++j) st[j] = s < NP ? 0.f : sssd[(((size_t)(s - NP) * H + h) * PD + p) * NST + nq * 16 + j];
    const float A = -expf(Alog[h]), Dh = Dsk[h], bias = dtb[h];
    for (int t = 0; t < L; ++t) {
        if (tid < PD + 2 * NST) {
            const int ch = tid < PD ? h * PD + tid : (tid < PD + NST ? DSSD + g * NST + (tid - PD) : DSSD + NG * NST + g * NST + (tid - PD - NST));
            float c = convb[ch];
            for (int k = 0; k < 4; ++k) c += xbcf(proj, sconv, s, t + k, ch) * convw[k * CONVD + ch];
            c = siluf(c);
            if (tid < PD) sx[tid] = c; else if (tid < PD + NST) sB[tid - PD] = c; else sC[tid - PD - NST] = c;
        }
        __syncthreads();
        const float dt = softplusf(dtraw[(size_t)(row0 + t) * 8 + h] + bias), dA = expf(dt * A), xv = sx[p], dx = dt * xv;
        float y = 0.f;
        for (int j = 0; j < 16; ++j) { st[j] = st[j] * dA + dx * sB[nq * 16 + j]; y += sC[nq * 16 + j] * st[j]; }
        y += __shfl_xor(y, 1); y += __shfl_xor(y, 2); y += __shfl_xor(y, 4);
        if (nq == 0) yssd[(size_t)(row0 + t) * DSSD + h * PD + p] = y + Dh * xv;
        __syncthreads();
    }
    float* o = s < NP ? out + OUT_SSDP + (((size_t)s * H + h) * PD + p) * NST : out + OUT_SSDS + (((size_t)(s - NP) * H + h) * PD + p) * NST;
    for (int j = 0; j < 16; ++j) o[nq * 16 + j] = st[j];
}
__global__ void nv_ssdnorm(const float* yssd, const bf16* proj, const float* ng, bf16* mix) {
    const int row = blockIdx.x, t = threadIdx.x;
    __shared__ float red[2][256];
    float v[2];
    for (int gi = 0; gi < 2; ++gi) { const int c = gi * 256 + t; v[gi] = yssd[(size_t)row * DSSD + c] * siluf(bf2f(proj[(size_t)row * NPROJ + c])); red[gi][t] = v[gi] * v[gi]; }
    __syncthreads();
    for (int o = 128; o > 0; o >>= 1) { if (t < o) { red[0][t] += red[0][t + o]; red[1][t] += red[1][t + o]; } __syncthreads(); }
    for (int gi = 0; gi < 2; ++gi) { const int c = gi * 256 + t; mix[(size_t)row * D + c] = (bf16)f2bf(v[gi] * rsqrtf(red[gi][0] / 256.f + EPS) * ng[c]); }
}
__global__ void nv_s5(const bf16* proj, const float* s0re, const float* s0im, const float* Are, const float* Aim, const float* lstep, const float* Bre, const float* Bim,
                      const float* Cre, const float* Cim, const float* Dsk, bf16* gy, float* out) {
    const int s = blockIdx.x / G5, g = blockIdx.x % G5, p = threadIdx.x;
    const int L = s < NP ? LP : LS, row0 = s < NP ? s * LP : MP + (s - NP) * LS;
    const float lr = Are[g * P5 + p], li = Aim[g * P5 + p], step = expf(lstep[g]);
    const float mag = expf(lr * step), abr = mag * cosf(li * step), abi = mag * sinf(li * step);
    const float nr = abr - 1.f, ni = abi, den = lr * lr + li * li, fr = (nr * lr + ni * li) / den, fi = (ni * lr - nr * li) / den;
    float bbr[CH5], bbi[CH5], cr[CH5], ci[CH5];
    for (int c = 0; c < CH5; ++c) { const float br = Bre[((size_t)g * P5 + p) * CH5 + c], bi = Bim[((size_t)g * P5 + p) * CH5 + c];
        bbr[c] = fr * br - fi * bi; bbi[c] = fr * bi + fi * br; cr[c] = Cre[((size_t)g * CH5 + c) * P5 + p]; ci[c] = Cim[((size_t)g * CH5 + c) * P5 + p]; }
    float hr = s < NP ? 0.f : s0re[((size_t)(s - NP) * G5 + g) * P5 + p], hi = s < NP ? 0.f : s0im[((size_t)(s - NP) * G5 + g) * P5 + p];
    for (int t = 0; t < L; ++t) {
        const bf16* u = proj + (size_t)(row0 + t) * NPROJ + 1536 + g * CH5;
        float br = 0.f, bi = 0.f, uv[CH5];
        for (int c = 0; c < CH5; ++c) { uv[c] = bf2f(u[c]); br += bbr[c] * uv[c]; bi += bbi[c] * uv[c]; }
        const float nhr = abr * hr - abi * hi + br, nhi = abr * hi + abi * hr + bi; hr = nhr; hi = nhi;
        float mine = 0.f;
        for (int c = 0; c < CH5; ++c) { float v = cr[c] * hr - ci[c] * hi;
            for (int o = 1; o < 64; o <<= 1) v += __shfl_xor(v, o);
            if (p == c) mine = v + Dsk[g * CH5 + c] * uv[c]; }
        if (p < CH5) gy[(size_t)(row0 + t) * DS5 + g * CH5 + p] = (bf16)f2bf(0.5f * mine * (1.f + erff(mine * 0.70710678118654752f)));
    }
    float* ore = s < NP ? out + OUT_REP + ((size_t)s * G5 + g) * P5 : out + OUT_RES + ((size_t)(s - NP) * G5 + g) * P5;
    float* oim = s < NP ? out + OUT_IMP + ((size_t)s * G5 + g) * P5 : out + OUT_IMS + ((size_t)(s - NP) * G5 + g) * P5;
    ore[p] = hr; oim[p] = hi;
}
__global__ void nv_ada(const float* cp, const float* cs, const float* w, const float* b, float* mod, int N, int off) {
    const int j = blockIdx.x * 256 + threadIdx.x, s = blockIdx.y;
    const float* c = s < NP ? cp + (size_t)s * D : cs + (size_t)(s - NP) * D;
    float acc = 0.f;
    for (int k = 0; k < D; ++k) acc += siluf(c[k]) * w[(size_t)k * N + j];
    mod[(size_t)s * NMOD + off + j] = acc + b[j];
}

constexpr int NPHASE = 12;
__global__ void __launch_bounds__(NTHR, 2) fwd_mega(Args a) {
    extern __shared__ __attribute__((aligned(16))) unsigned char lds_raw[];
    LAS unsigned char* lds = (LAS unsigned char*)lds_raw;
    cg::grid_group grid = cg::this_grid();
    const int tid = threadIdx.x, lane = tid & 63, wave = __builtin_amdgcn_readfirstlane(tid >> 6);
    unsigned char* ws = a.ws;
    const int lo = a.ph_lo, hi = a.ph_hi, G = gridDim.x;
#define IN(k) (lo <= (k) && (k) < hi)
#define SEAM(k) do { if (IN(k) && IN((k) + 1)) grid.sync(); } while (0)
    if (IN(0)) phase_prep(a, lds, tid, lane, wave);
    SEAM(0);
    if (IN(1)) phase_modnorm<0>(a, lds, tid, lane, wave);
    SEAM(1);
    if (IN(2)) { pg8::Gemm g{(const bf16*)(ws + WS_U), (const bf16*)(ws + WS_WIN), M, NPROJ, D}; pg8::StaticOrder S; S.init(M, NPROJ, G, (int)blockIdx.x);
                 pg8::EpiBf16 E{(bf16*)(ws + WS_PROJ), NPROJ}; pg8::gemm_phase<pg8::EpiBf16, pg8::StaticOrder, true, true>(lds, g, S, E); }
    SEAM(2);
    if (IN(3)) phase_mix1(a, lds, tid, lane, wave);
    SEAM(3);
    if (IN(4)) phase_chunkscan(a, tid);
    SEAM(4);
    if (IN(5)) phase_mix2(a, lds, tid, lane, wave);
    SEAM(5);
    if (IN(6)) { pg8::Gemm g{(const bf16*)(ws + WS_GY), (const bf16*)(ws + WS_WGLU), M, DS5, DS5}; pg8::StaticOrder S; S.init(M, DS5, G, (int)blockIdx.x);
                 pg8::EpiGlu E{(const bf16*)(ws + WS_GY), (bf16*)(ws + WS_MIX), a.in[I_BGLU]}; pg8::gemm_phase<pg8::EpiGlu, pg8::StaticOrder, true, true>(lds, g, S, E); }
    SEAM(6);
    if (IN(7)) { pg8::Gemm g{(const bf16*)(ws + WS_MIX), (const bf16*)(ws + WS_WOUT), M, D, D}; pg8::StaticOrder S; S.init(M, D, G, (int)blockIdx.x);
                 pg8::EpiResid E{a.in[I_XP], a.in[I_XS], a.out + OUT_Y, (const float*)(ws + WS_MOD) + 2048}; pg8::gemm_phase<pg8::EpiResid, pg8::StaticOrder, true, true>(lds, g, S, E); }
    SEAM(7);
    if (IN(8)) phase_modnorm<1>(a, lds, tid, lane, wave);
    SEAM(8);
    if (IN(9)) { pg8::Gemm g{(const bf16*)(ws + WS_U), (const bf16*)(ws + WS_WUP), M, 2 * DFF, D}; pg8::StaticOrder S; S.init(M, 2 * DFF, G, (int)blockIdx.x);
                 pg8::EpiSwiglu E{(bf16*)(ws + WS_HFF), DFF}; pg8::gemm_phase<pg8::EpiSwiglu, pg8::StaticOrder, true, true>(lds, g, S, E); }
    SEAM(9);
    if (IN(10)) { pg8::Gemm g{(const bf16*)(ws + WS_HFF), (const bf16*)(ws + WS_WDOWN), M, D, DFF}; pg8::StaticOrder S; S.init(M, D, G, (int)blockIdx.x);
                  pg8::EpiResid E{a.out + OUT_Y, a.out + OUT_Y + (size_t)MP * D, a.out + OUT_Y, (const float*)(ws + WS_MOD) + 5120}; pg8::gemm_phase<pg8::EpiResid, pg8::StaticOrder, true, true>(lds, g, S, E); }
    SEAM(10);
    if (IN(11)) phase_modnorm<2>(a, lds, tid, lane, wave);
#undef IN
#undef SEAM
}

extern "C" void kernel_launch(void* const* d_in, const int* in_sizes, int n_in, void* d_out, int out_size, void* d_ws, size_t ws_size, hipStream_t stream) {
    static int grid = 0;
    if (grid == 0) {
        int dev = 0, cus = 0, per_cu = 0;
        (void)hipGetDevice(&dev); (void)hipDeviceGetAttribute(&cus, hipDeviceAttributeMultiprocessorCount, dev);
        (void)hipFuncSetAttribute((const void*)fwd_mega, hipFuncAttributeMaxDynamicSharedMemorySize, LDS_BYTES);
        (void)hipOccupancyMaxActiveBlocksPerMultiprocessor(&per_cu, (const void*)fwd_mega, NTHR, LDS_BYTES);
        grid = cus * (per_cu < 1 ? 1 : 1);
        if (n_in != 36 || ws_size < WS_END || out_size != (int)OUT_END) fprintf(stderr, "kernel_launch: unexpected sizes n_in %d ws %zu out %d\n", n_in, ws_size, out_size);
    }
    Args a{};
    for (int i = 0; i < 36; ++i) a.in[i] = (const float*)d_in[i];
    a.out = (float*)d_out; a.ws = (unsigned char*)d_ws;
    const float* const* in = a.in; unsigned char* ws = a.ws; float* out = a.out;
    auto run = [&](int lo, int hi) { a.ph_lo = lo; a.ph_hi = hi; hipLaunchKernelGGL(fwd_mega, dim3(grid), dim3(NTHR), LDS_BYTES, stream, a); };
    constexpr int FLAGS = DBG_FLAGS; a.flags = FLAGS;
    run(0, 1); run(1, 2); run(2, 3);
    run(3, 4); run(4, 5); run(5, 6);
    if (!(FLAGS & 1)) {
        float* yssd = (float*)(ws + 226 * MiB);
        nv_ssd<<<NSEQ * H, 512, 0, stream>>>((const bf16*)(ws + WS_PROJ), (const float*)(ws + WS_DT), in[I_SCONV], in[I_SSSD], in[I_CONVW], in[I_CONVB], in[I_DTB], in[I_ALOG], in[I_SSDD], yssd, out);
        nv_ssdnorm<<<M, 256, 0, stream>>>(yssd, (const bf16*)(ws + WS_PROJ), in[I_SSDNG], (bf16*)(ws + WS_MIX));
    }
    if (!(FLAGS & 2)) nv_s5<<<NSEQ * G5, 64, 0, stream>>>((const bf16*)(ws + WS_PROJ), in[I_SRE], in[I_SIM], in[I_ARE], in[I_AIM], in[I_LSTEP], in[I_BRE], in[I_BIM], in[I_CRE], in[I_CIM], in[I_S5D], (bf16*)(ws + WS_GY), out);
    run(6, 7); run(7, 8); run(8, 9); run(9, 10); run(10, 11); run(11, 12);
}
```

```cpp
#include <hip/hip_runtime.h>
#include <hip/hip_cooperative_groups.h>
#include <cstdio>
#include <cstdint>
namespace cg = cooperative_groups;
#ifndef DBG_FLAGS
#define DBG_FLAGS 3
#endif

constexpr int D = 1024, NP = 8, LP = 2048, NS = 128, LS = 4, NSEQ = NP + NS;
constexpr int MP = NP * LP, MS = NS * LS, M = MP + MS;
constexpr int H = 8, PD = 64, NST = 128, NG = 2, DSSD = 512, CONVD = 1024;
constexpr int G5 = 32, CH5 = 16, P5 = 64, DS5 = 512;
constexpr int DFF = 2816, INP = 2056, O1 = 512, O2 = 1536, O3 = 1544;
constexpr int NPROJ = 2048;
constexpr int NMOD = 8192;
constexpr float EPS = 1e-6f;
constexpr size_t OUT_Y = 0, OUT_SSDP = (size_t)M * D, OUT_SSDS = OUT_SSDP + (size_t)NP * H * PD * NST, OUT_CONVP = OUT_SSDS + (size_t)NS * H * PD * NST,
                 OUT_CONVS = OUT_CONVP + (size_t)NP * 3 * CONVD, OUT_REP = OUT_CONVS + (size_t)NS * 3 * CONVD, OUT_RES = OUT_REP + (size_t)NP * G5 * P5,
                 OUT_IMP = OUT_RES + (size_t)NS * G5 * P5, OUT_IMS = OUT_IMP + (size_t)NP * G5 * P5, OUT_END = OUT_IMS + (size_t)NS * G5 * P5;
constexpr size_t MiB = 1u << 20;
constexpr size_t WS_CTL = 0, WS_MOD = 1 * MiB, WS_DT = 6 * MiB, WS_BB = 7 * MiB, WS_CC = WS_BB + 256 * 1024, WS_AB = WS_CC + 256 * 1024, WS_ACS = 8 * MiB, WS_S5E = 9 * MiB,
                 WS_WIN = 12 * MiB, WS_WGLU = 16 * MiB, WS_WOUT = 17 * MiB, WS_WUP = 19 * MiB, WS_WDOWN = 30 * MiB,
                 WS_U = 36 * MiB, WS_CS = 36 * MiB, WS_PROJ = 69 * MiB, WS_XC = 135 * MiB, WS_HFF = 69 * MiB, WS_MIX = 168 * MiB, WS_GY = 201 * MiB, WS_G = 218 * MiB, WS_END = 256 * MiB;
static_assert(WS_MOD + (size_t)NSEQ * NMOD * 4 <= WS_DT && WS_DT + (size_t)M * 8 * 4 <= WS_BB && WS_WDOWN + (size_t)D * DFF * 2 <= WS_U && WS_U + (size_t)M * D * 2 <= WS_PROJ, "ws map 1");
static_assert(WS_PROJ + (size_t)M * NPROJ * 2 <= WS_XC && WS_XC + (size_t)M * CONVD * 2 <= WS_MIX && WS_HFF + (size_t)M * DFF * 2 <= WS_MIX && WS_MIX + (size_t)M * D * 2 <= WS_GY && WS_GY + (size_t)M * DS5 * 2 <= WS_G, "ws map 2");

typedef unsigned short bf16;
__device__ __host__ __forceinline__ int seq_of_row(int r) { return r < MP ? r / LP : NP + (r - MP) / LS; }
__device__ __forceinline__ float siluf(float v) { return v / (1.f + expf(-v)); }
__device__ __forceinline__ float softplusf(float v) { return v > 20.f ? v : log1pf(expf(v)); }
__device__ __forceinline__ float bf2f(bf16 b) { return __uint_as_float(((unsigned)b) << 16); }
__device__ __forceinline__ unsigned f2bf(float f) { unsigned u = __float_as_uint(f); return (u + 0x7fffu + ((u >> 16) & 1u)) >> 16; }
__device__ __forceinline__ unsigned pk2(float lo, float hi) { return f2bf(lo) | (f2bf(hi) << 16); }
__device__ __forceinline__ float bflo(unsigned w) { return __uint_as_float(w << 16); }
__device__ __forceinline__ float bfhi(unsigned w) { return __uint_as_float(w & 0xffff0000u); }
__device__ __forceinline__ float sigm(float v) { return __builtin_amdgcn_rcpf(1.f + __expf(-v)); }

namespace pg8 {
#define PG8_LAS __attribute__((address_space(3)))
typedef unsigned short bf16_t;
typedef short bf16x8 __attribute__((ext_vector_type(8)));
typedef float f32x4 __attribute__((ext_vector_type(4)));
typedef unsigned u32x4 __attribute__((ext_vector_type(4)));
constexpr int BM = 256, BK = 64, HALF = 128, HTB = HALF * BK * 2  , STAGE_BYTES = 8 * HTB, NXCD = 8, WGM = 8;

__host__ __device__ __forceinline__ int lds_byte(int r, int c) { const int st = (r >> 4) * 2 + (c >> 5), rr = r & 15, cc = c & 31, ob = rr * 64 + cc * 2; return st * 1024 + (ob ^ (((ob >> 9) & 1) << 5)); }
__host__ __device__ __forceinline__ void stage_rc(int b, int& R, int& C) { const int st = b / 1024, sb = b % 1024, swz = sb ^ (((sb >> 9) & 1) << 5); R = (st >> 1) * 16 + swz / 64; C = (st & 1) * 32 + (swz % 64) / 2; }
__host__ __device__ __forceinline__ int perm32(int rho) { const int n = rho >> 4, i = rho & 15; return 8 * (i >> 2) + 4 * n + (i & 3); }

struct Unit { int pm, pn; };
struct Gemm { const bf16_t* A; const bf16_t* Bt; int M, N, K; };

struct StaticOrder {
    int nM, nN, nwg, G, c;
    __host__ __device__ void init(int M, int N, int G_, int c_) { nM = M / BM; nN = N / BM; nwg = nM * nN; G = G_; c = c_; }
    __host__ __device__ bool next(int i, Unit& u) const {
        const long L = (long)i * G + c; if (L >= nwg) return false;
        int wgid = (int)L; { const int q = nwg / NXCD, r = nwg % NXCD, xcd = wgid % NXCD, off = wgid / NXCD; wgid = (xcd < r ? xcd * (q + 1) : r * (q + 1) + (xcd - r) * q) + off; }
        const int nig = WGM * nN, gid = wgid / nig, fm = gid * WGM, gsz = (nM - fm) < WGM ? (nM - fm) : WGM;
        u.pm = fm + ((wgid % nig) % gsz); u.pn = (wgid % nig) / gsz; return true;
    }
    __device__ __forceinline__ void a_ready(const Unit&) const {}
    __device__ __forceinline__ void done(const Unit&) const {}
};
__device__ __forceinline__ unsigned cvt_pk_bf16(float lo, float hi) { unsigned r; asm volatile("v_cvt_pk_bf16_f32 %0, %1, %2" : "=v"(r) : "v"(lo), "v"(hi)); return r; }
struct EpiBf16 {
    static constexpr bool PERM = true, AFTER_DRAIN = false;
    bf16_t* O; int ldc;
    __device__ __forceinline__ void operator()(const f32x4 (&acc)[2][2][4][2], const Unit& u, int wr, int wc, int fr, int fq) const {
        const int row0 = u.pm * BM + wr * 64 + fr, col0 = u.pn * BM + wc * 32 + 8 * fq;
#pragma unroll
        for (int ai = 0; ai < 2; ++ai)
#pragma unroll
            for (int m = 0; m < 4; ++m) { bf16_t* rowp = O + (size_t)(row0 + ai * HALF + m * 16) * ldc + col0;
#pragma unroll
                for (int bj = 0; bj < 2; ++bj) { const f32x4 v0 = acc[ai][bj][m][0], v1 = acc[ai][bj][m][1];
                    u32x4 w; w.x = cvt_pk_bf16(v0[0], v0[1]); w.y = cvt_pk_bf16(v0[2], v0[3]); w.z = cvt_pk_bf16(v1[0], v1[1]); w.w = cvt_pk_bf16(v1[2], v1[3]);
                    *(u32x4*)(rowp + bj * HALF) = w; } }
    }
};
struct EpiGlu {
    static constexpr bool PERM = true, AFTER_DRAIN = false;
    const bf16_t* GY; bf16_t* MIX; const float* bias;
    __device__ __forceinline__ void operator()(const f32x4 (&acc)[2][2][4][2], const Unit& u, int wr, int wc, int fr, int fq) const {
        const int row0 = u.pm * BM + wr * 64 + fr, col0 = u.pn * BM + wc * 32 + 8 * fq;
#pragma unroll
        for (int bj = 0; bj < 2; ++bj) { const int col = col0 + bj * HALF; const f32x4 b0 = *(const f32x4*)(bias + col), b1 = *(const f32x4*)(bias + col + 4);
#pragma unroll
            for (int ai = 0; ai < 2; ++ai)
#pragma unroll
                for (int m = 0; m < 4; ++m) { const size_t row = (size_t)(row0 + ai * HALF + m * 16);
                    const u32x4 g = *(const u32x4*)(GY + row * 512 + col); const f32x4 v0 = acc[ai][bj][m][0] + b0, v1 = acc[ai][bj][m][1] + b1;
                    u32x4 w; w.x = cvt_pk_bf16(bflo(g.x) * sigm(v0[0]), bfhi(g.x) * sigm(v0[1])); w.y = cvt_pk_bf16(bflo(g.y) * sigm(v0[2]), bfhi(g.y) * sigm(v0[3]));
                             w.z = cvt_pk_bf16(bflo(g.z) * sigm(v1[0]), bfhi(g.z) * sigm(v1[1])); w.w = cvt_pk_bf16(bflo(g.w) * sigm(v1[2]), bfhi(g.w) * sigm(v1[3]));
                    *(u32x4*)(MIX + row * 1024 + 512 + col) = w; } }
    }
};
struct EpiResid {
    static constexpr bool PERM = false, AFTER_DRAIN = false;
    const float* xa; const float* xb; float* out; const float* gate;
    static constexpr int MPROWS = 16384, NMODS = 8192;
    __device__ __forceinline__ void operator()(const f32x4 (&acc)[2][2][4][2], const Unit& u, int wr, int wc, int fr, int fq) const {
        const int row0 = u.pm * BM + wr * 64 + fr, col0 = u.pn * BM + wc * 32 + 4 * fq;
#pragma unroll
        for (int ai = 0; ai < 2; ++ai)
#pragma unroll
            for (int m = 0; m < 4; ++m) { const int row = row0 + ai * HALF + m * 16; const int s = row < MPROWS ? row / 2048 : 8 + (row - MPROWS) / 4;
                const float* res = row < MPROWS ? xa + (size_t)row * 1024 : xb + (size_t)(row - MPROWS) * 1024; const float* gp = gate + (size_t)s * NMODS; float* op = out + (size_t)row * 1024;
#pragma unroll
                for (int bj = 0; bj < 2; ++bj)
#pragma unroll
                    for (int n = 0; n < 2; ++n) { const int col = col0 + bj * HALF + n * 16; const f32x4 r = *(const f32x4*)(res + col), g = *(const f32x4*)(gp + col);
                        *(f32x4*)(op + col) = r + g * acc[ai][bj][m][n]; } }
    }
};
struct EpiSwiglu {
    static constexpr bool PERM = true, AFTER_DRAIN = false;
    bf16_t* Hf; int ldc;
    __device__ __forceinline__ void operator()(const f32x4 (&acc)[2][2][4][2], const Unit& u, int wr, int wc, int fr, int fq) const {
        const int row0 = u.pm * BM + wr * 64 + fr, col0 = u.pn * HALF + wc * 32 + 8 * fq;
#pragma unroll
        for (int ai = 0; ai < 2; ++ai)
#pragma unroll
            for (int m = 0; m < 4; ++m) { const f32x4 g0 = acc[ai][0][m][0], g1 = acc[ai][0][m][1], u0 = acc[ai][1][m][0], u1 = acc[ai][1][m][1];
                u32x4 w; w.x = cvt_pk_bf16(g0[0] * sigm(g0[0]) * u0[0], g0[1] * sigm(g0[1]) * u0[1]); w.y = cvt_pk_bf16(g0[2] * sigm(g0[2]) * u0[2], g0[3] * sigm(g0[3]) * u0[3]);
                         w.z = cvt_pk_bf16(g1[0] * sigm(g1[0]) * u1[0], g1[1] * sigm(g1[1]) * u1[1]); w.w = cvt_pk_bf16(g1[2] * sigm(g1[2]) * u1[2], g1[3] * sigm(g1[3]) * u1[3]);
                *(u32x4*)(Hf + (size_t)(row0 + ai * HALF + m * 16) * ldc + col0) = w; }
    }
};

template <class Epi, class Sched, bool ALIGN_EPI = false, bool SP2 = false>
__device__ __forceinline__ void gemm_phase(PG8_LAS unsigned char* lds, const Gemm g, const Sched& S, const Epi& E) {
    const int tid = threadIdx.x, wid = __builtin_amdgcn_readfirstlane(tid >> 6), lane = tid & 63, wr = wid >> 2, wc = wid & 3, fr = lane & 15, fq = lane >> 4;
    const int K = g.K, nt = K / BK;
    unsigned voffA[2], voffB[2];
#pragma unroll
    for (int i = 0; i < 2; ++i) { int R, C; stage_rc(tid * 16 + i * 8192, R, C); const int Rb = Epi::PERM ? ((R & ~31) + perm32(R & 31)) : R;
        voffA[i] = (unsigned)(R * K + C) * 2u; voffB[i] = (unsigned)(Rb * K + C) * 2u; }
    const size_t kstep = (size_t)(BK * 2);
    const size_t hstep = (size_t)HALF * K * 2;
    const size_t tstep = 2 * hstep;
    const unsigned ldsw = (unsigned)wid * 1024u;
    const int aoff = lds_byte(wr * 64 + fr, fq * 8), boff = lds_byte(wc * 32 + fr, fq * 8);
#define PG8_SA(b, h) (((b) * 2 + (h)) * HTB)
#define PG8_SB(b, h) ((4 + (b) * 2 + (h)) * HTB)
#define PG8_STAGE(bufoff, gbase, voff) do { _Pragma("unroll") for (int _i = 0; _i < 2; ++_i) \
        __builtin_amdgcn_global_load_lds((const unsigned*)((const char*)(gbase) + (voff)[_i]), (PG8_LAS unsigned*)(lds + (bufoff) + ldsw + _i * 8192), 16, 0, 0); } while (0)
#define PG8_LDA(dst, b, h) do { _Pragma("unroll") for (int m = 0; m < 4; ++m) _Pragma("unroll") for (int k = 0; k < 2; ++k) dst[m][k] = *(const PG8_LAS bf16x8*)(lds + PG8_SA(b, h) + aoff + m * 2048 + k * 1024); } while (0)
#define PG8_LDB(dst, b, h) do { _Pragma("unroll") for (int n = 0; n < 2; ++n) _Pragma("unroll") for (int k = 0; k < 2; ++k) dst[n][k] = *(const PG8_LAS bf16x8*)(lds + PG8_SB(b, h) + boff + n * 2048 + k * 1024); } while (0)
#define PG8_MMA(ai, bj, At, Bt) do { __builtin_amdgcn_s_setprio(1); _Pragma("unroll") for (int m = 0; m < 4; ++m) _Pragma("unroll") for (int n = 0; n < 2; ++n) _Pragma("unroll") for (int k = 0; k < 2; ++k) \
        acc[ai][bj][m][n] = __builtin_amdgcn_mfma_f32_16x16x32_bf16(Bt[n][k], At[m][k], acc[ai][bj][m][n], 0, 0, 0); __builtin_amdgcn_s_setprio(0); } while (0)
#define PG8_WAIT_V(n) asm volatile("s_waitcnt vmcnt(" #n ")" ::: "memory")
#define PG8_WAIT_L(n) asm volatile("s_waitcnt lgkmcnt(" #n ")" ::: "memory")
#define PG8_BAR __builtin_amdgcn_s_barrier()
#define PG8_SCHED __builtin_amdgcn_sched_barrier(0)
    Unit cur, nxt; int ui = 0;
    if (!S.next(0, cur)) return;
    f32x4 acc[2][2][4][2];
#pragma unroll
    for (int a = 0; a < 2; ++a)
#pragma unroll
        for (int b = 0; b < 2; ++b)
#pragma unroll
            for (int m = 0; m < 4; ++m)
#pragma unroll
                for (int n = 0; n < 2; ++n) acc[a][b][m][n] = (f32x4){0.f, 0.f, 0.f, 0.f};
    bf16x8 At[4][2], B0[2][2], B1[2][2];
    const char* cA = (const char*)g.A + (size_t)cur.pm * tstep; const char* cB = (const char*)g.Bt + (size_t)cur.pn * tstep;
    S.a_ready(cur);
    if constexpr (SP2) {
        PG8_STAGE(PG8_SB(0, 0), cB, voffB); PG8_STAGE(PG8_SB(0, 1), cB + hstep, voffB); PG8_STAGE(PG8_SA(0, 0), cA, voffA); PG8_STAGE(PG8_SA(0, 1), cA + hstep, voffA);
        if (wr == 1) PG8_BAR;
        PG8_WAIT_V(2); PG8_BAR;
        PG8_STAGE(PG8_SB(1, 0), cB + kstep, voffB); PG8_STAGE(PG8_SA(1, 0), cA + kstep, voffA); PG8_STAGE(PG8_SB(1, 1), cB + hstep + kstep, voffB);
        PG8_WAIT_V(6); PG8_BAR;
    } else {
        PG8_STAGE(PG8_SB(0, 0), cB, voffB); PG8_STAGE(PG8_SA(0, 0), cA, voffA); PG8_STAGE(PG8_SB(0, 1), cB + hstep, voffB); PG8_STAGE(PG8_SA(0, 1), cA + hstep, voffA);
        if (wr == 1) PG8_BAR;
        PG8_WAIT_V(4); PG8_BAR;
        PG8_STAGE(PG8_SB(1, 0), cB + kstep, voffB); PG8_STAGE(PG8_SA(1, 0), cA + kstep, voffA); PG8_STAGE(PG8_SB(1, 1), cB + hstep + kstep, voffB);
        PG8_WAIT_V(6); PG8_BAR;
    }
    for (;;) {
        const bool has_next = S.next(ui + 1, nxt);
        const char* nA = has_next ? (const char*)g.A + (size_t)nxt.pm * tstep : cA; const char* nB = has_next ? (const char*)g.Bt + (size_t)nxt.pn * tstep : cB;
        for (int t = 0; t < nt; t += 2) {
            const bool last = (t == nt - 2);
            const char* a1 = cA + (size_t)(t + 1) * kstep;
            const char* a2 = last ? nA : cA + (size_t)(t + 2) * kstep; const char* b2 = last ? nB : cB + (size_t)(t + 2) * kstep;
            const char* a3 = a2 + kstep; const char* b3 = b2 + kstep;
            if (last && has_next) S.a_ready(nxt);
            if constexpr (SP2) {
            PG8_LDB(B0, 0, 0); PG8_LDB(B1, 0, 1); PG8_SCHED; PG8_LDA(At, 0, 0); PG8_STAGE(PG8_SA(1, 1), a1 + hstep, voffA);
            PG8_WAIT_V(8); PG8_WAIT_L(0); PG8_BAR; PG8_MMA(0, 0, At, B0); PG8_MMA(0, 1, At, B1); PG8_BAR; PG8_SCHED;
            PG8_LDA(At, 0, 1); PG8_STAGE(PG8_SB(0, 0), b2, voffB); PG8_STAGE(PG8_SB(0, 1), b2 + hstep, voffB); PG8_STAGE(PG8_SA(0, 0), a2, voffA);
            PG8_WAIT_V(8); PG8_WAIT_L(0); PG8_BAR; PG8_MMA(1, 0, At, B0); PG8_MMA(1, 1, At, B1); PG8_BAR; PG8_SCHED;
            PG8_LDB(B0, 1, 0); PG8_LDB(B1, 1, 1); PG8_SCHED; PG8_LDA(At, 1, 0); PG8_STAGE(PG8_SA(0, 1), a2 + hstep, voffA);
            PG8_WAIT_V(8); PG8_WAIT_L(0); PG8_BAR; PG8_MMA(0, 0, At, B0); PG8_MMA(0, 1, At, B1); PG8_BAR; PG8_SCHED;
            PG8_LDA(At, 1, 1); PG8_STAGE(PG8_SB(1, 0), b3, voffB); PG8_STAGE(PG8_SB(1, 1), b3 + hstep, voffB); PG8_STAGE(PG8_SA(1, 0), a3, voffA);
            PG8_WAIT_V(8); PG8_WAIT_L(0); PG8_BAR; PG8_MMA(1, 0, At, B0); PG8_MMA(1, 1, At, B1); PG8_BAR; PG8_SCHED;
            } else {
            PG8_LDB(B0, 0, 0); PG8_SCHED; PG8_LDA(At, 0, 0); PG8_STAGE(PG8_SA(1, 1), a1 + hstep, voffA);
            PG8_WAIT_L(8); PG8_BAR; PG8_WAIT_L(0); PG8_MMA(0, 0, At, B0); PG8_BAR; PG8_SCHED;
            PG8_LDB(B1, 0, 1); PG8_STAGE(PG8_SB(0, 0), b2, voffB);
            PG8_BAR; PG8_WAIT_L(0); PG8_MMA(0, 1, At, B1); PG8_BAR;
            PG8_LDA(At, 0, 1); PG8_STAGE(PG8_SA(0, 0), a2, voffA);
            PG8_BAR; PG8_WAIT_L(0); PG8_MMA(1, 0, At, B0); PG8_BAR; PG8_SCHED;
            PG8_STAGE(PG8_SB(0, 1), b2 + hstep, voffB);
            PG8_WAIT_V(6); PG8_BAR; PG8_MMA(1, 1, At, B1); PG8_BAR;
            PG8_LDB(B0, 1, 0); PG8_SCHED; PG8_LDA(At, 1, 0); PG8_STAGE(PG8_SA(0, 1), a2 + hstep, voffA);
            PG8_WAIT_L(8); PG8_BAR; PG8_WAIT_L(0); PG8_MMA(0, 0, At, B0); PG8_BAR; PG8_SCHED;
            PG8_LDB(B1, 1, 1); PG8_STAGE(PG8_SB(1, 0), b3, voffB);
            PG8_BAR; PG8_WAIT_L(0); PG8_MMA(0, 1, At, B1); PG8_BAR;
            PG8_LDA(At, 1, 1); PG8_STAGE(PG8_SA(1, 0), a3, voffA);
            PG8_BAR; PG8_WAIT_L(0); PG8_MMA(1, 0, At, B0); PG8_BAR; PG8_SCHED;
            PG8_STAGE(PG8_SB(1, 1), b3 + hstep, voffB);
            PG8_WAIT_V(6); PG8_BAR; PG8_MMA(1, 1, At, B1); PG8_BAR;
            }
        }
        if constexpr (ALIGN_EPI) { if (wr == 0) PG8_BAR; }
        if constexpr (!Epi::AFTER_DRAIN) { E(acc, cur, wr, wc, fr, fq); S.done(cur); }
        if (!has_next) break;
#pragma unroll
        for (int a = 0; a < 2; ++a)
#pragma unroll
            for (int b = 0; b < 2; ++b)
#pragma unroll
                for (int m = 0; m < 4; ++m)
#pragma unroll
                    for (int n = 0; n < 2; ++n) acc[a][b][m][n] = (f32x4){0.f, 0.f, 0.f, 0.f};
        cur = nxt; cA = nA; cB = nB; ++ui;
        if constexpr (ALIGN_EPI) { if (wr == 1) PG8_BAR; }
    }
    PG8_WAIT_V(0);
    if constexpr (!ALIGN_EPI) { if (wr == 0) PG8_BAR; }
    PG8_BAR;
    if constexpr (Epi::AFTER_DRAIN) { E.fused(acc, cur, wr, wc, fr, fq, lds, wid, lane); S.done(cur); }
#undef PG8_SA
#undef PG8_SB
#undef PG8_STAGE
#undef PG8_LDA
#undef PG8_LDB
#undef PG8_MMA
#undef PG8_WAIT_V
#undef PG8_WAIT_L
#undef PG8_BAR
#undef PG8_SCHED
}
}
#define LAS __attribute__((address_space(3)))
typedef unsigned v4u __attribute__((ext_vector_type(4)));
typedef float f32x4 __attribute__((ext_vector_type(4)));
typedef float f32x2 __attribute__((ext_vector_type(2)));
typedef unsigned u32x2 __attribute__((ext_vector_type(2)));
typedef short bf16x8 __attribute__((ext_vector_type(8)));
constexpr int NWAVES = 8, NTHR = 512;
constexpr int LDS_BYTES = 147456;
#define LDS_WAIT() asm volatile("s_waitcnt lgkmcnt(0)" ::: "memory")

struct Args { const float* in[36]; float* out; unsigned char* ws; int ph_lo, ph_hi, flags, pad; };
enum { I_XP = 0, I_XS, I_CP, I_CS, I_SSSD, I_SCONV, I_SRE, I_SIM, I_WADA, I_BADA, I_N1G, I_WIN, I_CONVW, I_CONVB, I_DTB, I_ALOG, I_SSDD, I_SSDNG, I_ARE, I_AIM, I_LSTEP, I_BRE, I_BIM,
       I_CRE, I_CIM, I_S5D, I_WGLU, I_BGLU, I_WOUT, I_N2G, I_WGATE, I_WUP, I_WDOWN, I_WADAF, I_BADAF, I_NFG };

__device__ __forceinline__ float wave_sum(float v) {
#pragma unroll
    for (int o = 1; o < 64; o <<= 1) v += __shfl_xor(v, o);
    return v;
}
__device__ __forceinline__ void transpose_item(const float* W, int ldw, int col0, int k0, bf16* WT, int row0, int K, LAS float* scr, int lane) {
#pragma unroll 8
    for (int i = 0; i < 32; ++i) { const int kk = 2 * i + (lane >> 5); scr[kk * 33 + (lane & 31)] = W[(size_t)(k0 + kk) * ldw + col0 + (lane & 31)]; }
    LDS_WAIT();
    const int c = lane & 7;
#pragma unroll
    for (int j = 0; j < 4; ++j) { const int n = (lane >> 3) + 8 * j; const LAS float* s = scr + (8 * c) * 33 + n;
        v4u o; o.x = pk2(s[0 * 33], s[1 * 33]); o.y = pk2(s[2 * 33], s[3 * 33]); o.z = pk2(s[4 * 33], s[5 * 33]); o.w = pk2(s[6 * 33], s[7 * 33]);
        *(v4u*)(WT + (size_t)(row0 + n) * K + k0 + 8 * c) = o; }
    LDS_WAIT();
}

__device__ __forceinline__ void phase_prep(const Args& a, LAS unsigned char* lds, int tid, int lane, int wave) {
    unsigned char* ws = a.ws;
    LAS float* scr = (LAS float*)(lds + wave * 16384);
    const int gw = blockIdx.x * NWAVES + wave, NGW = gridDim.x * NWAVES;
    constexpr int I0 = 16 * 64, I1 = 8 * 16, I2 = 16 * 32, I3 = 16 * 176, I4 = 44 * 32, NIT = I0 + I1 + I2 + I3 + I4;
    for (int it = gw; it < NIT; it += NGW) {
        int r = it;
        if (r < I0) { const int kb = r / 64, nb = r % 64; transpose_item(a.in[I_WIN], INP, 32 * nb + (nb >= 48 ? 8 : 0), 64 * kb, (bf16*)(ws + WS_WIN), 32 * nb, 1024, scr, lane); continue; } r -= I0;
        if (r < I1) { const int kb = r / 16, nb = r % 16; transpose_item(a.in[I_WGLU], 512, 32 * nb, 64 * kb, (bf16*)(ws + WS_WGLU), 32 * nb, 512, scr, lane); continue; } r -= I1;
        if (r < I2) { const int kb = r / 32, nb = r % 32; transpose_item(a.in[I_WOUT], 1024, 32 * nb, 64 * kb, (bf16*)(ws + WS_WOUT), 32 * nb, 1024, scr, lane); continue; } r -= I2;
        if (r < I3) { const int kb = r / 176, nb = r % 176, tile = nb >> 3, sub = nb & 7;
                      transpose_item(sub < 4 ? a.in[I_WGATE] : a.in[I_WUP], DFF, 128 * tile + 32 * (sub & 3), 64 * kb, (bf16*)(ws + WS_WUP), 32 * nb, 1024, scr, lane); continue; } r -= I3;
        { const int kb = r / 32, nb = r % 32; transpose_item(a.in[I_WDOWN], 1024, 32 * nb, 64 * kb, (bf16*)(ws + WS_WDOWN), 32 * nb, DFF, scr, lane); }
    }
    { const int gp = blockIdx.x * NTHR + tid;
      if (gp < G5 * P5) { const int g = gp / P5, p = gp % P5;
        const float lr = a.in[I_ARE][gp], li = a.in[I_AIM][gp], step = expf(a.in[I_LSTEP][g]);
        const float mag = expf(lr * step), abr = mag * cosf(li * step), abi = mag * sinf(li * step);
        const float nr = abr - 1.f, ni = abi, den = lr * lr + li * li, fr = (nr * lr + ni * li) / den, fi = (ni * lr - nr * li) / den;
        float* AB = (float*)(ws + WS_AB); AB[2 * gp] = abr; AB[2 * gp + 1] = abi;
        float pr = abr, pi = abi;
#pragma unroll
        for (int q = 0; q < 7; ++q) { const float t = pr * pr - pi * pi; pi = 2.f * pr * pi; pr = t; }
        AB[2 * G5 * P5 + 2 * gp] = pr; AB[2 * G5 * P5 + 2 * gp + 1] = pi;
        bf16* BB = (bf16*)(ws + WS_BB) + ((size_t)g * 128 + 2 * p) * 16; bf16* CC = (bf16*)(ws + WS_CC) + (size_t)g * 16 * 128 + 2 * p;
        for (int c = 0; c < CH5; ++c) { const float br = a.in[I_BRE][(size_t)gp * CH5 + c], bi = a.in[I_BIM][(size_t)gp * CH5 + c];
            BB[c] = (bf16)f2bf(fr * br - fi * bi); BB[16 + c] = (bf16)f2bf(fr * bi + fi * br);
            CC[c * 128] = (bf16)f2bf(a.in[I_CRE][((size_t)g * CH5 + c) * P5 + p]); CC[c * 128 + 1] = (bf16)f2bf(-a.in[I_CIM][((size_t)g * CH5 + c) * P5 + p]); } } }
    __syncthreads();
    for (int wb = blockIdx.x; wb < NMOD / 32; wb += gridDim.x) {
        const int j0 = 32 * wb; const bool fin = j0 >= 6144; const float* W = fin ? a.in[I_WADAF] : a.in[I_WADA]; const int ldw = fin ? 2048 : 6144, jc = fin ? j0 - 6144 : j0;
        const float* bias = (fin ? a.in[I_BADAF] : a.in[I_BADA]) + jc;
        const int kq = wave & 3, nt = wave >> 2, fr = lane & 15, fq = lane >> 4;
        f32x4 acc[9];
#pragma unroll
        for (int mt = 0; mt < 9; ++mt) acc[mt] = (f32x4){0.f, 0.f, 0.f, 0.f};
        for (int kk = 0; kk < 8; ++kk) {
            const int k0 = 256 * kq + 32 * kk + 8 * fq;
            bf16x8 bfr;
#pragma unroll
            for (int j = 0; j < 8; ++j) bfr[j] = (short)f2bf(W[(size_t)(k0 + j) * ldw + jc + 16 * nt + fr]);
#pragma unroll
            for (int mt = 0; mt < 9; ++mt) { const int s = 16 * mt + fr; bf16x8 afr;
                if (s < NSEQ) { const float* c = (s < NP ? a.in[I_CP] + (size_t)s * D : a.in[I_CS] + (size_t)(s - NP) * D) + k0;
                    const f32x4 c0 = *(const f32x4*)c, c1 = *(const f32x4*)(c + 4);
#pragma unroll
                    for (int j = 0; j < 4; ++j) { afr[j] = (short)f2bf(siluf(c0[j])); afr[4 + j] = (short)f2bf(siluf(c1[j])); } }
                else {
#pragma unroll
                    for (int j = 0; j < 8; ++j) afr[j] = 0; }
                acc[mt] = __builtin_amdgcn_mfma_f32_16x16x32_bf16(afr, bfr, acc[mt], 0, 0, 0); }
        }
        LAS float* part = (LAS float*)lds;
#pragma unroll
        for (int mt = 0; mt < 9; ++mt)
#pragma unroll
            for (int r = 0; r < 4; ++r) part[((kq * 2 + nt) * 144 + 16 * mt + 4 * fq + r) * 16 + fr] = acc[mt][r];
        __syncthreads();
        for (int e = tid; e < NSEQ * 32; e += NTHR) { const int s = e >> 5, c = e & 31, ntt = c >> 4, cc = c & 15; float v = bias[c];
#pragma unroll
            for (int q = 0; q < 4; ++q) v += part[((q * 2 + ntt) * 144 + s) * 16 + cc];
            ((float*)(ws + WS_MOD))[(size_t)s * NMOD + j0 + c] = v; }
        __syncthreads();
    }
}

template <int MODE> __device__ __forceinline__ void phase_modnorm(const Args& a, LAS unsigned char* lds, int tid, int lane, int wave) {
    unsigned char* ws = a.ws; const float* mod = (const float*)(ws + WS_MOD);
    const int sh_off = MODE == 0 ? 0 : (MODE == 1 ? 3072 : 6144), sc_off = sh_off + 1024;
    const float* gam = a.in[MODE == 0 ? I_N1G : (MODE == 1 ? I_N2G : I_NFG)];
    LAS float* wdt = (LAS float*)lds;
    if (MODE == 0) { for (int e = tid; e < 8192; e += NTHR) { const int k = e >> 3, h = e & 7; wdt[h * 1024 + k] = a.in[I_WIN][(size_t)k * INP + O2 + h]; } __syncthreads(); }
    const int gw = blockIdx.x * NWAVES + wave, NGW = gridDim.x * NWAVES;
    for (int row = gw; row < M; row += NGW) {
        const int s = seq_of_row(row);
        const float* x = MODE == 0 ? (row < MP ? a.in[I_XP] + (size_t)row * D : a.in[I_XS] + (size_t)(row - MP) * D) : a.out + OUT_Y + (size_t)row * D;
        f32x4 v[4]; float ss = 0.f;
#pragma unroll
        for (int j = 0; j < 4; ++j) { v[j] = *(const f32x4*)(x + 4 * lane + 256 * j); ss += (v[j][0] * v[j][0] + v[j][1] * v[j][1]) + (v[j][2] * v[j][2] + v[j][3] * v[j][3]); }
        const float inv = rsqrtf(wave_sum(ss) * (1.f / D) + EPS);
        const float* ms = mod + (size_t)s * NMOD;
#pragma unroll
        for (int j = 0; j < 4; ++j) { const int c = 4 * lane + 256 * j; const f32x4 g = *(const f32x4*)(gam + c), sc = *(const f32x4*)(ms + sc_off + c), sh = *(const f32x4*)(ms + sh_off + c);
            v[j] = v[j] * inv * g * (sc + 1.f) + sh; }
        if (MODE == 2) {
#pragma unroll
            for (int j = 0; j < 4; ++j) *(f32x4*)(a.out + OUT_Y + (size_t)row * D + 4 * lane + 256 * j) = v[j];
        } else {
            bf16* o = (bf16*)(ws + WS_U) + (size_t)row * D;
#pragma unroll
            for (int j = 0; j < 4; ++j) { u32x2 w; w.x = pk2(v[j][0], v[j][1]); w.y = pk2(v[j][2], v[j][3]); *(u32x2*)(o + 4 * lane + 256 * j) = w; }
        }
        if (MODE == 0) {
            float mine = 0.f;
#pragma unroll
            for (int h = 0; h < 8; ++h) { float d = 0.f;
#pragma unroll
                for (int j = 0; j < 4; ++j) { const f32x4 w = *(const LAS f32x4*)(wdt + h * 1024 + 4 * lane + 256 * j); d += (v[j][0] * w[0] + v[j][1] * w[1]) + (v[j][2] * w[2] + v[j][3] * w[3]); }
                d = wave_sum(d); if (lane == h) mine = d; }
            if (lane < 8) ((float*)(ws + WS_DT))[(size_t)row * 8 + lane] = mine;
        }
    }
}

constexpr int PT = 136;
typedef float f32x16 __attribute__((ext_vector_type(16)));
__device__ __forceinline__ f32x4 mfma16(bf16x8 a, bf16x8 b, f32x4 c) { return __builtin_amdgcn_mfma_f32_16x16x32_bf16(a, b, c, 0, 0, 0); }
__device__ __forceinline__ bf16x8 ldfrag(const LAS bf16* base, int row, int k) { return *(const LAS bf16x8*)(base + row * PT + k); }
__device__ __forceinline__ float fsilu(float v) { return v * __builtin_amdgcn_rcpf(1.f + __expf(-v)); }

struct ConvPair {
    float w0[4], w1[4], b0, b1, h0[3], h1[3];
    __device__ __forceinline__ void init(const Args& a, int ch) {
#pragma unroll
        for (int k = 0; k < 4; ++k) { const f32x2 w = *(const f32x2*)(a.in[I_CONVW] + k * CONVD + ch); w0[k] = w.x; w1[k] = w.y; }
        const f32x2 b = *(const f32x2*)(a.in[I_CONVB] + ch); b0 = b.x; b1 = b.y;
    }
    __device__ __forceinline__ void hist(int i, unsigned pr) { h0[i] = bflo(pr); h1[i] = bfhi(pr); }
    __device__ __forceinline__ void step(unsigned pr, float& o0, float& o1) {
        const float x0 = bflo(pr), x1 = bfhi(pr);
        o0 = fsilu(b0 + w0[0] * h0[0] + w0[1] * h0[1] + w0[2] * h0[2] + w0[3] * x0);
        o1 = fsilu(b1 + w1[0] * h1[0] + w1[1] * h1[1] + w1[2] * h1[2] + w1[3] * x1);
        h0[0] = h0[1]; h0[1] = h0[2]; h0[2] = x0; h1[0] = h1[1]; h1[1] = h1[2]; h1[2] = x1;
    }
};

__device__ __forceinline__ void ssd_pass1_unit(const Args& a, LAS unsigned char* lds, int tid, int lane, int wave, int b, int c, int g) {
    unsigned char* ws = a.ws;
    const bf16* PROJ = (const bf16*)(ws + WS_PROJ); bf16* XC = (bf16*)(ws + WS_XC);
    const int r0 = b * LP + c * 128, fr = lane & 15, fq = lane >> 4;
    LAS bf16* Bn = (LAS bf16*)lds;
    LAS bf16* Cn = Bn + 128 * PT;
    LAS bf16* Xt = (LAS bf16*)lds;
    LAS bf16* Bt = (LAS bf16*)(lds + 69632);
    LAS float* sAcs = (LAS float*)(lds + 104448);
    LAS float* sW = sAcs + 512;
    if (wave < 4) {
        const int h = 4 * g + wave; const float A = -expf(a.in[I_ALOG][h]), bias = a.in[I_DTB][h];
        const float* dtr = (const float*)(ws + WS_DT);
        const float d0 = softplusf(dtr[(size_t)(r0 + lane) * 8 + h] + bias), d1 = softplusf(dtr[(size_t)(r0 + 64 + lane) * 8 + h] + bias);
        float s0 = d0 * A, s1 = d1 * A;
#pragma unroll
        for (int o = 1; o < 64; o <<= 1) { const float t0 = __shfl_up(s0, o), t1 = __shfl_up(s1, o); if (lane >= o) { s0 += t0; s1 += t1; } }
        s1 += __shfl(s0, 63); const float last = __shfl(s1, 63);
        sAcs[wave * 128 + lane] = s0; sAcs[wave * 128 + 64 + lane] = s1;
        sW[wave * 128 + lane] = d0 * expf(last - s0); sW[wave * 128 + 64 + lane] = d1 * expf(last - s1);
        float* rec = (float*)(ws + WS_ACS) + ((size_t)(b * 16 + c) * H + h) * 256;
        rec[lane] = s0; rec[64 + lane] = s1; rec[128 + lane] = d0; rec[192 + lane] = d1;
    }
    {
        const int cp = tid & 127, tr = tid >> 7, c2 = 2 * cp;
        const int ch = c2 < 128 ? DSSD + NST * g + c2 : DSSD + NG * NST + NST * g + (c2 - 128);
        ConvPair cv; cv.init(a, ch);
        const bf16* src = PROJ + (size_t)(r0 + 32 * tr) * NPROJ + O1 + ch;
        if (c == 0 && tr == 0) { cv.hist(0, 0u); cv.hist(1, 0u); cv.hist(2, 0u); }
        else {
#pragma unroll
            for (int i = 0; i < 3; ++i) cv.hist(i, *(const unsigned*)(src + (ptrdiff_t)(i - 3) * NPROJ)); }
        LAS bf16* nat = c2 < 128 ? Bn + c2 : Cn + (c2 - 128);
        for (int blk = 0; blk < 4; ++blk) {
            unsigned pr[8]; float o0[8], o1[8];
#pragma unroll
            for (int i = 0; i < 8; ++i) pr[i] = *(const unsigned*)(src + (size_t)(8 * blk + i) * NPROJ);
#pragma unroll
            for (int i = 0; i < 8; ++i) cv.step(pr[i], o0[i], o1[i]);
            const int l0 = 32 * tr + 8 * blk;
#pragma unroll
            for (int i = 0; i < 8; ++i) *(LAS unsigned*)(nat + (l0 + i) * PT) = pk2(o0[i], o1[i]);
            if (c2 >= 128) {
#pragma unroll
                for (int i = 0; i < 8; ++i) *(unsigned*)(XC + (size_t)(r0 + l0 + i) * CONVD + ch) = pk2(o0[i], o1[i]);
            } else {
                v4u t0, t1; t0.x = pk2(o0[0], o0[1]); t0.y = pk2(o0[2], o0[3]); t0.z = pk2(o0[4], o0[5]); t0.w = pk2(o0[6], o0[7]);
                t1.x = pk2(o1[0], o1[1]); t1.y = pk2(o1[2], o1[3]); t1.z = pk2(o1[4], o1[5]); t1.w = pk2(o1[6], o1[7]);
                *(LAS v4u*)(Bt + c2 * PT + l0) = t0; *(LAS v4u*)(Bt + (c2 + 1) * PT + l0) = t1;
            }
        }
    }
    __syncthreads();
    {
        bf16x8 cf[4];
#pragma unroll
        for (int kk = 0; kk < 4; ++kk) cf[kk] = ldfrag(Cn, 16 * wave + fr, 32 * kk + 8 * fq);
        bf16* Gg = (bf16*)(ws + WS_G) + (size_t)((b * 16 + c) * NG + g) * 128 * 128;
        for (int st = 0; st <= wave; ++st) {
            f32x4 acc = (f32x4){0.f, 0.f, 0.f, 0.f};
#pragma unroll
            for (int kk = 0; kk < 4; ++kk) acc = mfma16(ldfrag(Bn, 16 * st + fr, 32 * kk + 8 * fq), cf[kk], acc);
            u32x2 w; w.x = pk2(acc[0], acc[1]); w.y = pk2(acc[2], acc[3]);
            *(u32x2*)(Gg + (size_t)(16 * wave + fr) * 128 + 16 * st + 4 * fq) = w;
        }
    }
    __syncthreads();
    {
        const int cp = tid & 127, tr = tid >> 7, c2 = 2 * cp, ch = 256 * g + c2, hh = c2 >> 6;
        ConvPair cv; cv.init(a, ch);
        const bf16* src = PROJ + (size_t)(r0 + 32 * tr) * NPROJ + O1 + ch;
        if (c == 0 && tr == 0) { cv.hist(0, 0u); cv.hist(1, 0u); cv.hist(2, 0u); }
        else {
#pragma unroll
            for (int i = 0; i < 3; ++i) cv.hist(i, *(const unsigned*)(src + (ptrdiff_t)(i - 3) * NPROJ)); }
        for (int blk = 0; blk < 4; ++blk) {
            unsigned pr[8]; float o0[8], o1[8];
#pragma unroll
            for (int i = 0; i < 8; ++i) pr[i] = *(const unsigned*)(src + (size_t)(8 * blk + i) * NPROJ);
#pragma unroll
            for (int i = 0; i < 8; ++i) cv.step(pr[i], o0[i], o1[i]);
            const int l0 = 32 * tr + 8 * blk;
#pragma unroll
            for (int i = 0; i < 8; ++i) *(unsigned*)(XC + (size_t)(r0 + l0 + i) * CONVD + ch) = pk2(o0[i], o1[i]);
            const f32x4 wa = *(const LAS f32x4*)(sW + hh * 128 + l0), wb = *(const LAS f32x4*)(sW + hh * 128 + l0 + 4);
            v4u t0, t1; t0.x = pk2(o0[0] * wa[0], o0[1] * wa[1]); t0.y = pk2(o0[2] * wa[2], o0[3] * wa[3]); t0.z = pk2(o0[4] * wb[0], o0[5] * wb[1]); t0.w = pk2(o0[6] * wb[2], o0[7] * wb[3]);
            t1.x = pk2(o1[0] * wa[0], o1[1] * wa[1]); t1.y = pk2(o1[2] * wa[2], o1[3] * wa[3]); t1.z = pk2(o1[4] * wb[0], o1[5] * wb[1]); t1.w = pk2(o1[6] * wb[2], o1[7] * wb[3]);
            *(LAS v4u*)(Xt + c2 * PT + l0) = t0; *(LAS v4u*)(Xt + (c2 + 1) * PT + l0) = t1;
        }
    }
    __syncthreads();
    {
        const int hh = wave >> 1, nt0 = 4 * (wave & 1);
        f32x4 acc[4][4];
#pragma unroll
        for (int i = 0; i < 4; ++i)
#pragma unroll
            for (int j = 0; j < 4; ++j) acc[i][j] = (f32x4){0.f, 0.f, 0.f, 0.f};
#pragma unroll
        for (int kk = 0; kk < 4; ++kk) { bf16x8 bfr[4], xfr[4];
#pragma unroll
            for (int i = 0; i < 4; ++i) { bfr[i] = ldfrag(Bt, 16 * (nt0 + i) + fr, 32 * kk + 8 * fq); xfr[i] = ldfrag(Xt, 64 * hh + 16 * i + fr, 32 * kk + 8 * fq); }
#pragma unroll
            for (int i = 0; i < 4; ++i)
#pragma unroll
                for (int j = 0; j < 4; ++j) acc[i][j] = mfma16(bfr[i], xfr[j], acc[i][j]); }
        float* CSp = (float*)(ws + WS_CS) + ((size_t)((b * 16 + c) * H + 4 * g + hh)) * PD * NST;
#pragma unroll
        for (int i = 0; i < 4; ++i)
#pragma unroll
            for (int j = 0; j < 4; ++j) *(f32x4*)(CSp + (size_t)(16 * j + fr) * NST + 16 * (nt0 + i) + 4 * fq) = acc[i][j];
    }
    __syncthreads();
}

__device__ __forceinline__ void ssd_sample_unit(const Args& a, LAS unsigned char* lds, int tid, int lane, int wave, int bs, int g) {
    unsigned char* ws = a.ws; const bf16* PROJ = (const bf16*)(ws + WS_PROJ);
    const int r0 = MP + 4 * bs;
    LAS float* sx = (LAS float*)lds;
    LAS float* sB = sx + 1024;
    LAS float* sC = sB + 512;
    LAS float* sdt = sC + 512;
    LAS float* yp = sdt + 32;
    LAS float* red = yp + 2048;
    {   const int idx = tid, ch = idx < 256 ? 256 * g + idx : (idx < 384 ? DSSD + NST * g + (idx - 256) : DSSD + NG * NST + NST * g + (idx - 384));
        float w[4], hs[7];
#pragma unroll
        for (int k = 0; k < 4; ++k) w[k] = a.in[I_CONVW][k * CONVD + ch];
        const float bb = a.in[I_CONVB][ch];
#pragma unroll
        for (int i = 0; i < 3; ++i) hs[i] = a.in[I_SCONV][((size_t)bs * 3 + i) * CONVD + ch];
#pragma unroll
        for (int i = 0; i < 4; ++i) hs[3 + i] = bf2f(PROJ[(size_t)(r0 + i) * NPROJ + O1 + ch]);
#pragma unroll
        for (int t = 0; t < 4; ++t) { const float v = fsilu(bb + w[0] * hs[t] + w[1] * hs[t + 1] + w[2] * hs[t + 2] + w[3] * hs[t + 3]);
            if (idx < 256) sx[t * 256 + idx] = v; else if (idx < 384) sB[t * 128 + idx - 256] = v; else sC[t * 128 + idx - 384] = v; }
    }
    if (tid < 16) { const int t = tid >> 2, hh = tid & 3, h = 4 * g + hh; const float dt = softplusf(((const float*)(ws + WS_DT))[(size_t)(r0 + t) * 8 + h] + a.in[I_DTB][h]);
        sdt[t * 4 + hh] = dt; sdt[16 + t * 4 + hh] = expf(-dt * expf(a.in[I_ALOG][h])); }
    __syncthreads();
    {   const int hh = wave >> 1, nh = wave & 1, h = 4 * g + hh, p = lane;
        const float* s0 = a.in[I_SSSD] + (((size_t)bs * H + h) * PD + p) * NST + 64 * nh;
        f32x4 st[16];
#pragma unroll
        for (int j = 0; j < 16; ++j) st[j] = *(const f32x4*)(s0 + 4 * j);
#pragma unroll
        for (int t = 0; t < 4; ++t) { const float dA = sdt[16 + t * 4 + hh], dx = sdt[t * 4 + hh] * sx[t * 256 + 64 * hh + p]; float y = 0.f;
#pragma unroll
            for (int j = 0; j < 16; ++j) { const f32x4 Bv = *(const LAS f32x4*)(sB + t * 128 + 64 * nh + 4 * j), Cv = *(const LAS f32x4*)(sC + t * 128 + 64 * nh + 4 * j);
                st[j] = st[j] * dA + Bv * dx; y += (Cv[0] * st[j][0] + Cv[1] * st[j][1]) + (Cv[2] * st[j][2] + Cv[3] * st[j][3]); }
            yp[(nh * 4 + t) * 256 + 64 * hh + p] = y; }
        float* o = a.out + OUT_SSDS + (((size_t)bs * H + h) * PD + p) * NST + 64 * nh;
#pragma unroll
        for (int j = 0; j < 16; ++j) *(f32x4*)(o + 4 * j) = st[j];
    }
    __syncthreads();
    {   const int ch = tid & 255, t0 = tid >> 8; float v[2];
#pragma unroll
        for (int i = 0; i < 2; ++i) { const int t = t0 + 2 * i; const float y = yp[t * 256 + ch] + yp[(4 + t) * 256 + ch] + a.in[I_SSDD][4 * g + (ch >> 6)] * sx[t * 256 + ch];
            v[i] = y * fsilu(bf2f(PROJ[(size_t)(r0 + t) * NPROJ + 256 * g + ch])); }
        const float q0 = wave_sum(v[0] * v[0]), q1 = wave_sum(v[1] * v[1]);
        if (lane == 0) { red[wave * 2] = q0; red[wave * 2 + 1] = q1; }
        __syncthreads();
        const int wb = (wave >> 2) * 4; const float ngv = a.in[I_SSDNG][256 * g + ch];
#pragma unroll
        for (int i = 0; i < 2; ++i) { const float tot = (red[(wb + 0) * 2 + i] + red[(wb + 1) * 2 + i]) + (red[(wb + 2) * 2 + i] + red[(wb + 3) * 2 + i]);
            ((bf16*)(ws + WS_MIX))[(size_t)(r0 + t0 + 2 * i) * D + 256 * g + ch] = (bf16)f2bf(v[i] * rsqrtf(tot * (1.f / 256.f) + EPS) * ngv); }
    }
    __syncthreads();
}

template <int MODE> __device__ __forceinline__ void s5_unit(const Args& a, LAS unsigned char* ldsw, int lane, int unit) {
    unsigned char* ws = a.ws; const bf16* PROJ = (const bf16*)(ws + WS_PROJ);
    const int g = unit & 31, q = unit >> 5;
    const int b = q >> 4, c = q & 15;
    const int row0 = MODE == 2 ? MP + 32 * q : b * LP + 128 * c, nsub = MODE == 2 ? 1 : 4;
    const float* AB = (const float*)(ws + WS_AB);
    const float abr = AB[2 * (g * P5 + lane)], abi = AB[2 * (g * P5 + lane) + 1];
    LAS float* BUs = (LAS float*)ldsw;
    bf16x8 bfr[4];
#pragma unroll
    for (int cb = 0; cb < 4; ++cb) bfr[cb] = *(const bf16x8*)((const bf16*)(ws + WS_BB) + ((size_t)g * 128 + 32 * cb + (lane & 31)) * 16 + 8 * (lane >> 5));
    bf16x8 cfr[4];
    if (MODE >= 1) {
#pragma unroll
        for (int kk = 0; kk < 4; ++kk) cfr[kk] = *(const bf16x8*)((const bf16*)(ws + WS_CC) + ((size_t)g * 16 + (lane & 15)) * 128 + 32 * kk + 8 * (lane >> 4)); }
    float hr = 0.f, hi = 0.f;
    if (MODE == 1) { const float pr = AB[2 * G5 * P5 + 2 * (g * P5 + lane)], pi = AB[2 * G5 * P5 + 2 * (g * P5 + lane) + 1];
        for (int cc = 0; cc < c; ++cc) { const f32x2 e = *(const f32x2*)((const float*)(ws + WS_S5E) + ((size_t)((b * 16 + cc) * G5 + g)) * 128 + 2 * lane);
            const float nr = pr * hr - pi * hi + e.x, ni = pr * hi + pi * hr + e.y; hr = nr; hi = ni; } }
    for (int sub = 0; sub < nsub; ++sub) {
        const int rb = row0 + 32 * sub;
        const bf16x8 afr = *(const bf16x8*)(PROJ + (size_t)(rb + (lane & 31)) * NPROJ + 1536 + 16 * g + 8 * (lane >> 5));
#pragma unroll
        for (int cb = 0; cb < 4; ++cb) { f32x16 d;
#pragma unroll
            for (int i = 0; i < 16; ++i) d[i] = 0.f;
            d = __builtin_amdgcn_mfma_f32_32x32x16_bf16(afr, bfr[cb], d, 0, 0, 0);
#pragma unroll
            for (int i = 0; i < 16; ++i) BUs[((i & 3) + 8 * (i >> 2) + 4 * (lane >> 5)) * 132 + 32 * cb + (lane & 31)] = d[i]; }
        LDS_WAIT();
#pragma unroll 4
        for (int t = 0; t < 32; ++t) {
            if (MODE == 2 && (t & 3) == 0) { const int bs = (rb - MP + t) >> 2; hr = a.in[I_SRE][((size_t)bs * G5 + g) * P5 + lane]; hi = a.in[I_SIM][((size_t)bs * G5 + g) * P5 + lane]; }
            const f32x2 bu = *(const LAS f32x2*)(BUs + t * 132 + 2 * lane);
            const float nr = abr * hr - abi * hi + bu.x, ni = abr * hi + abi * hr + bu.y; hr = nr; hi = ni;
            if (MODE >= 1) *(LAS unsigned*)((LAS bf16*)(BUs + t * 132) + 2 * lane) = pk2(hr, hi);
            if (MODE == 2 && (t & 3) == 3) { const int bs = (rb - MP + t) >> 2; a.out[OUT_RES + ((size_t)bs * G5 + g) * P5 + lane] = hr; a.out[OUT_IMS + ((size_t)bs * G5 + g) * P5 + lane] = hi; }
        }
        if (MODE >= 1) {
            LDS_WAIT();
            const int fr = lane & 15, fq = lane >> 4;
#pragma unroll
            for (int tt = 0; tt < 2; ++tt) { f32x4 y = (f32x4){0.f, 0.f, 0.f, 0.f};
#pragma unroll
                for (int kk = 0; kk < 4; ++kk) y = mfma16(cfr[kk], *(const LAS bf16x8*)((const LAS bf16*)(BUs + (16 * tt + fr) * 132) + 32 * kk + 8 * fq), y);
                const int row = rb + 16 * tt + fr, co = 16 * g + 4 * fq;
                const u32x2 uu = *(const u32x2*)(PROJ + (size_t)row * NPROJ + 1536 + co); const f32x4 dk = *(const f32x4*)(a.in[I_S5D] + co);
                float v[4] = {y[0] + dk[0] * bflo(uu.x), y[1] + dk[1] * bfhi(uu.x), y[2] + dk[2] * bflo(uu.y), y[3] + dk[3] * bfhi(uu.y)};
#pragma unroll
                for (int r = 0; r < 4; ++r) v[r] = 0.5f * v[r] * (1.f + erff(v[r] * 0.70710678118654752f));
                u32x2 w; w.x = pk2(v[0], v[1]); w.y = pk2(v[2], v[3]);
                *(u32x2*)((bf16*)(ws + WS_GY) + (size_t)row * DS5 + co) = w; }
            LDS_WAIT();
        }
    }
    if (MODE == 0) { f32x2 e; e.x = hr; e.y = hi; *(f32x2*)((float*)(ws + WS_S5E) + ((size_t)((b * 16 + c) * G5 + g)) * 128 + 2 * lane) = e; }
    if (MODE == 1 && c == 15) { a.out[OUT_REP + ((size_t)b * G5 + g) * P5 + lane] = hr; a.out[OUT_IMP + ((size_t)b * G5 + g) * P5 + lane] = hi; }
}

__device__ __forceinline__ void phase_mix1(const Args& a, LAS unsigned char* lds, int tid, int lane, int wave) {
    unsigned char* ws = a.ws;
    if (a.flags & 1) {
    for (int u = blockIdx.x; u < NP * 16 * NG; u += gridDim.x) ssd_pass1_unit(a, lds, tid, lane, wave, u >> 5, (u >> 1) & 15, u & 1);
    for (int u = blockIdx.x; u < NS * NG; u += gridDim.x) ssd_sample_unit(a, lds, tid, lane, wave, u >> 1, u & 1);
    }
    const int gw = blockIdx.x * NWAVES + wave, NGW = gridDim.x * NWAVES;
    LAS unsigned char* ldsw = lds + wave * 16896;
    if (a.flags & 2) {
    for (int u = gw; u < NP * 16 * G5; u += NGW) s5_unit<0>(a, ldsw, lane, u);
    for (int u = gw; u < (MS / 32) * G5; u += NGW) s5_unit<2>(a, ldsw, lane, u);
    }
    const bf16* PROJ = (const bf16*)(ws + WS_PROJ);
    for (int e = blockIdx.x * NTHR + tid; e < NSEQ * 3 * CONVD; e += gridDim.x * NTHR) {
        const int s = e / (3 * CONVD), i = (e / CONVD) % 3, ch = e % CONVD;
        const int row = s < NP ? s * LP + LP - 3 + i : MP + (s - NP) * LS + 1 + i;
        a.out[OUT_CONVP + e] = bf2f(PROJ[(size_t)row * NPROJ + O1 + ch]); }
    __syncthreads();
}
__device__ __forceinline__ void phase_chunkscan(const Args& a, int tid) {
    unsigned char* ws = a.ws; float* CS = (float*)(ws + WS_CS); const float* ACS = (const float*)(ws + WS_ACS);
    if (!(a.flags & 1)) return;
    for (int e = blockIdx.x * NTHR + tid; e < NP * H * PD * NST / 4; e += gridDim.x * NTHR) {
        const int b = e >> 14, h = (e >> 11) & 7, pn = e & 2047;
        f32x4 v[16]; float dec[16];
#pragma unroll
        for (int c = 0; c < 16; ++c) { v[c] = *(const f32x4*)(CS + ((size_t)((b * 16 + c) * H + h)) * 8192 + 4 * pn); dec[c] = expf(ACS[((size_t)(b * 16 + c) * H + h) * 256 + 127]); }
        f32x4 run = (f32x4){0.f, 0.f, 0.f, 0.f};
#pragma unroll
        for (int c = 0; c < 16; ++c) { *(f32x4*)(CS + ((size_t)((b * 16 + c) * H + h)) * 8192 + 4 * pn) = run; run = run * dec[c] + v[c]; }
        *(f32x4*)(a.out + OUT_SSDP + ((size_t)(b * H + h)) * 8192 + 4 * pn) = run;
    }
}
__device__ __forceinline__ void ssd_pass2_unit(const Args& a, LAS unsigned char* lds, int tid, int lane, int wave, int b, int c, int g) {
    unsigned char* ws = a.ws; const bf16* PROJ = (const bf16*)(ws + WS_PROJ); const bf16* XC = (const bf16*)(ws + WS_XC);
    const int r0 = b * LP + c * 128, fr = lane & 15, fq = lane >> 4;
    LAS bf16* Cn = (LAS bf16*)lds;
    LAS bf16* Gs = Cn + 128 * PT;
    LAS bf16* Xt = Gs + 128 * PT;
    LAS bf16* Ib = Xt + 64 * PT;
    LAS float* sAcs = (LAS float*)(Ib + 64 * PT);
    LAS float* sDt = sAcs + 512;
    const bf16* Gg = (const bf16*)(ws + WS_G) + (size_t)((b * 16 + c) * NG + g) * 128 * 128;
    for (int e = tid; e < 128 * 16; e += NTHR) { const int l = e >> 4, k8 = (e & 15) * 8;
        *(LAS v4u*)(Cn + l * PT + k8) = *(const v4u*)(XC + (size_t)(r0 + l) * CONVD + DSSD + NG * NST + NST * g + k8);
        *(LAS v4u*)(Gs + l * PT + k8) = *(const v4u*)(Gg + (size_t)l * 128 + k8); }
    for (int e = tid; e < 1024; e += NTHR) { const int hh = e >> 8, i = e & 255; sAcs[(i >> 7) * 512 + hh * 128 + (i & 127)] = ((const float*)(ws + WS_ACS))[((size_t)(b * 16 + c) * H + 4 * g + hh) * 256 + i]; }
    float ssq = 0.f;
    const int l = 16 * wave + fr, row = r0 + l;
    bf16* mixrow = (bf16*)(ws + WS_MIX) + (size_t)row * D + 256 * g;
#pragma unroll 1
    for (int hh = 0; hh < 4; ++hh) {
        __syncthreads();
        {   const int pp = tid & 31, sb = tid >> 5, chl = 64 * hh + 2 * pp; unsigned pr[8];
#pragma unroll
            for (int i = 0; i < 8; ++i) pr[i] = *(const unsigned*)(XC + (size_t)(r0 + 8 * sb + i) * CONVD + 256 * g + chl);
            const f32x4 da = *(const LAS f32x4*)(sDt + hh * 128 + 8 * sb), db = *(const LAS f32x4*)(sDt + hh * 128 + 8 * sb + 4);
            v4u t0, t1; t0.x = pk2(bflo(pr[0]) * da[0], bflo(pr[1]) * da[1]); t0.y = pk2(bflo(pr[2]) * da[2], bflo(pr[3]) * da[3]); t0.z = pk2(bflo(pr[4]) * db[0], bflo(pr[5]) * db[1]); t0.w = pk2(bflo(pr[6]) * db[2], bflo(pr[7]) * db[3]);
            t1.x = pk2(bfhi(pr[0]) * da[0], bfhi(pr[1]) * da[1]); t1.y = pk2(bfhi(pr[2]) * da[2], bfhi(pr[3]) * da[3]); t1.z = pk2(bfhi(pr[4]) * db[0], bfhi(pr[5]) * db[1]); t1.w = pk2(bfhi(pr[6]) * db[2], bfhi(pr[7]) * db[3]);
            *(LAS v4u*)(Xt + (2 * pp) * PT + 8 * sb) = t0; *(LAS v4u*)(Xt + (2 * pp + 1) * PT + 8 * sb) = t1;
            const float* CSp = (const float*)(ws + WS_CS) + ((size_t)((b * 16 + c) * H + 4 * g + hh)) * PD * NST;
#pragma unroll
            for (int i = 0; i < 4; ++i) { const int e = tid + NTHR * i, p = e >> 5, n4 = (e & 31) * 4; const f32x4 v = *(const f32x4*)(CSp + (size_t)p * NST + n4);
                u32x2 w; w.x = pk2(v[0], v[1]); w.y = pk2(v[2], v[3]); *(LAS u32x2*)(Ib + p * PT + n4) = w; }
        }
        __syncthreads();
        f32x4 ad[4], ao[4];
#pragma unroll
        for (int pt = 0; pt < 4; ++pt) { ad[pt] = (f32x4){0.f, 0.f, 0.f, 0.f}; ao[pt] = (f32x4){0.f, 0.f, 0.f, 0.f}; }
        const float acl = sAcs[hh * 128 + l];
        for (int kk = 0; kk <= (wave >> 1); ++kk) {
            const bf16x8 gf = ldfrag(Gs, l, 32 * kk + 8 * fq);
            const f32x4 a0 = *(const LAS f32x4*)(sAcs + hh * 128 + 32 * kk + 8 * fq), a1 = *(const LAS f32x4*)(sAcs + hh * 128 + 32 * kk + 8 * fq + 4);
            bf16x8 pf;
#pragma unroll
            for (int j = 0; j < 8; ++j) { const int s = 32 * kk + 8 * fq + j; const float as = j < 4 ? a0[j & 3] : a1[j & 3];
                const float pv = s <= l ? bf2f((bf16)gf[j]) * __expf(acl - as) : 0.f; pf[j] = (short)f2bf(pv); }
#pragma unroll
            for (int pt = 0; pt < 4; ++pt) ad[pt] = mfma16(ldfrag(Xt, 16 * pt + fr, 32 * kk + 8 * fq), pf, ad[pt]);
        }
#pragma unroll
        for (int kk = 0; kk < 4; ++kk) { const bf16x8 cf = ldfrag(Cn, l, 32 * kk + 8 * fq);
#pragma unroll
            for (int pt = 0; pt < 4; ++pt) ao[pt] = mfma16(ldfrag(Ib, 16 * pt + fr, 32 * kk + 8 * fq), cf, ao[pt]); }
        const float el = __expf(acl), Dh = a.in[I_SSDD][4 * g + hh];
#pragma unroll
        for (int pt = 0; pt < 4; ++pt) { const int chl = 64 * hh + 16 * pt + 4 * fq;
            const u32x2 xx = *(const u32x2*)(XC + (size_t)row * CONVD + 256 * g + chl), zz = *(const u32x2*)(PROJ + (size_t)row * NPROJ + 256 * g + chl);
            const float xv[4] = {bflo(xx.x), bfhi(xx.x), bflo(xx.y), bfhi(xx.y)}, zv[4] = {bflo(zz.x), bfhi(zz.x), bflo(zz.y), bfhi(zz.y)};
            float v[4];
#pragma unroll
            for (int r = 0; r < 4; ++r) { const float y = ad[pt][r] + el * ao[pt][r] + Dh * xv[r]; v[r] = y * fsilu(zv[r]); ssq += v[r] * v[r]; }
            u32x2 w; w.x = pk2(v[0], v[1]); w.y = pk2(v[2], v[3]); *(u32x2*)(mixrow + chl) = w; }
    }
    ssq += __shfl_xor(ssq, 16); ssq += __shfl_xor(ssq, 32);
    const float scale = rsqrtf(ssq * (1.f / 256.f) + EPS);
#pragma unroll 1
    for (int hp = 0; hp < 16; ++hp) { const int chl = 16 * hp + 4 * fq; const f32x4 ng = *(const f32x4*)(a.in[I_SSDNG] + 256 * g + chl);
        const u32x2 vv = *(const u32x2*)(mixrow + chl);
        u32x2 w; w.x = pk2(bflo(vv.x) * scale * ng[0], bfhi(vv.x) * scale * ng[1]); w.y = pk2(bflo(vv.y) * scale * ng[2], bfhi(vv.y) * scale * ng[3]);
        *(u32x2*)(mixrow + chl) = w; }
    __syncthreads();
}
__device__ __forceinline__ void phase_mix2(const Args& a, LAS unsigned char* lds, int tid, int lane, int wave) {
    if (a.flags & 1) for (int u = blockIdx.x; u < NP * 16 * NG; u += gridDim.x) ssd_pass2_unit(a, lds, tid, lane, wave, u >> 5, (u >> 1) & 15, u & 1);
    const int gw = blockIdx.x * NWAVES + wave, NGW = gridDim.x * NWAVES;
    LAS unsigned char* ldsw = lds + wave * 16896;
    if (a.flags & 2) for (int u = gw; u < NP * 16 * G5; u += NGW) s5_unit<1>(a, ldsw, lane, u);
    __syncthreads();
}

__device__ __forceinline__ float xbcf(const bf16* proj, const float* sconv, int s, int i, int ch) {
    if (i < 3) return s < NP ? 0.f : sconv[((size_t)(s - NP) * 3 + i) * CONVD + ch];
    const int row = s < NP ? s * LP + (i - 3) : MP + (s - NP) * LS + (i - 3);
    return bf2f(proj[(size_t)row * NPROJ + O1 + ch]);
}
__global__ void nv_convnew(const bf16* proj, const float* sconv, float* out) {
    const int s = blockIdx.x, L = s < NP ? LP : LS;
    float* o = s < NP ? out + OUT_CONVP + (size_t)s * 3 * CONVD : out + OUT_CONVS + (size_t)(s - NP) * 3 * CONVD;
    for (int e = threadIdx.x; e < 3 * CONVD; e += blockDim.x) o[e] = xbcf(proj, sconv, s, L + e / CONVD, e % CONVD);
}
__global__ void __launch_bounds__(512) nv_ssd(const bf16* proj, const float* dtraw, const float* sconv, const float* sssd, const float* convw, const float* convb, const float* dtb, const float* Alog,
                                              const float* Dsk, float* yssd, float* out) {
    const int s = blockIdx.x / H, h = blockIdx.x % H, g = h / (H / NG), tid = threadIdx.x, p = tid / 8, nq = tid % 8;
    const int L = s < NP ? LP : LS, row0 = s < NP ? s * LP : MP + (s - NP) * LS;
    __shared__ float sx[PD], sB[NST], sC[NST];
    float st[16];
    for (int j = 0; j < 16; ++j) st[j] = s < NP ? 0.f : sssd[(((size_t)(s - NP) * H + h) * PD + p) * NST + nq * 16 + j];
    const float A = -expf(Alog[h]), Dh = Dsk[h], bias = dtb[h];
    for (int t = 0; t < L; ++t) {
        if (tid < PD + 2 * NST) {
            const int ch = tid < PD ? h * PD + tid : (tid < PD + NST ? DSSD + g * NST + (tid - PD) : DSSD + NG * NST + g * NST + (tid - PD - NST));
            float c = convb[ch];
            for (int k = 0; k < 4; ++k) c += xbcf(proj, sconv, s, t + k, ch) * convw[k * CONVD + ch];
            c = siluf(c);
            if (tid < PD) sx[tid] = c; else if (tid < PD + NST) sB[tid - PD] = c; else sC[tid - PD - NST] = c;
        }
        __syncthreads();
        const float dt = softplusf(dtraw[(size_t)(row0 + t) * 8 + h] + bias), dA = expf(dt * A), xv = sx[p], dx = dt * xv;
        float y = 0.f;
        for (int j = 0; j < 16; ++j) { st[j] = st[j] * dA + dx * sB[nq * 16 + j]; y += sC[nq * 16 + j] * st[j]; }
        y += __shfl_xor(y, 1); y += __shfl_xor(y, 2); y += __shfl_xor(y, 4);
        if (nq == 0) yssd[(size_t)(row0 + t) * DSSD + h * PD + p] = y + Dh * xv;
        __syncthreads();
    }
    float* o = s < NP ? out + OUT_SSDP + (((size_t)s * H + h) * PD + p) * NST : out + OUT_SSDS + (((size_t)(s - NP) * H + h) * PD + p) * NST;
    for (int j = 0; j < 16; ++j) o[nq * 16 + j] = st[j];
}
__global__ void nv_ssdnorm(const float* yssd, const bf16* proj, const float* ng, bf16* mix) {
    const int row = blockIdx.x, t = threadIdx.x;
    __shared__ float red[2][256];
    float v[2];
    for (int gi = 0; gi < 2; ++gi) { const int c = gi * 256 + t; v[gi] = yssd[(size_t)row * DSSD + c] * siluf(bf2f(proj[(size_t)row * NPROJ + c])); red[gi][t] = v[gi] * v[gi]; }
    __syncthreads();
    for (int o = 128; o > 0; o >>= 1) { if (t < o) { red[0][t] += red[0][t + o]; red[1][t] += red[1][t + o]; } __syncthreads(); }
    for (int gi = 0; gi < 2; ++gi) { const int c = gi * 256 + t; mix[(size_t)row * D + c] = (bf16)f2bf(v[gi] * rsqrtf(red[gi][0] / 256.f + EPS) * ng[c]); }
}
__global__ void nv_s5(const bf16* proj, const float* s0re, const float* s0im, const float* Are, const float* Aim, const float* lstep, const float* Bre, const float* Bim,
                      const float* Cre, const float* Cim, const float* Dsk, bf16* gy, float* out) {
    const int s = blockIdx.x / G5, g = blockIdx.x % G5, p = threadIdx.x;
    const int L = s < NP ? LP : LS, row0 = s < NP ? s * LP : MP + (s - NP) * LS;
    const float lr = Are[g * P5 + p], li = Aim[g * P5 + p], step = expf(lstep[g]);
    const float mag = expf(lr * step), abr = mag * cosf(li * step), abi = mag * sinf(li * step);
    const float nr = abr - 1.f, ni = abi, den = lr * lr + li * li, fr = (nr * lr + ni * li) / den, fi = (ni * lr - nr * li) / den;
    float bbr[CH5], bbi[CH5], cr[CH5], ci[CH5];
    for (int c = 0; c < CH5; ++c) { const float br = Bre[((size_t)g * P5 + p) * CH5 + c], bi = Bim[((size_t)g * P5 + p) * CH5 + c];
        bbr[c] = fr * br - fi * bi; bbi[c] = fr * bi + fi * br; cr[c] = Cre[((size_t)g * CH5 + c) * P5 + p]; ci[c] = Cim[((size_t)g * CH5 + c) * P5 + p]; }
    float hr = s < NP ? 0.f : s0re[((size_t)(s - NP) * G5 + g) * P5 + p], hi = s < NP ? 0.f : s0im[((size_t)(s - NP) * G5 + g) * P5 + p];
    for (int t = 0; t < L; ++t) {
        const bf16* u = proj + (size_t)(row0 + t) * NPROJ + 1536 + g * CH5;
        float br = 0.f, bi = 0.f, uv[CH5];
        for (int c = 0; c < CH5; ++c) { uv[c] = bf2f(u[c]); br += bbr[c] * uv[c]; bi += bbi[c] * uv[c]; }
        const float nhr = abr * hr - abi * hi + br, nhi = abr * hi + abi * hr + bi; hr = nhr; hi = nhi;
        float mine = 0.f;
        for (int c = 0; c < CH5; ++c) { float v = cr[c] * hr - ci[c] * hi;
            for (int o = 1; o < 64; o <<= 1) v += __shfl_xor(v, o);
            if (p == c) mine = v + Dsk[g * CH5 + c] * uv[c]; }
        if (p < CH5) gy[(size_t)(row0 + t) * DS5 + g * CH5 + p] = (bf16)f2bf(0.5f * mine * (1.f + erff(mine * 0.70710678118654752f)));
    }
    float* ore = s < NP ? out + OUT_REP + ((size_t)s * G5 + g) * P5 : out + OUT_RES + ((size_t)(s - NP) * G5 + g) * P5;
    float* oim = s < NP ? out + OUT_IMP + ((size_t)s * G5 + g) * P5 : out + OUT_IMS + ((size_t)(s - NP) * G5 + g) * P5;
    ore[p] = hr; oim[p] = hi;
}
__global__ void nv_ada(const float* cp, const float* cs, const float* w, const float* b, float* mod, int N, int off) {
    const int j = blockIdx.x * 256 + threadIdx.x, s = blockIdx.y;
    const float* c = s < NP ? cp + (size_t)s * D : cs + (size_t)(s - NP) * D;
    float acc = 0.f;
    for (int k = 0; k < D; ++k) acc += siluf(c[k]) * w[(size_t)k * N + j];
    mod[(size_t)s * NMOD + off + j] = acc + b[j];
}

constexpr int NPHASE = 12;
__global__ void __launch_bounds__(NTHR, 2) fwd_mega(Args a) {
    extern __shared__ __attribute__((aligned(16))) unsigned char lds_raw[];
    LAS unsigned char* lds = (LAS unsigned char*)lds_raw;
    cg::grid_group grid = cg::this_grid();
    const int tid = threadIdx.x, lane = tid & 63, wave = __builtin_amdgcn_readfirstlane(tid >> 6);
    unsigned char* ws = a.ws;
    const int lo = a.ph_lo, hi = a.ph_hi, G = gridDim.x;
#define IN(k) (lo <= (k) && (k) < hi)
#define SEAM(k) do { if (IN(k) && IN((k) + 1)) grid.sync(); } while (0)
    if (IN(0)) phase_prep(a, lds, tid, lane, wave);
    SEAM(0);
    if (IN(1)) phase_modnorm<0>(a, lds, tid, lane, wave);
    SEAM(1);
    if (IN(2)) { pg8::Gemm g{(const bf16*)(ws + WS_U), (const bf16*)(ws + WS_WIN), M, NPROJ, D}; pg8::StaticOrder S; S.init(M, NPROJ, G, (int)blockIdx.x);
                 pg8::EpiBf16 E{(bf16*)(ws + WS_PROJ), NPROJ}; pg8::gemm_phase<pg8::EpiBf16, pg8::StaticOrder, true, true>(lds, g, S, E); }
    SEAM(2);
    if (IN(3)) phase_mix1(a, lds, tid, lane, wave);
    SEAM(3);
    if (IN(4)) phase_chunkscan(a, tid);
    SEAM(4);
    if (IN(5)) phase_mix2(a, lds, tid, lane, wave);
    SEAM(5);
    if (IN(6)) { pg8::Gemm g{(const bf16*)(ws + WS_GY), (const bf16*)(ws + WS_WGLU), M, DS5, DS5}; pg8::StaticOrder S; S.init(M, DS5, G, (int)blockIdx.x);
                 pg8::EpiGlu E{(const bf16*)(ws + WS_GY), (bf16*)(ws + WS_MIX), a.in[I_BGLU]}; pg8::gemm_phase<pg8::EpiGlu, pg8::StaticOrder, true, true>(lds, g, S, E); }
    SEAM(6);
    if (IN(7)) { pg8::Gemm g{(const bf16*)(ws + WS_MIX), (const bf16*)(ws + WS_WOUT), M, D, D}; pg8::StaticOrder S; S.init(M, D, G, (int)blockIdx.x);
                 pg8::EpiResid E{a.in[I_XP], a.in[I_XS], a.out + OUT_Y, (const float*)(ws + WS_MOD) + 2048}; pg8::gemm_phase<pg8::EpiResid, pg8::StaticOrder, true, true>(lds, g, S, E); }
    SEAM(7);
    if (IN(8)) phase_modnorm<1>(a, lds, tid, lane, wave);
    SEAM(8);
    if (IN(9)) { pg8::Gemm g{(const bf16*)(ws + WS_U), (const bf16*)(ws + WS_WUP), M, 2 * DFF, D}; pg8::StaticOrder S; S.init(M, 2 * DFF, G, (int)blockIdx.x);
                 pg8::EpiSwiglu E{(bf16*)(ws + WS_HFF), DFF}; pg8::gemm_phase<pg8::EpiSwiglu, pg8::StaticOrder, true, true>(lds, g, S, E); }
    SEAM(9);
    if (IN(10)) { pg8::Gemm g{(const bf16*)(ws + WS_HFF), (const bf16*)(ws + WS_WDOWN), M, D, DFF}; pg8::StaticOrder S; S.init(M, D, G, (int)blockIdx.x);
                  pg8::EpiResid E{a.out + OUT_Y, a.out + OUT_Y + (size_t)MP * D, a.out + OUT_Y, (const float*)(ws + WS_MOD) + 5120}; pg8::gemm_phase<pg8::EpiResid, pg8::StaticOrder, true, true>(lds, g, S, E); }
    SEAM(10);
    if (IN(11)) phase_modnorm<2>(a, lds, tid, lane, wave);
#undef IN
#undef SEAM
}

extern "C" void kernel_launch(void* const* d_in, const int* in_sizes, int n_in, void* d_out, int out_size, void* d_ws, size_t ws_size, hipStream_t stream) {
    static int grid = 0;
    if (grid == 0) {
        int dev = 0, cus = 0, per_cu = 0;
        (void)hipGetDevice(&dev); (void)hipDeviceGetAttribute(&cus, hipDeviceAttributeMultiprocessorCount, dev);
        (void)hipFuncSetAttribute((const void*)fwd_mega, hipFuncAttributeMaxDynamicSharedMemorySize, LDS_BYTES);
        (void)hipOccupancyMaxActiveBlocksPerMultiprocessor(&per_cu, (const void*)fwd_mega, NTHR, LDS_BYTES);
        grid = cus * (per_cu < 1 ? 1 : 1);
        if (n_in != 36 || ws_size < WS_END || out_size != (int)OUT_END) fprintf(stderr, "kernel_launch: unexpected sizes n_in %d ws %zu out %d\n", n_in, ws_size, out_size);
    }
    Args a{};
    for (int i = 0; i < 36; ++i) a.in[i] = (const float*)d_in[i];
    a.out = (float*)d_out; a.ws = (unsigned char*)d_ws;
    const float* const* in = a.in; unsigned char* ws = a.ws; float* out = a.out;
    a.flags = 3; a.ph_lo = 0; a.ph_hi = NPHASE;
    void* kargs[] = {&a};
    const hipError_t e = hipLaunchCooperativeKernel((const void*)fwd_mega, dim3(grid), dim3(NTHR), kargs, LDS_BYTES, stream);
    if (e != hipSuccess) fprintf(stderr, "kernel_launch: cooperative launch failed: %s (grid %d)\n", hipGetErrorString(e), grid);
    (void)in; (void)ws; (void)out;
}
```

```cpp
#include <hip/hip_runtime.h>
#include <hip/hip_cooperative_groups.h>
#include <cstdio>
#include <cstdint>
namespace cg = cooperative_groups;
#ifndef PROBE_REP
#define PROBE_REP 0
#endif
#ifndef PROBE_PH
#define PROBE_PH -1
#endif
#define EXTRA_BAR2 0
#define DIAG_NAIVE 0
#define USE_CG_SYNC 0
#define DELAY_AFTER4 0
#define BARRIER_WG_RELEASE 0
#define TAIL_FIRST_P2 1
#define TAIL_FIRST_P7 0
#define TAIL_FIRST_P10 0
#ifndef DBG_FLAGS
#define DBG_FLAGS 3
#endif

constexpr int D = 1024, NP = 8, LP = 2048, NS = 128, LS = 4, NSEQ = NP + NS;
constexpr int MP = NP * LP, MS = NS * LS, M = MP + MS;
constexpr int H = 8, PD = 64, NST = 128, NG = 2, DSSD = 512, CONVD = 1024;
constexpr int G5 = 32, CH5 = 16, P5 = 64, DS5 = 512;
constexpr int DFF = 2816, INP = 2056, O1 = 512, O2 = 1536, O3 = 1544;
constexpr int NPROJ = 2048;
constexpr int NMOD = 8192;
constexpr float EPS = 1e-6f;
constexpr size_t OUT_Y = 0, OUT_SSDP = (size_t)M * D, OUT_SSDS = OUT_SSDP + (size_t)NP * H * PD * NST, OUT_CONVP = OUT_SSDS + (size_t)NS * H * PD * NST,
                 OUT_CONVS = OUT_CONVP + (size_t)NP * 3 * CONVD, OUT_REP = OUT_CONVS + (size_t)NS * 3 * CONVD, OUT_RES = OUT_REP + (size_t)NP * G5 * P5,
                 OUT_IMP = OUT_RES + (size_t)NS * G5 * P5, OUT_IMS = OUT_IMP + (size_t)NP * G5 * P5, OUT_END = OUT_IMS + (size_t)NS * G5 * P5;
constexpr size_t MiB = 1u << 20;
constexpr size_t WS_CTL = 0, WS_MOD = 1 * MiB, WS_DT = 6 * MiB, WS_BB = 7 * MiB, WS_CC = WS_BB + 256 * 1024, WS_AB = WS_CC + 256 * 1024, WS_SC = 6 * MiB + 640 * 1024  , WS_ACS = 8 * MiB, WS_S5E = 9 * MiB, WS_SCL = 11 * MiB  ,
                 WS_WIN = 12 * MiB, WS_WGLU = 16 * MiB, WS_WOUT = 17 * MiB, WS_WUP = 19 * MiB, WS_WDOWN = 30 * MiB,
                 WS_U = 36 * MiB, WS_CS = 36 * MiB, WS_PROJ = 69 * MiB, WS_XC = 135 * MiB, WS_HFF = 69 * MiB, WS_MIX = 168 * MiB, WS_GY = 201 * MiB, WS_G = 218 * MiB, WS_X1B = 201 * MiB  , WS_INIT = 234 * MiB  , WS_END = 256 * MiB;
constexpr int CW_P7 = 4096, CW_P10 = 8192, CW_T7 = 12288, CW_T10 = 13312;
constexpr size_t WS_XB7 = 256 * 1024, WS_XB10 = 512 * 1024, WS_XT7 = 768 * 1024, WS_XT10 = 832 * 1024;
static_assert(WS_MOD + (size_t)NSEQ * NMOD * 4 <= WS_DT && WS_DT + (size_t)M * 8 * 4 <= WS_BB && WS_WDOWN + (size_t)D * DFF * 2 <= WS_U && WS_U + (size_t)M * D * 2 <= WS_PROJ, "ws map 1");
static_assert(WS_X1B + (size_t)M * D * 2 <= WS_END, "ws map 3");
static_assert(WS_PROJ + (size_t)M * NPROJ * 2 <= WS_XC && WS_XC + (size_t)M * CONVD * 2 <= WS_MIX && WS_HFF + (size_t)M * DFF * 2 <= WS_MIX && WS_MIX + (size_t)M * D * 2 <= WS_GY && WS_GY + (size_t)M * DS5 * 2 <= WS_G, "ws map 2");

typedef unsigned short bf16;
__device__ __host__ __forceinline__ int seq_of_row(int r) { return r < MP ? r / LP : NP + (r - MP) / LS; }
__device__ __forceinline__ float siluf(float v) { return v / (1.f + expf(-v)); }
__device__ __forceinline__ float softplusf(float v) { return v > 20.f ? v : log1pf(expf(v)); }
__device__ __forceinline__ float bf2f(bf16 b) { return __uint_as_float(((unsigned)b) << 16); }
__device__ __forceinline__ unsigned f2bf(float f) { unsigned u = __float_as_uint(f); return (u + 0x7fffu + ((u >> 16) & 1u)) >> 16; }
typedef __bf16 bf16x2_t __attribute__((ext_vector_type(2)));
__device__ __forceinline__ unsigned pk2(float lo, float hi) { const bf16x2_t r = __builtin_convertvector((__attribute__((ext_vector_type(2))) float){lo, hi}, bf16x2_t); return __builtin_bit_cast(unsigned, r); }
__device__ __forceinline__ float bflo(unsigned w) { return __uint_as_float(w << 16); }
__device__ __forceinline__ float bfhi(unsigned w) { return __uint_as_float(w & 0xffff0000u); }
__device__ __forceinline__ float sigm(float v) { return __builtin_amdgcn_rcpf(1.f + __expf(-v)); }

namespace pg8 {
#define PG8_LAS __attribute__((address_space(3)))
typedef unsigned short bf16_t;
typedef short bf16x8 __attribute__((ext_vector_type(8)));
typedef float f32x4 __attribute__((ext_vector_type(4)));
typedef unsigned u32x4 __attribute__((ext_vector_type(4)));
constexpr int BM = 256, BK = 64, HALF = 128, HTB = HALF * BK * 2  , STAGE_BYTES = 8 * HTB, NXCD = 8, WGM = 8;

__host__ __device__ __forceinline__ int lds_byte(int r, int c) { const int st = (r >> 4) * 2 + (c >> 5), rr = r & 15, cc = c & 31, ob = rr * 64 + cc * 2; return st * 1024 + (ob ^ (((ob >> 9) & 1) << 5)); }
__host__ __device__ __forceinline__ void stage_rc(int b, int& R, int& C) { const int st = b / 1024, sb = b % 1024, swz = sb ^ (((sb >> 9) & 1) << 5); R = (st >> 1) * 16 + swz / 64; C = (st & 1) * 32 + (swz % 64) / 2; }
__host__ __device__ __forceinline__ int perm32(int rho) { const int n = rho >> 4, i = rho & 15; return 8 * (i >> 2) + 4 * n + (i & 3); }

struct Unit { int pm, pn; };
struct Gemm { const bf16_t* A; const bf16_t* Bt; int M, N, K; };

struct StaticOrder {
    int nM, nN, nwg, G, c;
    __host__ __device__ void init(int M, int N, int G_, int c_) { nM = M / BM; nN = N / BM; nwg = nM * nN; G = G_; c = c_; }
    __host__ __device__ bool next(int i, Unit& u) const {
        const long L = (long)i * G + c; if (L >= nwg) return false;
        int wgid = (int)L; { const int q = nwg / NXCD, r = nwg % NXCD, xcd = wgid % NXCD, off = wgid / NXCD; wgid = (xcd < r ? xcd * (q + 1) : r * (q + 1) + (xcd - r) * q) + off; }
        const int nig = WGM * nN, gid = wgid / nig, fm = gid * WGM, gsz = (nM - fm) < WGM ? (nM - fm) : WGM;
        u.pm = fm + ((wgid % nig) % gsz); u.pn = (wgid % nig) / gsz; return true;
    }
    __device__ __forceinline__ void a_ready(const Unit&) const {}
    __device__ __forceinline__ void done(const Unit&) const {}
};
__device__ __forceinline__ unsigned cvt_pk_bf16(float lo, float hi) { unsigned r; asm volatile("v_cvt_pk_bf16_f32 %0, %1, %2" : "=v"(r) : "v"(lo), "v"(hi)); return r; }
struct EpiBf16 {
    static constexpr bool PERM = true, AFTER_DRAIN = false;
    bf16_t* O; int ldc;
    __device__ __forceinline__ void operator()(const f32x4 (&acc)[2][2][4][2], const Unit& u, int wr, int wc, int fr, int fq) const {
        const int row0 = u.pm * BM + wr * 64 + fr, col0 = u.pn * BM + wc * 32 + 8 * fq;
#pragma unroll
        for (int ai = 0; ai < 2; ++ai)
#pragma unroll
            for (int m = 0; m < 4; ++m) { bf16_t* rowp = O + (size_t)(row0 + ai * HALF + m * 16) * ldc + col0;
#pragma unroll
                for (int bj = 0; bj < 2; ++bj) { const f32x4 v0 = acc[ai][bj][m][0], v1 = acc[ai][bj][m][1];
                    u32x4 w; w.x = cvt_pk_bf16(v0[0], v0[1]); w.y = cvt_pk_bf16(v0[2], v0[3]); w.z = cvt_pk_bf16(v1[0], v1[1]); w.w = cvt_pk_bf16(v1[2], v1[3]);
                    *(u32x4*)(rowp + bj * HALF) = w; } }
    }
};
struct EpiGlu {
    static constexpr bool PERM = true, AFTER_DRAIN = false;
    const bf16_t* GY; bf16_t* MIX; const float* bias;
    __device__ __forceinline__ void operator()(const f32x4 (&acc)[2][2][4][2], const Unit& u, int wr, int wc, int fr, int fq) const {
        const int row0 = u.pm * BM + wr * 64 + fr, col0 = u.pn * BM + wc * 32 + 8 * fq;
#pragma unroll
        for (int bj = 0; bj < 2; ++bj) { const int col = col0 + bj * HALF; const f32x4 b0 = *(const f32x4*)(bias + col), b1 = *(const f32x4*)(bias + col + 4);
#pragma unroll
            for (int ai = 0; ai < 2; ++ai)
#pragma unroll
                for (int m = 0; m < 4; ++m) { const size_t row = (size_t)(row0 + ai * HALF + m * 16);
                    const u32x4 g = *(const u32x4*)(GY + row * 512 + col); const f32x4 v0 = acc[ai][bj][m][0] + b0, v1 = acc[ai][bj][m][1] + b1;
                    u32x4 w; w.x = cvt_pk_bf16(bflo(g.x) * sigm(v0[0]), bfhi(g.x) * sigm(v0[1])); w.y = cvt_pk_bf16(bflo(g.y) * sigm(v0[2]), bfhi(g.y) * sigm(v0[3]));
                             w.z = cvt_pk_bf16(bflo(g.z) * sigm(v1[0]), bfhi(g.z) * sigm(v1[1])); w.w = cvt_pk_bf16(bflo(g.w) * sigm(v1[2]), bfhi(g.w) * sigm(v1[3]));
                    *(u32x4*)(MIX + row * 1024 + 512 + col) = w; } }
    }
};
struct EpiResid {
    static constexpr bool PERM = false, AFTER_DRAIN = false;
    const float* xa; const float* xb; float* out; const float* gate;
    static constexpr int MPROWS = 16384, NMODS = 8192;
    __device__ __forceinline__ void operator()(const f32x4 (&acc)[2][2][4][2], const Unit& u, int wr, int wc, int fr, int fq) const {
        const int row0 = u.pm * BM + wr * 64 + fr, col0 = u.pn * BM + wc * 32 + 4 * fq;
#pragma unroll
        for (int ai = 0; ai < 2; ++ai)
#pragma unroll
            for (int m = 0; m < 4; ++m) { const int row = row0 + ai * HALF + m * 16; const int s = row < MPROWS ? row / 2048 : 8 + (row - MPROWS) / 4;
                const float* res = row < MPROWS ? xa + (size_t)row * 1024 : xb + (size_t)(row - MPROWS) * 1024; const float* gp = gate + (size_t)s * NMODS; float* op = out + (size_t)row * 1024;
#pragma unroll
                for (int bj = 0; bj < 2; ++bj)
#pragma unroll
                    for (int n = 0; n < 2; ++n) { const int col = col0 + bj * HALF + n * 16; const f32x4 r = *(const f32x4*)(res + col), g = *(const f32x4*)(gp + col);
                        *(f32x4*)(op + col) = r + g * acc[ai][bj][m][n]; } }
    }
};
struct EpiSwiglu {
    static constexpr bool PERM = true, AFTER_DRAIN = false;
    bf16_t* Hf; int ldc;
    __device__ __forceinline__ void operator()(const f32x4 (&acc)[2][2][4][2], const Unit& u, int wr, int wc, int fr, int fq) const {
        const int row0 = u.pm * BM + wr * 64 + fr, col0 = u.pn * HALF + wc * 32 + 8 * fq;
#pragma unroll
        for (int ai = 0; ai < 2; ++ai)
#pragma unroll
            for (int m = 0; m < 4; ++m) { const f32x4 g0 = acc[ai][0][m][0], g1 = acc[ai][0][m][1], u0 = acc[ai][1][m][0], u1 = acc[ai][1][m][1];
                u32x4 w; w.x = cvt_pk_bf16(g0[0] * sigm(g0[0]) * u0[0], g0[1] * sigm(g0[1]) * u0[1]); w.y = cvt_pk_bf16(g0[2] * sigm(g0[2]) * u0[2], g0[3] * sigm(g0[3]) * u0[3]);
                         w.z = cvt_pk_bf16(g1[0] * sigm(g1[0]) * u1[0], g1[1] * sigm(g1[1]) * u1[1]); w.w = cvt_pk_bf16(g1[2] * sigm(g1[2]) * u1[2], g1[3] * sigm(g1[3]) * u1[3]);
                *(u32x4*)(Hf + (size_t)(row0 + ai * HALF + m * 16) * ldc + col0) = w; }
    }
};


template <int MODE> struct EpiResNorm {
    static constexpr bool PERM = false, AFTER_DRAIN = true;
    const void* res; const float* mod; int gate_off, sh_off, sc_off; const float* gam;
    bf16_t* xout; bf16_t* vout; float* yout;
    unsigned* xbuf; unsigned* cnt; float eps;
    __device__ __forceinline__ void fused(f32x4 (&acc)[2][2][4][2], const Unit& u, int wr, int wc, int fr, int fq, PG8_LAS unsigned char* lds, int wid, int lane) const {
        PG8_LAS float* P = (PG8_LAS float*)lds;
        PG8_LAS float* S = (PG8_LAS float*)(lds + 8192);
        const int col0 = u.pn * BM + wc * 32 + 4 * fq, s = (u.pm * BM) / 2048;
        const float* ms = mod + (size_t)s * 8192;
        {   f32x4 gt[2][2];
#pragma unroll
            for (int bj = 0; bj < 2; ++bj)
#pragma unroll
                for (int n = 0; n < 2; ++n) gt[bj][n] = *(const f32x4*)(ms + gate_off + col0 + bj * HALF + n * 16);
#pragma unroll
            for (int ai = 0; ai < 2; ++ai)
#pragma unroll
                for (int m = 0; m < 4; ++m) { const int rl = ai * HALF + wr * 64 + m * 16 + fr; const size_t ro = (size_t)(u.pm * BM + rl) * 1024 + col0; float q = 0.f;
#pragma unroll
                    for (int bj = 0; bj < 2; ++bj)
#pragma unroll
                        for (int n = 0; n < 2; ++n) { f32x4 r; if (MODE == 0) r = *(const f32x4*)((const float*)res + ro + bj * HALF + n * 16);
                            else { typedef unsigned u32x2w __attribute__((ext_vector_type(2))); const u32x2w rb = *(const u32x2w*)((const bf16_t*)res + ro + bj * HALF + n * 16); r = (f32x4){bflo(rb.x), bfhi(rb.x), bflo(rb.y), bfhi(rb.y)}; }
                            const f32x4 x1 = r + gt[bj][n] * acc[ai][bj][m][n]; acc[ai][bj][m][n] = x1;
                            q += (x1[0] * x1[0] + x1[1] * x1[1]) + (x1[2] * x1[2] + x1[3] * x1[3]); }
                    q += __shfl_xor(q, 16); q += __shfl_xor(q, 32);
                    if (fq == 0) P[rl * 4 + wc] = q;
                    if (m & 1) asm volatile("" ::: "memory"); }
        }
        asm volatile("s_waitcnt lgkmcnt(0)" ::: "memory"); __builtin_amdgcn_s_barrier(); asm volatile("" ::: "memory");
        const int row = wid * 32 + (lane & 31);
        if (lane < 32) { const f32x4 p = *(const PG8_LAS f32x4*)(P + row * 4); const float t = (p[0] + p[1]) + (p[2] + p[3]);
            __hip_atomic_store(xbuf + ((size_t)(u.pm * BM + row) * 4 + u.pn), __float_as_uint(t), __ATOMIC_RELAXED, __HIP_MEMORY_SCOPE_AGENT); }
        asm volatile("s_waitcnt vmcnt(0)" ::: "memory");
        if (lane == 0) __hip_atomic_fetch_add(cnt + 64 * u.pm, 1u, __ATOMIC_RELAXED, __HIP_MEMORY_SCOPE_AGENT);
        if (wid == 0) { unsigned sp = 0;
            while ((unsigned)__builtin_amdgcn_readfirstlane(__hip_atomic_load(cnt + 64 * u.pm, __ATOMIC_RELAXED, __HIP_MEMORY_SCOPE_AGENT)) < 32u) { __builtin_amdgcn_s_sleep(2); if (++sp > (1u << 22)) break; }
            __builtin_amdgcn_fence(__ATOMIC_ACQUIRE, "agent"); }
        asm volatile("s_waitcnt vmcnt(0) lgkmcnt(0)" ::: "memory"); __builtin_amdgcn_s_barrier(); asm volatile("" ::: "memory");
        if (lane < 32) { const unsigned* sl = xbuf + (size_t)(u.pm * BM + row) * 4; float t = 0.f;
#pragma unroll
            for (int k = 0; k < 4; ++k) t += __uint_as_float(__hip_atomic_load(sl + k, __ATOMIC_RELAXED, __HIP_MEMORY_SCOPE_AGENT));
            S[row] = 1.0f / sqrtf(t * (1.0f / 1024.0f) + eps); }
        asm volatile("s_waitcnt lgkmcnt(0)" ::: "memory"); __builtin_amdgcn_s_barrier(); asm volatile("" ::: "memory");
        f32x4 scl[2][2], shf[2][2];
#pragma unroll
        for (int bj = 0; bj < 2; ++bj)
#pragma unroll
            for (int n = 0; n < 2; ++n) { const int c = col0 + bj * HALF + n * 16; scl[bj][n] = *(const f32x4*)(gam + c) * (*(const f32x4*)(ms + sc_off + c) + 1.0f); shf[bj][n] = *(const f32x4*)(ms + sh_off + c); }
#pragma unroll
        for (int ai = 0; ai < 2; ++ai)
#pragma unroll
            for (int m = 0; m < 4; ++m) { const int rl = ai * HALF + wr * 64 + m * 16 + fr; const float rs = S[rl]; const size_t off = (size_t)(u.pm * BM + rl) * 1024 + col0;
#pragma unroll
                for (int bj = 0; bj < 2; ++bj)
#pragma unroll
                    for (int n = 0; n < 2; ++n) { const f32x4 x1 = acc[ai][bj][m][n]; const f32x4 v = x1 * rs * scl[bj][n] + shf[bj][n];
                        if (MODE == 0) { typedef unsigned u32x2v __attribute__((ext_vector_type(2))); u32x2v xw; xw.x = cvt_pk_bf16(x1[0], x1[1]); xw.y = cvt_pk_bf16(x1[2], x1[3]); *(u32x2v*)(xout + off + bj * HALF + n * 16) = xw;
                            u32x2v w; w.x = cvt_pk_bf16(v[0], v[1]); w.y = cvt_pk_bf16(v[2], v[3]); *(u32x2v*)(vout + off + bj * HALF + n * 16) = w; }
                        else *(f32x4*)(yout + off + bj * HALF + n * 16) = v; } }
    }
};
template <class Epi, class Sched, bool ALIGN_EPI = false, bool SP2 = false>
__device__ __forceinline__ void gemm_phase(PG8_LAS unsigned char* lds, const Gemm g, const Sched& S, const Epi& E) {
    const int tid = threadIdx.x, wid = __builtin_amdgcn_readfirstlane(tid >> 6), lane = tid & 63, wr = wid >> 2, wc = wid & 3, fr = lane & 15, fq = lane >> 4;
    const int K = g.K, nt = K / BK;
    unsigned voffA[2], voffB[2];
#pragma unroll
    for (int i = 0; i < 2; ++i) { int R, C; stage_rc(tid * 16 + i * 8192, R, C); const int Rb = Epi::PERM ? ((R & ~31) + perm32(R & 31)) : R;
        voffA[i] = (unsigned)(R * K + C) * 2u; voffB[i] = (unsigned)(Rb * K + C) * 2u; }
    const size_t kstep = (size_t)(BK * 2);
    const size_t hstep = (size_t)HALF * K * 2;
    const size_t tstep = 2 * hstep;
    const unsigned ldsw = (unsigned)wid * 1024u;
    const int aoff = lds_byte(wr * 64 + fr, fq * 8), boff = lds_byte(wc * 32 + fr, fq * 8);
#define PG8_SA(b, h) (((b) * 2 + (h)) * HTB)
#define PG8_SB(b, h) ((4 + (b) * 2 + (h)) * HTB)
#define PG8_STAGE(bufoff, gbase, voff) do { _Pragma("unroll") for (int _i = 0; _i < 2; ++_i) \
        __builtin_amdgcn_global_load_lds((const unsigned*)((const char*)(gbase) + (voff)[_i]), (PG8_LAS unsigned*)(lds + (bufoff) + ldsw + _i * 8192), 16, 0, 0); } while (0)
#define PG8_LDA(dst, b, h) do { _Pragma("unroll") for (int m = 0; m < 4; ++m) _Pragma("unroll") for (int k = 0; k < 2; ++k) dst[m][k] = *(const PG8_LAS bf16x8*)(lds + PG8_SA(b, h) + aoff + m * 2048 + k * 1024); } while (0)
#define PG8_LDB(dst, b, h) do { _Pragma("unroll") for (int n = 0; n < 2; ++n) _Pragma("unroll") for (int k = 0; k < 2; ++k) dst[n][k] = *(const PG8_LAS bf16x8*)(lds + PG8_SB(b, h) + boff + n * 2048 + k * 1024); } while (0)
#define PG8_MMA(ai, bj, At, Bt) do { __builtin_amdgcn_s_setprio(1); _Pragma("unroll") for (int m = 0; m < 4; ++m) _Pragma("unroll") for (int n = 0; n < 2; ++n) _Pragma("unroll") for (int k = 0; k < 2; ++k) \
        acc[ai][bj][m][n] = __builtin_amdgcn_mfma_f32_16x16x32_bf16(Bt[n][k], At[m][k], acc[ai][bj][m][n], 0, 0, 0); __builtin_amdgcn_s_setprio(0); } while (0)
#define PG8_WAIT_V(n) asm volatile("s_waitcnt vmcnt(" #n ")" ::: "memory")
#define PG8_WAIT_L(n) asm volatile("s_waitcnt lgkmcnt(" #n ")" ::: "memory")
#define PG8_BAR __builtin_amdgcn_s_barrier()
#define PG8_SCHED __builtin_amdgcn_sched_barrier(0)
    Unit cur, nxt; int ui = 0;
    if (!S.next(0, cur)) return;
    f32x4 acc[2][2][4][2];
#pragma unroll
    for (int a = 0; a < 2; ++a)
#pragma unroll
        for (int b = 0; b < 2; ++b)
#pragma unroll
            for (int m = 0; m < 4; ++m)
#pragma unroll
                for (int n = 0; n < 2; ++n) acc[a][b][m][n] = (f32x4){0.f, 0.f, 0.f, 0.f};
    bf16x8 At[4][2], B0[2][2], B1[2][2];
    const char* cA = (const char*)g.A + (size_t)cur.pm * tstep; const char* cB = (const char*)g.Bt + (size_t)cur.pn * tstep;
    S.a_ready(cur);
    if constexpr (SP2) {
        PG8_STAGE(PG8_SB(0, 0), cB, voffB); PG8_STAGE(PG8_SB(0, 1), cB + hstep, voffB); PG8_STAGE(PG8_SA(0, 0), cA, voffA); PG8_STAGE(PG8_SA(0, 1), cA + hstep, voffA);
        if (wr == 1) PG8_BAR;
        PG8_WAIT_V(2); PG8_BAR;
        PG8_STAGE(PG8_SB(1, 0), cB + kstep, voffB); PG8_STAGE(PG8_SA(1, 0), cA + kstep, voffA); PG8_STAGE(PG8_SB(1, 1), cB + hstep + kstep, voffB);
        PG8_WAIT_V(6); PG8_BAR;
    } else {
        PG8_STAGE(PG8_SB(0, 0), cB, voffB); PG8_STAGE(PG8_SA(0, 0), cA, voffA); PG8_STAGE(PG8_SB(0, 1), cB + hstep, voffB); PG8_STAGE(PG8_SA(0, 1), cA + hstep, voffA);
        if (wr == 1) PG8_BAR;
        PG8_WAIT_V(4); PG8_BAR;
        PG8_STAGE(PG8_SB(1, 0), cB + kstep, voffB); PG8_STAGE(PG8_SA(1, 0), cA + kstep, voffA); PG8_STAGE(PG8_SB(1, 1), cB + hstep + kstep, voffB);
        PG8_WAIT_V(6); PG8_BAR;
    }
    for (;;) {
        const bool has_next = S.next(ui + 1, nxt);
        const char* nA = has_next ? (const char*)g.A + (size_t)nxt.pm * tstep : cA; const char* nB = has_next ? (const char*)g.Bt + (size_t)nxt.pn * tstep : cB;
        for (int t = 0; t < nt; t += 2) {
            const bool last = (t == nt - 2);
            const char* a1 = cA + (size_t)(t + 1) * kstep;
            const char* a2 = last ? nA : cA + (size_t)(t + 2) * kstep; const char* b2 = last ? nB : cB + (size_t)(t + 2) * kstep;
            const char* a3 = a2 + kstep; const char* b3 = b2 + kstep;
            if (last && has_next) S.a_ready(nxt);
            if constexpr (SP2) {
            PG8_LDB(B0, 0, 0); PG8_LDB(B1, 0, 1); PG8_SCHED; PG8_LDA(At, 0, 0); PG8_STAGE(PG8_SA(1, 1), a1 + hstep, voffA);
            PG8_WAIT_V(8); PG8_WAIT_L(0); PG8_BAR; PG8_MMA(0, 0, At, B0); PG8_MMA(0, 1, At, B1); PG8_BAR; PG8_SCHED;
            PG8_LDA(At, 0, 1); PG8_STAGE(PG8_SB(0, 0), b2, voffB); PG8_STAGE(PG8_SB(0, 1), b2 + hstep, voffB); PG8_STAGE(PG8_SA(0, 0), a2, voffA);
            PG8_WAIT_V(8); PG8_WAIT_L(0); PG8_BAR; PG8_MMA(1, 0, At, B0); PG8_MMA(1, 1, At, B1); PG8_BAR; PG8_SCHED;
            PG8_LDB(B0, 1, 0); PG8_LDB(B1, 1, 1); PG8_SCHED; PG8_LDA(At, 1, 0); PG8_STAGE(PG8_SA(0, 1), a2 + hstep, voffA);
            PG8_WAIT_V(8); PG8_WAIT_L(0); PG8_BAR; PG8_MMA(0, 0, At, B0); PG8_MMA(0, 1, At, B1); PG8_BAR; PG8_SCHED;
            PG8_LDA(At, 1, 1); PG8_STAGE(PG8_SB(1, 0), b3, voffB); PG8_STAGE(PG8_SB(1, 1), b3 + hstep, voffB); PG8_STAGE(PG8_SA(1, 0), a3, voffA);
            PG8_WAIT_V(8); PG8_WAIT_L(0); PG8_BAR; PG8_MMA(1, 0, At, B0); PG8_MMA(1, 1, At, B1); PG8_BAR; PG8_SCHED;
            } else {
            PG8_LDB(B0, 0, 0); PG8_SCHED; PG8_LDA(At, 0, 0); PG8_STAGE(PG8_SA(1, 1), a1 + hstep, voffA);
            PG8_WAIT_L(8); PG8_BAR; PG8_WAIT_L(0); PG8_MMA(0, 0, At, B0); PG8_BAR; PG8_SCHED;
            PG8_LDB(B1, 0, 1); PG8_STAGE(PG8_SB(0, 0), b2, voffB);
            PG8_BAR; PG8_WAIT_L(0); PG8_MMA(0, 1, At, B1); PG8_BAR;
            PG8_LDA(At, 0, 1); PG8_STAGE(PG8_SA(0, 0), a2, voffA);
            PG8_BAR; PG8_WAIT_L(0); PG8_MMA(1, 0, At, B0); PG8_BAR; PG8_SCHED;
            PG8_STAGE(PG8_SB(0, 1), b2 + hstep, voffB);
            PG8_WAIT_V(6); PG8_BAR; PG8_MMA(1, 1, At, B1); PG8_BAR;
            PG8_LDB(B0, 1, 0); PG8_SCHED; PG8_LDA(At, 1, 0); PG8_STAGE(PG8_SA(0, 1), a2 + hstep, voffA);
            PG8_WAIT_L(8); PG8_BAR; PG8_WAIT_L(0); PG8_MMA(0, 0, At, B0); PG8_BAR; PG8_SCHED;
            PG8_LDB(B1, 1, 1); PG8_STAGE(PG8_SB(1, 0), b3, voffB);
            PG8_BAR; PG8_WAIT_L(0); PG8_MMA(0, 1, At, B1); PG8_BAR;
            PG8_LDA(At, 1, 1); PG8_STAGE(PG8_SA(1, 0), a3, voffA);
            PG8_BAR; PG8_WAIT_L(0); PG8_MMA(1, 0, At, B0); PG8_BAR; PG8_SCHED;
            PG8_STAGE(PG8_SB(1, 1), b3 + hstep, voffB);
            PG8_WAIT_V(6); PG8_BAR; PG8_MMA(1, 1, At, B1); PG8_BAR;
            }
        }
        if constexpr (ALIGN_EPI) { if (wr == 0) PG8_BAR; }
        if constexpr (!Epi::AFTER_DRAIN) { E(acc, cur, wr, wc, fr, fq); S.done(cur); }
        if (!has_next) break;
#pragma unroll
        for (int a = 0; a < 2; ++a)
#pragma unroll
            for (int b = 0; b < 2; ++b)
#pragma unroll
                for (int m = 0; m < 4; ++m)
#pragma unroll
                    for (int n = 0; n < 2; ++n) acc[a][b][m][n] = (f32x4){0.f, 0.f, 0.f, 0.f};
        cur = nxt; cA = nA; cB = nB; ++ui;
        if constexpr (ALIGN_EPI) { if (wr == 1) PG8_BAR; }
    }
    PG8_WAIT_V(0);
    if constexpr (!ALIGN_EPI) { if (wr == 0) PG8_BAR; }
    PG8_BAR;
    if constexpr (Epi::AFTER_DRAIN) { E.fused(acc, cur, wr, wc, fr, fq, lds, wid, lane); S.done(cur); }
#undef PG8_SA
#undef PG8_SB
#undef PG8_STAGE
#undef PG8_LDA
#undef PG8_LDB
#undef PG8_MMA
#undef PG8_WAIT_V
#undef PG8_WAIT_L
#undef PG8_BAR
#undef PG8_SCHED
}
}
#define LAS __attribute__((address_space(3)))
typedef unsigned v4u __attribute__((ext_vector_type(4)));
typedef float f32x4 __attribute__((ext_vector_type(4)));
typedef float f32x2 __attribute__((ext_vector_type(2)));
typedef unsigned u32x2 __attribute__((ext_vector_type(2)));
typedef short bf16x8 __attribute__((ext_vector_type(8)));
constexpr int NWAVES = 8, NTHR = 512;
constexpr int LDS_BYTES = 147456;
#define LDS_WAIT() asm volatile("s_waitcnt lgkmcnt(0)" ::: "memory")

#define XB_TMO      128
#define XB_XCNT(j)  (256  + 64 * (j))
#define XB_XSUB(j)  (1280 + 64 * (j))
#define XB_XGEN(j)  (2304 + 64 * (j))
#define XB_TOP      3328
#define XB_TOPGEN   3392
#define XCD_BAR_WORDS 3456
#define XB_SPIN_CAP (1u << 18)

__device__ __forceinline__ unsigned xb_ld(unsigned* p)              { return __hip_atomic_load(p, __ATOMIC_RELAXED, __HIP_MEMORY_SCOPE_AGENT); }
__device__ __forceinline__ unsigned xb_add(unsigned* p, unsigned v) { return __hip_atomic_fetch_add(p, v, __ATOMIC_RELAXED, __HIP_MEMORY_SCOPE_AGENT); }
__device__ __forceinline__ unsigned xb_xcc_id() { return (unsigned)__builtin_amdgcn_s_getreg((3 << 11) | 20) & 0xFu; }
#define XB_SPIN(cond, bar) do { unsigned _sp = 0; while (cond) { __builtin_amdgcn_s_sleep(1); \
    if ((++_sp & 255u) == 0u) { if (xb_ld(&(bar)[XB_TMO])) break; if (_sp > XB_SPIN_CAP) { atomicAdd(&(bar)[XB_TMO], 1u); break; } } } } while (0)

struct XcdBarrier {
    unsigned* bar; unsigned x;
    volatile LAS unsigned* st;
};

__device__ __forceinline__ XcdBarrier xcd_barrier_post(unsigned* bar, volatile LAS unsigned* st) {
    XcdBarrier b; b.bar = bar; b.x = xb_xcc_id(); b.st = st;
    if (threadIdx.x == 0) (void)xb_add(&bar[XB_XCNT(b.x)], 1u);
    return b;
}
__device__ __forceinline__ void xcd_barrier_complete(unsigned* bar, unsigned x, unsigned& nloc, unsigned& nx) {
    const unsigned G = gridDim.x * gridDim.y * gridDim.z;
    unsigned sum, cnt, mine, sp = 0u;
    for (;;) {
        sum = 0u; cnt = 0u; mine = 0u;
#pragma unroll
        for (unsigned j = 0; j < 16; ++j) { const unsigned c = xb_ld(&bar[XB_XCNT(j)]); sum += c; cnt += (c > 0u) ? 1u : 0u; mine = (j == x) ? c : mine; }
        if (sum == G) break;
        __builtin_amdgcn_s_sleep(1);
        if ((++sp & 255u) == 0u) { if (xb_ld(&bar[XB_TMO])) break; if (sp > XB_SPIN_CAP) { atomicAdd(&bar[XB_TMO], 1u); break; } }
    }
    nloc = mine > 0u ? mine : 1u; nx = cnt > 0u ? cnt : 1u;
}

__device__ __forceinline__ void xcd_barrier(const XcdBarrier& b) {
    asm volatile("s_waitcnt vmcnt(0)" ::: "memory");
    __syncthreads();
    if (threadIdx.x == 0) {
        unsigned* bar = b.bar;
        __builtin_amdgcn_s_waitcnt(0);
        unsigned nloc = b.st[0], nx = b.st[1];
        if (nloc == 0u) { xcd_barrier_complete(bar, b.x, nloc, nx); b.st[0] = nloc; b.st[1] = nx; }
#if BARRIER_WG_RELEASE
        __builtin_amdgcn_fence(__ATOMIC_RELEASE, "agent");
        asm volatile("s_waitcnt vmcnt(0)" ::: "memory");
#endif
        const unsigned old = xb_add(&bar[XB_XSUB(b.x)], 1u);
        const unsigned gen = old / nloc;
        if (old + 1u == (gen + 1u) * nloc) {
            __builtin_amdgcn_fence(__ATOMIC_RELEASE, "agent");
            asm volatile("s_waitcnt vmcnt(0)" ::: "memory");
            const unsigned og = xb_add(&bar[XB_TOP], 1u);
            const unsigned tg = og / nx;
            if (og + 1u == (tg + 1u) * nx) xb_add(&bar[XB_TOPGEN], 1u);
            else XB_SPIN(xb_ld(&bar[XB_TOPGEN]) == tg, bar);
            __builtin_amdgcn_fence(__ATOMIC_ACQUIRE, "agent");
            xb_add(&bar[XB_XGEN(b.x)], 1u);
            asm volatile("s_waitcnt vmcnt(0)" ::: "memory");
        } else {
            XB_SPIN(xb_ld(&bar[XB_XGEN(b.x)]) == gen, bar);
            __builtin_amdgcn_fence(__ATOMIC_ACQUIRE, "agent");
            asm volatile("s_waitcnt vmcnt(0)" ::: "memory");
        }
    }
    __syncthreads();
}

__device__ __forceinline__ f32x4 mfma16(bf16x8 a, bf16x8 b, f32x4 c) { return __builtin_amdgcn_mfma_f32_16x16x32_bf16(a, b, c, 0, 0, 0); }
struct Args { const float* in[36]; float* out; unsigned char* ws; int ph_lo, ph_hi, flags, pad; };
enum { I_XP = 0, I_XS, I_CP, I_CS, I_SSSD, I_SCONV, I_SRE, I_SIM, I_WADA, I_BADA, I_N1G, I_WIN, I_CONVW, I_CONVB, I_DTB, I_ALOG, I_SSDD, I_SSDNG, I_ARE, I_AIM, I_LSTEP, I_BRE, I_BIM,
       I_CRE, I_CIM, I_S5D, I_WGLU, I_BGLU, I_WOUT, I_N2G, I_WGATE, I_WUP, I_WDOWN, I_WADAF, I_BADAF, I_NFG };

__device__ __forceinline__ float wave_sum(float v) {
#pragma unroll
    for (int o = 1; o < 64; o <<= 1) v += __shfl_xor(v, o);
    return v;
}
__device__ __forceinline__ float fsilu0(float v) { return v * __builtin_amdgcn_rcpf(1.f + __expf(-v)); }
__device__ __forceinline__ void transpose_item(const float* src, int ldw, bf16* dst, int K) {
    f32x4 v[32];
#pragma unroll
    for (int i = 0; i < 32; ++i) v[i] = __builtin_nontemporal_load((const f32x4*)(src + (size_t)i * ldw));
#pragma unroll
    for (int j = 0; j < 4; ++j)
#pragma unroll
        for (int q = 0; q < 4; ++q) { v4u o; o.x = pk2(v[8 * q][j], v[8 * q + 1][j]); o.y = pk2(v[8 * q + 2][j], v[8 * q + 3][j]); o.z = pk2(v[8 * q + 4][j], v[8 * q + 5][j]); o.w = pk2(v[8 * q + 6][j], v[8 * q + 7][j]);
            *(v4u*)(dst + (size_t)j * K + 8 * q) = o; }
}

__device__ __forceinline__ unsigned cvtpk(float lo, float hi) { return pk2(lo, hi); }
#if PROBE_PH >= 0
#define PSTAMP(i) do { if (blockIdx.x == 0 && tid == 0) ((volatile LAS unsigned long long*)(lds + 140000))[i] = __builtin_amdgcn_s_memrealtime(); } while (0)
#else
#define PSTAMP(i) do { } while (0)
#endif
__device__ __forceinline__ void phase_prep(const Args& a, LAS unsigned char* lds, int tid, int lane, int wave) {
    unsigned char* ws = a.ws;
    PSTAMP(26);
    {   constexpr int I0 = 32 * 8, I1 = 16 * 2, I2 = 32 * 4, I3 = 32 * 22, I4 = 88 * 4, NIT = I0 + I1 + I2 + I3 + I4;
        for (int it = blockIdx.x * NWAVES + wave; it < NIT; it += gridDim.x * NWAVES) {
            int r = it;
            if (r < I0) { const int kb = r >> 3, nb = r & 7; transpose_item(a.in[I_WIN] + (size_t)(32 * kb) * INP + 256 * nb + (nb >= 6 ? 8 : 0) + 4 * lane, INP, (bf16*)(ws + WS_WIN) + (size_t)(256 * nb + 4 * lane) * 1024 + 32 * kb, 1024); continue; } r -= I0;
            if (r < I1) { const int kb = r >> 1, nb = r & 1; transpose_item(a.in[I_WGLU] + (size_t)(32 * kb) * 512 + 256 * nb + 4 * lane, 512, (bf16*)(ws + WS_WGLU) + (size_t)(256 * nb + 4 * lane) * 512 + 32 * kb, 512); continue; } r -= I1;
            if (r < I2) { const int kb = r >> 2, nb = r & 3; transpose_item(a.in[I_WOUT] + (size_t)(32 * kb) * 1024 + 256 * nb + 4 * lane, 1024, (bf16*)(ws + WS_WOUT) + (size_t)(256 * nb + 4 * lane) * 1024 + 32 * kb, 1024); continue; } r -= I2;
            if (r < I3) { const int kb = r / 22, pn = r % 22; transpose_item((lane < 32 ? a.in[I_WGATE] : a.in[I_WUP]) + (size_t)(32 * kb) * DFF + 128 * pn + 4 * (lane & 31), DFF, (bf16*)(ws + WS_WUP) + (size_t)(256 * pn + 4 * lane) * 1024 + 32 * kb, 1024); continue; } r -= I3;
            { const int kb = r >> 2, nb = r & 3; transpose_item(a.in[I_WDOWN] + (size_t)(32 * kb) * 1024 + 256 * nb + 4 * lane, 1024, (bf16*)(ws + WS_WDOWN) + (size_t)(256 * nb + 4 * lane) * DFF + 32 * kb, DFF); }
        }
        __syncthreads(); PSTAMP(27);
        for (int itx = tid * (int)gridDim.x + (int)blockIdx.x; itx < G5 * P5 * 4; itx += NTHR * (int)gridDim.x) { const int gp = itx >> 2, c0 = (itx & 3) * 4, g = gp / P5, p = gp % P5;
            const float lr = a.in[I_ARE][gp], li = a.in[I_AIM][gp], step = expf(a.in[I_LSTEP][g]);
            const float mag = expf(lr * step), abr = mag * cosf(li * step), abi = mag * sinf(li * step);
            const float nr = abr - 1.f, ni = abi, den = lr * lr + li * li, fr = (nr * lr + ni * li) / den, fi = (ni * lr - nr * li) / den;
            if (c0 == 0) { float* AB = (float*)(ws + WS_AB); AB[2 * gp] = abr; AB[2 * gp + 1] = abi;
                float pr = abr, pi = abi;
#pragma unroll
                for (int q = 0; q < 7; ++q) { const float t = pr * pr - pi * pi; pi = 2.f * pr * pi; pr = t; }
                AB[2 * G5 * P5 + 2 * gp] = pr; AB[2 * G5 * P5 + 2 * gp + 1] = pi; }
            bf16* BB = (bf16*)(ws + WS_BB) + ((size_t)g * 128 + 2 * p) * 16; bf16* CC = (bf16*)(ws + WS_CC) + (size_t)g * 16 * 128 + 2 * p;
            float brv[4], biv[4], crv[4], civ[4];
#pragma unroll
            for (int c = 0; c < 4; ++c) { brv[c] = a.in[I_BRE][(size_t)gp * CH5 + c0 + c]; biv[c] = a.in[I_BIM][(size_t)gp * CH5 + c0 + c]; crv[c] = a.in[I_CRE][((size_t)g * CH5 + c0 + c) * P5 + p]; civ[c] = a.in[I_CIM][((size_t)g * CH5 + c0 + c) * P5 + p]; }
#pragma unroll
            for (int c = 0; c < 4; ++c) { BB[c0 + c] = (bf16)f2bf(fr * brv[c] - fi * biv[c]); BB[16 + c0 + c] = (bf16)f2bf(fr * biv[c] + fi * brv[c]); CC[(c0 + c) * 128] = (bf16)f2bf(crv[c]); CC[(c0 + c) * 128 + 1] = (bf16)f2bf(-civ[c]); } }
    }
    __syncthreads(); PSTAMP(28);
    constexpr int SCP = 264;
    LAS bf16* SC = (LAS bf16*)lds;
    for (int e = tid; e < 8 * SCP / 2; e += NTHR) ((LAS unsigned*)(SC + 136 * SCP))[e] = 0u;
    for (int wb = blockIdx.x; wb < NMOD / 32; wb += gridDim.x) {
        const int j0 = 32 * wb; const bool fin = j0 >= 6144; const float* W = fin ? a.in[I_WADAF] : a.in[I_WADA]; const int ldw = fin ? 2048 : 6144, jc = fin ? j0 - 6144 : j0;
        const float* bias = (fin ? a.in[I_BADAF] : a.in[I_BADA]) + jc;
        const int nt = wave & 1, mg = wave >> 1, fr = lane & 15, fq = lane >> 4;
        f32x4 acc[3];
#pragma unroll
        for (int i = 0; i < 3; ++i) acc[i] = (f32x4){0.f, 0.f, 0.f, 0.f};
#pragma unroll 1
        for (int q = 0; q < 4; ++q) {
            float wv[8][8];
            const float* wp = W + (size_t)(256 * q + 8 * fq) * ldw + jc + 16 * nt + fr;
#pragma unroll
            for (int kk = 0; kk < 8; ++kk)
#pragma unroll
                for (int j = 0; j < 8; ++j) wv[kk][j] = wp[(size_t)(32 * kk + j) * ldw];
            {   f32x4 cv[17];
#pragma unroll
                for (int i = 0; i < 17; ++i) { const int e = tid + NTHR * i, s = e >> 6, k4 = (e & 63) * 4;
                    cv[i] = *(const f32x4*)((s < NP ? a.in[I_CP] + (size_t)s * D : a.in[I_CS] + (size_t)(s - NP) * D) + 256 * q + k4); }
#pragma unroll
                for (int i = 0; i < 17; ++i) { const int e = tid + NTHR * i, s = e >> 6, k4 = (e & 63) * 4;
                    u32x2 w; w.x = cvtpk(fsilu0(cv[i][0]), fsilu0(cv[i][1])); w.y = cvtpk(fsilu0(cv[i][2]), fsilu0(cv[i][3])); *(LAS u32x2*)(SC + s * SCP + k4) = w; } }
            __syncthreads();
#pragma unroll
            for (int kk = 0; kk < 8; ++kk) { v4u bw;
#pragma unroll
                for (int j = 0; j < 4; ++j) bw[j] = cvtpk(wv[kk][2 * j], wv[kk][2 * j + 1]);
                const bf16x8 bfr = __builtin_bit_cast(bf16x8, bw);
#pragma unroll
                for (int i = 0; i < 3; ++i) if (i < 2 || mg == 0) { const bf16x8 afr = *(const LAS bf16x8*)(SC + (16 * (mg + 4 * i) + fr) * SCP + 32 * kk + 8 * fq);
                    acc[i] = __builtin_amdgcn_mfma_f32_16x16x32_bf16(afr, bfr, acc[i], 0, 0, 0); } }
            __syncthreads();
        }
        asm volatile("s_nop 15\n\ts_nop 15" : "+v"(acc[0]), "+v"(acc[1]), "+v"(acc[2]));
        const float bv = bias[16 * nt + fr];
#pragma unroll
        for (int i = 0; i < 3; ++i) if (i < 2 || mg == 0)
#pragma unroll
            for (int r = 0; r < 4; ++r) { const int s = 16 * (mg + 4 * i) + 4 * fq + r; if (s < NSEQ) ((float*)(ws + WS_MOD))[(size_t)s * NMOD + j0 + 16 * nt + fr] = acc[i][r] + bv; }
    }
    __syncthreads(); PSTAMP(29);
}

template <int MODE> __device__ __forceinline__ const float* modnorm_src(const Args& a, int row) {
    return MODE == 0 ? (row < MP ? a.in[I_XP] + (size_t)row * D : a.in[I_XS] + (size_t)(row - MP) * D) : a.out + OUT_Y + (size_t)row * D; }
template <int MODE> __device__ __forceinline__ void modnorm_apply(const Args& a, int row, int lane, const LAS float* wdt, f32x4 (&v)[4]) {
    unsigned char* ws = a.ws; const float* mod = (const float*)(ws + WS_MOD);
    const int sh_off = MODE == 0 ? 0 : (MODE == 1 ? 3072 : 6144), sc_off = sh_off + 1024;
    const float* gam = a.in[MODE == 0 ? I_N1G : (MODE == 1 ? I_N2G : I_NFG)];
    const int s = seq_of_row(row);
    float ss = 0.f;
#pragma unroll
    for (int j = 0; j < 4; ++j) ss += (v[j][0] * v[j][0] + v[j][1] * v[j][1]) + (v[j][2] * v[j][2] + v[j][3] * v[j][3]);
    const float inv = rsqrtf(wave_sum(ss) * (1.f / D) + EPS);
    const float* ms = mod + (size_t)s * NMOD;
#pragma unroll
    for (int j = 0; j < 4; ++j) { const int c = 4 * lane + 256 * j; const f32x4 g = *(const f32x4*)(gam + c), sc = *(const f32x4*)(ms + sc_off + c), sh = *(const f32x4*)(ms + sh_off + c);
        v[j] = v[j] * inv * g * (sc + 1.f) + sh; }
    if (MODE == 2) {
#pragma unroll
        for (int j = 0; j < 4; ++j) *(f32x4*)(a.out + OUT_Y + (size_t)row * D + 4 * lane + 256 * j) = v[j];
    } else {
        bf16* o = (bf16*)(ws + WS_U) + (size_t)row * D;
#pragma unroll
        for (int j = 0; j < 4; ++j) { u32x2 w; w.x = pk2(v[j][0], v[j][1]); w.y = pk2(v[j][2], v[j][3]); *(u32x2*)(o + 4 * lane + 256 * j) = w; }
    }
    if (MODE == 0) {
        float mine = 0.f;
#pragma unroll
        for (int h = 0; h < 8; ++h) { float d = 0.f;
#pragma unroll
            for (int j = 0; j < 4; ++j) { const f32x4 w = *(const LAS f32x4*)(wdt + h * 1024 + 4 * lane + 256 * j); d += (v[j][0] * w[0] + v[j][1] * w[1]) + (v[j][2] * w[2] + v[j][3] * w[3]); }
            d = wave_sum(d); if (lane == h) mine = d; }
        if (lane < 8) ((float*)(ws + WS_DT))[(size_t)row * 8 + lane] = mine;
    }
}
template <int MODE> __device__ __forceinline__ void modnorm_row(const Args& a, int row, int lane, const LAS float* wdt) {
    const float* x = modnorm_src<MODE>(a, row); f32x4 v[4];
#pragma unroll
    for (int j = 0; j < 4; ++j) v[j] = *(const f32x4*)(x + 4 * lane + 256 * j);
    modnorm_apply<MODE>(a, row, lane, wdt, v);
}
template <int MODE> __device__ __forceinline__ void phase_modnorm(const Args& a, LAS unsigned char* lds, int tid, int lane, int wave) {
    LAS float* wdt = (LAS float*)lds;
    if (MODE == 0) { for (int e = tid; e < 8192; e += NTHR) { const int k = e >> 3, h = e & 7; wdt[h * 1024 + k] = a.in[I_WIN][(size_t)k * INP + O2 + h]; } __syncthreads(); }
    const int gw = blockIdx.x * NWAVES + wave, NGW = gridDim.x * NWAVES;
    for (int row = gw; row < M; row += NGW) modnorm_row<MODE>(a, row, lane, wdt);
}

#if PROBE_PH >= 0
#define SUBSTAMP(i) do { if (blockIdx.x == 0 && threadIdx.x == 0) ((volatile LAS unsigned long long*)((LAS unsigned char*)lds + (LDS_BYTES - 512)))[i] = __builtin_amdgcn_s_memrealtime(); } while (0)
#else
#define SUBSTAMP(i) do { } while (0)
#endif
#define MFMA_SETTLE(x) asm volatile("s_nop 15\n\ts_nop 15" : "+v"(x))
constexpr int PT = 136;
typedef float f32x16 __attribute__((ext_vector_type(16)));
__device__ __forceinline__ bf16x8 ldfrag(const LAS bf16* base, int row, int k) { return *(const LAS bf16x8*)(base + row * PT + k); }
__device__ __forceinline__ float fsilu(float v) { return v * __builtin_amdgcn_rcpf(1.f + __expf(-v)); }

typedef float f32x2 __attribute__((ext_vector_type(2)));
__device__ __forceinline__ f32x2 gelu_pk(f32x2 v) {
    const f32x2 av = __builtin_elementwise_abs(v), d = av * 0.2316418882f + 1.0f;
    f32x2 t; t.x = __builtin_amdgcn_rcpf(d.x); t.y = __builtin_amdgcn_rcpf(d.y);
    f32x2 q = t * 0.5307027145f + (-0.7265760135f); q = q * t + 0.7107068705f; q = q * t + (-0.142248368f); q = q * t + 0.127414796f; q = q * t;
    const f32x2 s = (v * v) * (-0.72134752044f);
    f32x2 e; e.x = __builtin_amdgcn_exp2f(s.x); e.y = __builtin_amdgcn_exp2f(s.y);
    const f32x2 m = v * (q * e), r = v - m;
    f32x2 o; o.x = v.x < 0.f ? m.x : r.x; o.y = v.y < 0.f ? m.y : r.y; return o;
}

struct ConvPair {
    float w0[4], w1[4], b0, b1, h0[3], h1[3];
    __device__ __forceinline__ void init(const Args& a, int ch) {
#pragma unroll
        for (int k = 0; k < 4; ++k) { const f32x2 w = *(const f32x2*)(a.in[I_CONVW] + k * CONVD + ch); w0[k] = w.x; w1[k] = w.y; }
        const f32x2 b = *(const f32x2*)(a.in[I_CONVB] + ch); b0 = b.x; b1 = b.y;
    }
    __device__ __forceinline__ void hist(int i, unsigned pr) { h0[i] = bflo(pr); h1[i] = bfhi(pr); }
    __device__ __forceinline__ void step(unsigned pr, float& o0, float& o1) {
        const float x0 = bflo(pr), x1 = bfhi(pr);
        o0 = fsilu(b0 + w0[0] * h0[0] + w0[1] * h0[1] + w0[2] * h0[2] + w0[3] * x0);
        o1 = fsilu(b1 + w1[0] * h1[0] + w1[1] * h1[1] + w1[2] * h1[2] + w1[3] * x1);
        h0[0] = h0[1]; h0[1] = h0[2]; h0[2] = x0; h1[0] = h1[1]; h1[1] = h1[2]; h1[2] = x1;
    }
};

__device__ __forceinline__ void ssd_pass1_unit(const Args& a, LAS unsigned char* lds, int tid, int lane, int wave, int b, int c, int g) {
    unsigned char* ws = a.ws;
    const bf16* PROJ = (const bf16*)(ws + WS_PROJ); bf16* XC = (bf16*)(ws + WS_XC);
    const int r0 = b * LP + c * 128, fr = lane & 15, fq = lane >> 4;
    LAS bf16* Bn = (LAS bf16*)lds;
    LAS bf16* Cn = Bn + 128 * PT;
    LAS bf16* Xt = (LAS bf16*)lds;
    LAS bf16* Bt = (LAS bf16*)(lds + 69632);
    LAS float* sAcs = (LAS float*)(lds + 104448);
    LAS float* sW = sAcs + 512;
    SUBSTAMP(40);
    if (wave < 4) {
        const int h = 4 * g + wave; const float A = -expf(a.in[I_ALOG][h]), bias = a.in[I_DTB][h];
        const float* dtr = (const float*)(ws + WS_DT);
        const float d0 = softplusf(dtr[(size_t)(r0 + lane) * 8 + h] + bias), d1 = softplusf(dtr[(size_t)(r0 + 64 + lane) * 8 + h] + bias);
        float s0 = d0 * A, s1 = d1 * A;
#pragma unroll
        for (int o = 1; o < 64; o <<= 1) { const float t0 = __shfl_up(s0, o), t1 = __shfl_up(s1, o); if (lane >= o) { s0 += t0; s1 += t1; } }
        s1 += __shfl(s0, 63); const float last = __shfl(s1, 63);
        sAcs[wave * 128 + lane] = s0; sAcs[wave * 128 + 64 + lane] = s1;
        sW[wave * 128 + lane] = d0 * expf(last - s0); sW[wave * 128 + 64 + lane] = d1 * expf(last - s1);
        float* rec = (float*)(ws + WS_ACS) + ((size_t)(b * 16 + c) * H + h) * 256;
        rec[lane] = s0; rec[64 + lane] = s1; rec[128 + lane] = d0; rec[192 + lane] = d1;
    }
    {
        const int cp = tid & 127, tr = tid >> 7, c2 = 2 * cp;
        const int ch = c2 < 128 ? DSSD + NST * g + c2 : DSSD + NG * NST + NST * g + (c2 - 128);
        ConvPair cv; cv.init(a, ch);
        const bf16* src = PROJ + (size_t)(r0 + 32 * tr) * NPROJ + O1 + ch;
        if (c == 0 && tr == 0) { cv.hist(0, 0u); cv.hist(1, 0u); cv.hist(2, 0u); }
        else {
#pragma unroll
            for (int i = 0; i < 3; ++i) cv.hist(i, *(const unsigned*)(src + (ptrdiff_t)(i - 3) * NPROJ)); }
        LAS bf16* nat = c2 < 128 ? Bn + c2 : Cn + (c2 - 128);
        for (int blk = 0; blk < 4; ++blk) {
            unsigned pr[8]; float o0[8], o1[8];
#pragma unroll
            for (int i = 0; i < 8; ++i) pr[i] = *(const unsigned*)(src + (size_t)(8 * blk + i) * NPROJ);
#pragma unroll
            for (int i = 0; i < 8; ++i) cv.step(pr[i], o0[i], o1[i]);
            const int l0 = 32 * tr + 8 * blk;
#pragma unroll
            for (int i = 0; i < 8; ++i) *(LAS unsigned*)(nat + (l0 + i) * PT) = pk2(o0[i], o1[i]);
            if (c2 >= 128) {
#pragma unroll
                for (int i = 0; i < 8; ++i) *(unsigned*)(XC + (size_t)(r0 + l0 + i) * CONVD + ch) = pk2(o0[i], o1[i]);
            } else {
                v4u t0, t1; t0.x = pk2(o0[0], o0[1]); t0.y = pk2(o0[2], o0[3]); t0.z = pk2(o0[4], o0[5]); t0.w = pk2(o0[6], o0[7]);
                t1.x = pk2(o1[0], o1[1]); t1.y = pk2(o1[2], o1[3]); t1.z = pk2(o1[4], o1[5]); t1.w = pk2(o1[6], o1[7]);
                *(LAS v4u*)(Bt + c2 * PT + l0) = t0; *(LAS v4u*)(Bt + (c2 + 1) * PT + l0) = t1;
            }
        }
    }
    __syncthreads(); SUBSTAMP(41);
    {
        bf16x8 cf[4];
#pragma unroll
        for (int kk = 0; kk < 4; ++kk) cf[kk] = ldfrag(Cn, 16 * wave + fr, 32 * kk + 8 * fq);
        bf16* Gg = (bf16*)(ws + WS_G) + (size_t)((b * 16 + c) * NG + g) * 128 * 128;
        for (int st = 0; st <= wave; ++st) {
            f32x4 acc = (f32x4){0.f, 0.f, 0.f, 0.f};
#pragma unroll
            for (int kk = 0; kk < 4; ++kk) acc = mfma16(ldfrag(Bn, 16 * st + fr, 32 * kk + 8 * fq), cf[kk], acc);
            MFMA_SETTLE(acc);
            u32x2 w; w.x = pk2(acc[0], acc[1]); w.y = pk2(acc[2], acc[3]);
            *(u32x2*)(Gg + (size_t)(16 * wave + fr) * 128 + 16 * st + 4 * fq) = w;
        }
    }
    __syncthreads(); SUBSTAMP(42);
    {
        const int cp = tid & 127, tr = tid >> 7, c2 = 2 * cp, ch = 256 * g + c2, hh = c2 >> 6;
        ConvPair cv; cv.init(a, ch);
        const bf16* src = PROJ + (size_t)(r0 + 32 * tr) * NPROJ + O1 + ch;
        if (c == 0 && tr == 0) { cv.hist(0, 0u); cv.hist(1, 0u); cv.hist(2, 0u); }
        else {
#pragma unroll
            for (int i = 0; i < 3; ++i) cv.hist(i, *(const unsigned*)(src + (ptrdiff_t)(i - 3) * NPROJ)); }
        for (int blk = 0; blk < 4; ++blk) {
            unsigned pr[8]; float o0[8], o1[8];
#pragma unroll
            for (int i = 0; i < 8; ++i) pr[i] = *(const unsigned*)(src + (size_t)(8 * blk + i) * NPROJ);
#pragma unroll
            for (int i = 0; i < 8; ++i) cv.step(pr[i], o0[i], o1[i]);
            const int l0 = 32 * tr + 8 * blk;
#pragma unroll
            for (int i = 0; i < 8; ++i) *(unsigned*)(XC + (size_t)(r0 + l0 + i) * CONVD + ch) = pk2(o0[i], o1[i]);
            const f32x4 wa = *(const LAS f32x4*)(sW + hh * 128 + l0), wb = *(const LAS f32x4*)(sW + hh * 128 + l0 + 4);
            v4u t0, t1; t0.x = pk2(o0[0] * wa[0], o0[1] * wa[1]); t0.y = pk2(o0[2] * wa[2], o0[3] * wa[3]); t0.z = pk2(o0[4] * wb[0], o0[5] * wb[1]); t0.w = pk2(o0[6] * wb[2], o0[7] * wb[3]);
            t1.x = pk2(o1[0] * wa[0], o1[1] * wa[1]); t1.y = pk2(o1[2] * wa[2], o1[3] * wa[3]); t1.z = pk2(o1[4] * wb[0], o1[5] * wb[1]); t1.w = pk2(o1[6] * wb[2], o1[7] * wb[3]);
            *(LAS v4u*)(Xt + c2 * PT + l0) = t0; *(LAS v4u*)(Xt + (c2 + 1) * PT + l0) = t1;
        }
    }
    __syncthreads(); SUBSTAMP(43);
    {
        const int hh = wave >> 1, nt0 = 4 * (wave & 1);
        f32x4 acc[4][4];
#pragma unroll
        for (int i = 0; i < 4; ++i)
#pragma unroll
            for (int j = 0; j < 4; ++j) acc[i][j] = (f32x4){0.f, 0.f, 0.f, 0.f};
#pragma unroll
        for (int kk = 0; kk < 4; ++kk) { bf16x8 bfr[4], xfr[4];
#pragma unroll
            for (int i = 0; i < 4; ++i) { bfr[i] = ldfrag(Bt, 16 * (nt0 + i) + fr, 32 * kk + 8 * fq); xfr[i] = ldfrag(Xt, 64 * hh + 16 * i + fr, 32 * kk + 8 * fq); }
#pragma unroll
            for (int i = 0; i < 4; ++i)
#pragma unroll
                for (int j = 0; j < 4; ++j) acc[i][j] = mfma16(bfr[i], xfr[j], acc[i][j]); }
        MFMA_SETTLE(acc[3][3]);
        bf16* CSp = (bf16*)(ws + WS_CS) + ((size_t)((b * 16 + c) * H + 4 * g + hh)) * PD * NST;
#pragma unroll
        for (int i = 0; i < 4; ++i)
#pragma unroll
            for (int j = 0; j < 4; ++j) { u32x2 w; w.x = pk2(acc[i][j][0], acc[i][j][1]); w.y = pk2(acc[i][j][2], acc[i][j][3]); *(u32x2*)(CSp + (size_t)(16 * j + fr) * NST + 16 * (nt0 + i) + 4 * fq) = w; }
    }
    __syncthreads(); SUBSTAMP(44);
}

__device__ __forceinline__ void ssd_sample_unit(const Args& a, LAS unsigned char* lds, int tid, int lane, int wave, int bs, int g) {
    unsigned char* ws = a.ws; const bf16* PROJ = (const bf16*)(ws + WS_PROJ);
    const int r0 = MP + 4 * bs;
    LAS float* sx = (LAS float*)lds;
    LAS float* sB = sx + 1024;
    LAS float* sC = sB + 512;
    LAS float* sdt = sC + 512;
    LAS float* yp = sdt + 32;
    LAS float* red = yp + 2048;
    {   const int idx = tid, ch = idx < 256 ? 256 * g + idx : (idx < 384 ? DSSD + NST * g + (idx - 256) : DSSD + NG * NST + NST * g + (idx - 384));
        float w[4], hs[7];
#pragma unroll
        for (int k = 0; k < 4; ++k) w[k] = a.in[I_CONVW][k * CONVD + ch];
        const float bb = a.in[I_CONVB][ch];
#pragma unroll
        for (int i = 0; i < 3; ++i) hs[i] = a.in[I_SCONV][((size_t)bs * 3 + i) * CONVD + ch];
#pragma unroll
        for (int i = 0; i < 4; ++i) hs[3 + i] = bf2f(PROJ[(size_t)(r0 + i) * NPROJ + O1 + ch]);
#pragma unroll
        for (int t = 0; t < 4; ++t) { const float v = fsilu(bb + w[0] * hs[t] + w[1] * hs[t + 1] + w[2] * hs[t + 2] + w[3] * hs[t + 3]);
            if (idx < 256) sx[t * 256 + idx] = v; else if (idx < 384) sB[t * 128 + idx - 256] = v; else sC[t * 128 + idx - 384] = v; }
    }
    if (tid < 16) { const int t = tid >> 2, hh = tid & 3, h = 4 * g + hh; const float dt = softplusf(((const float*)(ws + WS_DT))[(size_t)(r0 + t) * 8 + h] + a.in[I_DTB][h]);
        sdt[t * 4 + hh] = dt; sdt[16 + t * 4 + hh] = expf(-dt * expf(a.in[I_ALOG][h])); }
    __syncthreads();
    {   const int hh = wave >> 1, nh = wave & 1, h = 4 * g + hh, p = lane;
        const float* s0 = a.in[I_SSSD] + (((size_t)bs * H + h) * PD + p) * NST + 64 * nh;
        f32x4 st[16];
#pragma unroll
        for (int j = 0; j < 16; ++j) st[j] = *(const f32x4*)(s0 + 4 * j);
#pragma unroll
        for (int t = 0; t < 4; ++t) { const float dA = sdt[16 + t * 4 + hh], dx = sdt[t * 4 + hh] * sx[t * 256 + 64 * hh + p]; float y = 0.f;
#pragma unroll
            for (int j = 0; j < 16; ++j) { const f32x4 Bv = *(const LAS f32x4*)(sB + t * 128 + 64 * nh + 4 * j), Cv = *(const LAS f32x4*)(sC + t * 128 + 64 * nh + 4 * j);
                st[j] = st[j] * dA + Bv * dx; y += (Cv[0] * st[j][0] + Cv[1] * st[j][1]) + (Cv[2] * st[j][2] + Cv[3] * st[j][3]); }
            yp[(nh * 4 + t) * 256 + 64 * hh + p] = y; }
        float* o = a.out + OUT_SSDS + (((size_t)bs * H + h) * PD + p) * NST + 64 * nh;
#pragma unroll
        for (int j = 0; j < 16; ++j) *(f32x4*)(o + 4 * j) = st[j];
    }
    __syncthreads();
    {   const int ch = tid & 255, t0 = tid >> 8; float v[2];
#pragma unroll
        for (int i = 0; i < 2; ++i) { const int t = t0 + 2 * i; const float y = yp[t * 256 + ch] + yp[(4 + t) * 256 + ch] + a.in[I_SSDD][4 * g + (ch >> 6)] * sx[t * 256 + ch];
            v[i] = y * fsilu(bf2f(PROJ[(size_t)(r0 + t) * NPROJ + 256 * g + ch])); }
        const float q0 = wave_sum(v[0] * v[0]), q1 = wave_sum(v[1] * v[1]);
        if (lane == 0) { red[wave * 2] = q0; red[wave * 2 + 1] = q1; }
        __syncthreads();
        const int wb = (wave >> 2) * 4; const float ngv = a.in[I_SSDNG][256 * g + ch];
#pragma unroll
        for (int i = 0; i < 2; ++i) { const float tot = (red[(wb + 0) * 2 + i] + red[(wb + 1) * 2 + i]) + (red[(wb + 2) * 2 + i] + red[(wb + 3) * 2 + i]);
            ((bf16*)(ws + WS_MIX))[(size_t)(r0 + t0 + 2 * i) * D + 256 * g + ch] = (bf16)f2bf(v[i] * rsqrtf(tot * (1.f / 256.f) + EPS) * ngv); }
    }
    __syncthreads();
}

template <int MODE> __device__ __forceinline__ void s5_unit(const Args& a, LAS unsigned char* ldsw, int lane, int unit) {
    unsigned char* ws = a.ws; const bf16* PROJ = (const bf16*)(ws + WS_PROJ);
    const int g = unit & 31, q = unit >> 5;
    const int b = q >> 4, c = q & 15;
    const int row0 = MODE == 2 ? MP + 32 * q : b * LP + 128 * c, nsub = MODE == 2 ? 1 : 4;
    const float* AB = (const float*)(ws + WS_AB);
    const float abr = AB[2 * (g * P5 + lane)], abi = AB[2 * (g * P5 + lane) + 1];
    LAS float* BUs = (LAS float*)ldsw;
    bf16x8 bfr[4];
#pragma unroll
    for (int cb = 0; cb < 4; ++cb) bfr[cb] = *(const bf16x8*)((const bf16*)(ws + WS_BB) + ((size_t)g * 128 + 32 * cb + (lane & 31)) * 16 + 8 * (lane >> 5));
    bf16x8 cfr[4];
    if (MODE >= 1) {
#pragma unroll
        for (int kk = 0; kk < 4; ++kk) cfr[kk] = *(const bf16x8*)((const bf16*)(ws + WS_CC) + ((size_t)g * 16 + (lane & 15)) * 128 + 32 * kk + 8 * (lane >> 4)); }
    float hr = 0.f, hi = 0.f;
    if (MODE == 1) { const float pr = AB[2 * G5 * P5 + 2 * (g * P5 + lane)], pi = AB[2 * G5 * P5 + 2 * (g * P5 + lane) + 1];
        f32x2 ev[15];
#pragma unroll
        for (int cc = 0; cc < 15; ++cc) ev[cc] = cc < c ? *(const f32x2*)((const float*)(ws + WS_S5E) + ((size_t)((b * 16 + cc) * G5 + g)) * 128 + 2 * lane) : (f32x2){0.f, 0.f};
#pragma unroll
        for (int cc = 0; cc < 15; ++cc) if (cc < c) { const float nr = pr * hr - pi * hi + ev[cc].x, ni = pr * hi + pi * hr + ev[cc].y; hr = nr; hi = ni; } }
    for (int sub = 0; sub < nsub; ++sub) {
        const int rb = row0 + 32 * sub;
        const bf16x8 afr = *(const bf16x8*)(PROJ + (size_t)(rb + (lane & 31)) * NPROJ + 1536 + 16 * g + 8 * (lane >> 5));
        {   f32x16 dd[4];
#pragma unroll
            for (int cb = 0; cb < 4; ++cb) {
#pragma unroll
                for (int i = 0; i < 16; ++i) dd[cb][i] = 0.f;
                dd[cb] = __builtin_amdgcn_mfma_f32_32x32x16_bf16(afr, bfr[cb], dd[cb], 0, 0, 0); }
            asm volatile("s_nop 15\n\ts_nop 15\n\ts_nop 15\n\ts_nop 15" : "+v"(dd[0]), "+v"(dd[1]), "+v"(dd[2]), "+v"(dd[3]));
#pragma unroll
            for (int cb = 0; cb < 4; ++cb)
#pragma unroll
                for (int i = 0; i < 16; ++i) BUs[((i & 3) + 8 * (i >> 2) + 4 * (lane >> 5)) * 132 + 32 * cb + (lane & 31)] = dd[cb][i]; }
        LDS_WAIT();
        float h0r[8], h0i[8];
        if (MODE == 2) {
#pragma unroll
            for (int i = 0; i < 8; ++i) { const int bs = ((rb - MP) >> 2) + i; h0r[i] = a.in[I_SRE][((size_t)bs * G5 + g) * P5 + lane]; h0i[i] = a.in[I_SIM][((size_t)bs * G5 + g) * P5 + lane]; } }
#pragma unroll
        for (int t0 = 0; t0 < 32; t0 += 8) {
            f32x2 bu[8];
#pragma unroll
            for (int i = 0; i < 8; ++i) bu[i] = *(const LAS f32x2*)(BUs + (t0 + i) * 132 + 2 * lane);
#pragma unroll
            for (int i = 0; i < 8; ++i) { const int t = t0 + i;
                if (MODE == 2 && (t & 3) == 0) { hr = h0r[t >> 2]; hi = h0i[t >> 2]; }
                const float nr = abr * hr - abi * hi + bu[i].x, ni = abr * hi + abi * hr + bu[i].y; hr = nr; hi = ni;
                if (MODE >= 1) *(LAS unsigned*)((LAS bf16*)(BUs + t * 132) + 2 * lane) = pk2(hr, hi);
                if (MODE == 2 && (t & 3) == 3) { const int bs = (rb - MP + t) >> 2; a.out[OUT_RES + ((size_t)bs * G5 + g) * P5 + lane] = hr; a.out[OUT_IMS + ((size_t)bs * G5 + g) * P5 + lane] = hi; } }
        }
        if (MODE >= 1) {
            LDS_WAIT();
            const int fr = lane & 15, fq = lane >> 4;
#pragma unroll
            for (int tt = 0; tt < 2; ++tt) { f32x4 y = (f32x4){0.f, 0.f, 0.f, 0.f};
#pragma unroll
                for (int kk = 0; kk < 4; ++kk) y = mfma16(cfr[kk], *(const LAS bf16x8*)((const LAS bf16*)(BUs + (16 * tt + fr) * 132) + 32 * kk + 8 * fq), y);
                MFMA_SETTLE(y);
                const int row = rb + 16 * tt + fr, co = 16 * g + 4 * fq;
                const u32x2 uu = *(const u32x2*)(PROJ + (size_t)row * NPROJ + 1536 + co); const f32x4 dk = *(const f32x4*)(a.in[I_S5D] + co);
                const f32x2 g0 = gelu_pk((f32x2){y[0] + dk[0] * bflo(uu.x), y[1] + dk[1] * bfhi(uu.x)}), g1 = gelu_pk((f32x2){y[2] + dk[2] * bflo(uu.y), y[3] + dk[3] * bfhi(uu.y)});
                u32x2 w; w.x = pk2(g0.x, g0.y); w.y = pk2(g1.x, g1.y);
                *(u32x2*)((bf16*)(ws + WS_GY) + (size_t)row * DS5 + co) = w; }
            LDS_WAIT();
        }
    }
    if (MODE == 0) { f32x2 e; e.x = hr; e.y = hi; *(f32x2*)((float*)(ws + WS_S5E) + ((size_t)((b * 16 + c) * G5 + g)) * 128 + 2 * lane) = e; }
    if (MODE == 1 && c == 15) { a.out[OUT_REP + ((size_t)b * G5 + g) * P5 + lane] = hr; a.out[OUT_IMP + ((size_t)b * G5 + g) * P5 + lane] = hi; }
}

__device__ __forceinline__ void phase_mix1(const Args& a, LAS unsigned char* lds, int tid, int lane, int wave) {
    unsigned char* ws = a.ws;
    SUBSTAMP(16);
    if (a.flags & 1) {
    for (int u = blockIdx.x; u < NP * 16 * NG; u += gridDim.x) ssd_pass1_unit(a, lds, tid, lane, wave, u >> 5, (u >> 1) & 15, u & 1);
    SUBSTAMP(17);
    for (int u = blockIdx.x; u < NS * NG; u += gridDim.x) ssd_sample_unit(a, lds, tid, lane, wave, u >> 1, u & 1);
    }
    SUBSTAMP(18);
    const int gw = blockIdx.x * NWAVES + wave, NGW = gridDim.x * NWAVES;
    LAS unsigned char* ldsw = lds + wave * 16896;
    if (a.flags & 2) {
    for (int u = gw; u < NP * 16 * G5; u += NGW) s5_unit<0>(a, ldsw, lane, u);
    for (int u = gw; u < (MS / 32) * G5; u += NGW) s5_unit<2>(a, ldsw, lane, u);
    }
    __syncthreads(); SUBSTAMP(19);
    const bf16* PROJ = (const bf16*)(ws + WS_PROJ);
    for (int e = blockIdx.x * NTHR + tid; e < NSEQ * 3 * CONVD; e += gridDim.x * NTHR) {
        const int s = e / (3 * CONVD), i = (e / CONVD) % 3, ch = e % CONVD;
        const int row = s < NP ? s * LP + LP - 3 + i : MP + (s - NP) * LS + 1 + i;
        a.out[OUT_CONVP + e] = bf2f(PROJ[(size_t)row * NPROJ + O1 + ch]); }
    __syncthreads();
}
__device__ __forceinline__ void phase_chunkscan(const Args& a, int tid) {
    unsigned char* ws = a.ws; bf16* CS = (bf16*)(ws + WS_CS); const float* ACS = (const float*)(ws + WS_ACS);
    if (!(a.flags & 1)) return;
    for (int e = blockIdx.x * NTHR + tid; e < NP * H * PD * NST / 4; e += gridDim.x * NTHR) {
        const int b = e >> 14, h = (e >> 11) & 7, pn = e & 2047;
        u32x2 v[16]; float dec[16];
#pragma unroll
        for (int c = 0; c < 16; ++c) { v[c] = *(const u32x2*)(CS + ((size_t)((b * 16 + c) * H + h)) * 8192 + 4 * pn); dec[c] = expf(ACS[((size_t)(b * 16 + c) * H + h) * 256 + 127]); }
        f32x4 run = (f32x4){0.f, 0.f, 0.f, 0.f};
#pragma unroll
        for (int c = 0; c < 16; ++c) { u32x2 w; w.x = pk2(run[0], run[1]); w.y = pk2(run[2], run[3]); *(u32x2*)((bf16*)(ws + WS_INIT) + ((size_t)((b * 16 + c) * H + h)) * 8192 + 4 * pn) = w;
            run = run * dec[c] + (f32x4){bflo(v[c].x), bfhi(v[c].x), bflo(v[c].y), bfhi(v[c].y)}; }
        *(f32x4*)(a.out + OUT_SSDP + ((size_t)(b * H + h)) * 8192 + 4 * pn) = run;
    }
}
__device__ __forceinline__ void ssd_pass2_unit(const Args& a, LAS unsigned char* lds, int tid, int lane, int wave, int b, int c, int g) {
    unsigned char* ws = a.ws; const bf16* PROJ = (const bf16*)(ws + WS_PROJ); const bf16* XC = (const bf16*)(ws + WS_XC);
    const int r0 = b * LP + c * 128, fr = lane & 15, fq = lane >> 4;
    LAS bf16* Cn = (LAS bf16*)lds;
    LAS bf16* Gs = Cn + 128 * PT;
    LAS bf16* Xt = Gs + 128 * PT;
    LAS bf16* Ib = Xt + 64 * PT;
    LAS float* sAcs = (LAS float*)(Ib + 64 * PT);
    LAS float* sDt = sAcs + 512;
    const bf16* Gg = (const bf16*)(ws + WS_G) + (size_t)((b * 16 + c) * NG + g) * 128 * 128;
    for (int e = tid; e < 128 * 16; e += NTHR) { const int l = e >> 4, k8 = (e & 15) * 8;
        *(LAS v4u*)(Cn + l * PT + k8) = *(const v4u*)(XC + (size_t)(r0 + l) * CONVD + DSSD + NG * NST + NST * g + k8);
        *(LAS v4u*)(Gs + l * PT + k8) = *(const v4u*)(Gg + (size_t)l * 128 + k8); }
    for (int e = tid; e < 1024; e += NTHR) { const int hh = e >> 8, i = e & 255; sAcs[(i >> 7) * 512 + hh * 128 + (i & 127)] = ((const float*)(ws + WS_ACS))[((size_t)(b * 16 + c) * H + 4 * g + hh) * 256 + i]; }
    SUBSTAMP(46);
    float ssq = 0.f;
    const int l = 16 * wave + fr, row = r0 + l;
    bf16* mixrow = (bf16*)(ws + WS_MIX) + (size_t)row * D + 256 * g;
    LAS unsigned* keep = (LAS unsigned*)(lds + 108544) + tid * 8;
    u32x2 k2[4], k3[4];
#pragma unroll
    for (int pt = 0; pt < 4; ++pt) { k2[pt].x = 0u; k2[pt].y = 0u; k3[pt].x = 0u; k3[pt].y = 0u; }
#pragma unroll 1
    for (int hh = 0; hh < 4; ++hh) {
        __syncthreads(); if (hh == 0) SUBSTAMP(48); if (hh == 1) SUBSTAMP(50);
        {   const int pp = tid & 31, sb = tid >> 5, chl = 64 * hh + 2 * pp; unsigned pr[8];
#pragma unroll
            for (int i = 0; i < 8; ++i) pr[i] = *(const unsigned*)(XC + (size_t)(r0 + 8 * sb + i) * CONVD + 256 * g + chl);
            const f32x4 da = *(const LAS f32x4*)(sDt + hh * 128 + 8 * sb), db = *(const LAS f32x4*)(sDt + hh * 128 + 8 * sb + 4);
            v4u t0, t1; t0.x = pk2(bflo(pr[0]) * da[0], bflo(pr[1]) * da[1]); t0.y = pk2(bflo(pr[2]) * da[2], bflo(pr[3]) * da[3]); t0.z = pk2(bflo(pr[4]) * db[0], bflo(pr[5]) * db[1]); t0.w = pk2(bflo(pr[6]) * db[2], bflo(pr[7]) * db[3]);
            t1.x = pk2(bfhi(pr[0]) * da[0], bfhi(pr[1]) * da[1]); t1.y = pk2(bfhi(pr[2]) * da[2], bfhi(pr[3]) * da[3]); t1.z = pk2(bfhi(pr[4]) * db[0], bfhi(pr[5]) * db[1]); t1.w = pk2(bfhi(pr[6]) * db[2], bfhi(pr[7]) * db[3]);
            *(LAS v4u*)(Xt + (2 * pp) * PT + 8 * sb) = t0; *(LAS v4u*)(Xt + (2 * pp + 1) * PT + 8 * sb) = t1;
            const bf16* CSp = (const bf16*)(ws + WS_INIT) + ((size_t)((b * 16 + c) * H + 4 * g + hh)) * PD * NST;
#pragma unroll
            for (int i = 0; i < 2; ++i) { const int e = tid + NTHR * i, p = e >> 4, n8 = (e & 15) * 8; *(LAS v4u*)(Ib + p * PT + n8) = *(const v4u*)(CSp + (size_t)p * NST + n8); }
        }
        __syncthreads(); if (hh == 0) SUBSTAMP(49);
        f32x4 ad[4], ao[4];
#pragma unroll
        for (int pt = 0; pt < 4; ++pt) { ad[pt] = (f32x4){0.f, 0.f, 0.f, 0.f}; ao[pt] = (f32x4){0.f, 0.f, 0.f, 0.f}; }
        const float acl = sAcs[hh * 128 + l];
        for (int kk = 0; kk <= (wave >> 1); ++kk) {
            const bf16x8 gf = ldfrag(Gs, l, 32 * kk + 8 * fq);
            const f32x4 a0 = *(const LAS f32x4*)(sAcs + hh * 128 + 32 * kk + 8 * fq), a1 = *(const LAS f32x4*)(sAcs + hh * 128 + 32 * kk + 8 * fq + 4);
            v4u pw; float pv[8];
#pragma unroll
            for (int j = 0; j < 8; ++j) { const int s = 32 * kk + 8 * fq + j; const float as = j < 4 ? a0[j & 3] : a1[j & 3];
                pv[j] = s <= l ? bf2f((bf16)gf[j]) * __expf(acl - as) : 0.f; }
#pragma unroll
            for (int j = 0; j < 4; ++j) pw[j] = pk2(pv[2 * j], pv[2 * j + 1]);
            const bf16x8 pf = __builtin_bit_cast(bf16x8, pw);
#pragma unroll
            for (int pt = 0; pt < 4; ++pt) ad[pt] = mfma16(ldfrag(Xt, 16 * pt + fr, 32 * kk + 8 * fq), pf, ad[pt]);
        }
#pragma unroll
        for (int kk = 0; kk < 4; ++kk) { const bf16x8 cf = ldfrag(Cn, l, 32 * kk + 8 * fq);
#pragma unroll
            for (int pt = 0; pt < 4; ++pt) ao[pt] = mfma16(ldfrag(Ib, 16 * pt + fr, 32 * kk + 8 * fq), cf, ao[pt]); }
        MFMA_SETTLE(ad[3]); MFMA_SETTLE(ao[3]);
        const float el = __expf(acl), Dh = a.in[I_SSDD][4 * g + hh];
#pragma unroll
        for (int pt = 0; pt < 4; ++pt) { const int chl = 64 * hh + 16 * pt + 4 * fq;
            const u32x2 xx = *(const u32x2*)(XC + (size_t)row * CONVD + 256 * g + chl), zz = *(const u32x2*)(PROJ + (size_t)row * NPROJ + 256 * g + chl);
            const float xv[4] = {bflo(xx.x), bfhi(xx.x), bflo(xx.y), bfhi(xx.y)}, zv[4] = {bflo(zz.x), bfhi(zz.x), bflo(zz.y), bfhi(zz.y)};
            float v[4];
#pragma unroll
            for (int r = 0; r < 4; ++r) { const float y = ad[pt][r] + el * ao[pt][r] + Dh * xv[r]; v[r] = y * fsilu(zv[r]); ssq += v[r] * v[r]; }
            u32x2 w; w.x = pk2(v[0], v[1]); w.y = pk2(v[2], v[3]);
            if (hh < 2) *(LAS u32x2*)(keep + hh * 4096 + 2 * pt) = w;
            k2[pt].x = hh == 2 ? w.x : k2[pt].x; k2[pt].y = hh == 2 ? w.y : k2[pt].y; k3[pt].x = hh == 3 ? w.x : k3[pt].x; k3[pt].y = hh == 3 ? w.y : k3[pt].y; }
    }
    SUBSTAMP(47);
    ssq += __shfl_xor(ssq, 16); ssq += __shfl_xor(ssq, 32);
    const float scale = rsqrtf(ssq * (1.f / 256.f) + EPS);
#pragma unroll
    for (int hh = 0; hh < 4; ++hh)
#pragma unroll
        for (int pt = 0; pt < 4; ++pt) { const int chl = 64 * hh + 16 * pt + 4 * fq; const f32x4 ng = *(const f32x4*)(a.in[I_SSDNG] + 256 * g + chl);
            const u32x2 vv = hh < 2 ? *(const LAS u32x2*)(keep + hh * 4096 + 2 * pt) : (hh == 2 ? k2[pt] : k3[pt]);
            u32x2 w; w.x = pk2(bflo(vv.x) * scale * ng[0], bfhi(vv.x) * scale * ng[1]); w.y = pk2(bflo(vv.y) * scale * ng[2], bfhi(vv.y) * scale * ng[3]);
            *(u32x2*)(mixrow + chl) = w; }
    __syncthreads();
}
__device__ __forceinline__ void ssd_rescale(const Args& a, int tid, int first_wg) {
    unsigned char* ws = a.ws; bf16* MIXp = (bf16*)(ws + WS_MIX); const float* SCL = (const float*)(ws + WS_SCL);
    const int nwg = (int)gridDim.x - first_wg; if ((int)blockIdx.x < first_wg || nwg <= 0) return;
    for (int i = ((int)blockIdx.x - first_wg) * NTHR + tid; i < MP * 64; i += nwg * NTHR) { const int row = i >> 6, c8 = (i & 63) * 8; const float s = SCL[(size_t)row * 2 + (c8 >> 8)];
        v4u x = *(const v4u*)(MIXp + (size_t)row * D + c8);
        x.x = pk2(bflo(x.x) * s, bfhi(x.x) * s); x.y = pk2(bflo(x.y) * s, bfhi(x.y) * s); x.z = pk2(bflo(x.z) * s, bfhi(x.z) * s); x.w = pk2(bflo(x.w) * s, bfhi(x.w) * s);
        *(v4u*)(MIXp + (size_t)row * D + c8) = x; }
}
__device__ __forceinline__ void phase_mix2(const Args& a, LAS unsigned char* lds, int tid, int lane, int wave) {
    SUBSTAMP(22);
    if (a.flags & 1) for (int u = blockIdx.x; u < NP * 16 * NG; u += gridDim.x) ssd_pass2_unit(a, lds, tid, lane, wave, u >> 5, (u >> 1) & 15, u & 1);
    SUBSTAMP(23);
    const int gw = blockIdx.x * NWAVES + wave, NGW = gridDim.x * NWAVES;
    LAS unsigned char* ldsw = lds + wave * 16896;
    if (a.flags & 2) for (int u = gw; u < NP * 16 * G5; u += NGW) s5_unit<1>(a, ldsw, lane, u);
    __syncthreads(); SUBSTAMP(24);
}


template <bool NORM, class F, class NF> __device__ __forceinline__ void tail_gemm(LAS unsigned char* lds, const bf16* A, const bf16* Bt, int N, int K, int tid, int lane, int wave, const F& f, unsigned* cntT, unsigned* slotT, const NF& nf) {
    const int fr = lane & 15, fq = lane >> 4, ntn = N / 64, ntiles = (MS / 32) * ntn, kw = K / 8;
    LAS float* part = (LAS float*)lds;
    __syncthreads();
    for (int t = blockIdx.x; t < ntiles; t += gridDim.x) {
        const int m0 = MP + 32 * (t / ntn), n0 = 64 * (t % ntn);
        const bf16* ap = A + (size_t)(m0 + fr) * K + wave * kw + 8 * fq; const bf16* bp = Bt + (size_t)(n0 + fr) * K + wave * kw + 8 * fq;
        f32x4 acc[2][4];
#pragma unroll
        for (int i = 0; i < 2; ++i)
#pragma unroll
            for (int j = 0; j < 4; ++j) acc[i][j] = (f32x4){0.f, 0.f, 0.f, 0.f};
#pragma unroll 4
        for (int k = 0; k < kw; k += 32) {
            bf16x8 af[2], bf[4];
#pragma unroll
            for (int i = 0; i < 2; ++i) af[i] = *(const bf16x8*)(ap + (size_t)(16 * i) * K + k);
#pragma unroll
            for (int j = 0; j < 4; ++j) bf[j] = *(const bf16x8*)(bp + (size_t)(16 * j) * K + k);
#pragma unroll
            for (int i = 0; i < 2; ++i)
#pragma unroll
                for (int j = 0; j < 4; ++j) acc[i][j] = mfma16(bf[j], af[i], acc[i][j]);
        }
#pragma unroll
        for (int i = 0; i < 2; ++i)
#pragma unroll
            for (int j = 0; j < 4; ++j) { if (i == 0 && j == 0) MFMA_SETTLE(acc[1][3]); *(LAS f32x4*)(part + (wave * 32 + 16 * i + fr) * 68 + 16 * j + 4 * fq) = acc[i][j]; }
        __syncthreads();
        {   const int row = tid >> 4, c4 = (tid & 15) * 4; f32x4 v = (f32x4){0.f, 0.f, 0.f, 0.f};
#pragma unroll
            for (int w = 0; w < 8; ++w) v += *(const LAS f32x4*)(part + (w * 32 + row) * 68 + c4);
            const f32x4 x1 = f(m0 + row, n0 + c4, v);
            if (NORM) {
                const int rb = t / ntn, cb = t % ntn;
                float q = (x1[0] * x1[0] + x1[1] * x1[1]) + (x1[2] * x1[2] + x1[3] * x1[3]);
                q += __shfl_xor(q, 1); q += __shfl_xor(q, 2); q += __shfl_xor(q, 4); q += __shfl_xor(q, 8);
                if ((tid & 15) == 0) __hip_atomic_store(slotT + ((size_t)(rb * 32 + row) * 16 + cb), __float_as_uint(q), __ATOMIC_RELAXED, __HIP_MEMORY_SCOPE_AGENT);
                asm volatile("s_waitcnt vmcnt(0)" ::: "memory");
                __syncthreads();
                if (tid == 0) { __hip_atomic_fetch_add(cntT + 64 * rb, 1u, __ATOMIC_RELAXED, __HIP_MEMORY_SCOPE_AGENT); unsigned sp = 0;
                    while (__hip_atomic_load(cntT + 64 * rb, __ATOMIC_RELAXED, __HIP_MEMORY_SCOPE_AGENT) < (unsigned)ntn) { __builtin_amdgcn_s_sleep(2); if (++sp > (1u << 22)) break; }
                    __builtin_amdgcn_fence(__ATOMIC_ACQUIRE, "agent"); asm volatile("s_waitcnt vmcnt(0)" ::: "memory"); }
                __syncthreads();
                float tq = __uint_as_float(__hip_atomic_load(slotT + ((size_t)(rb * 32 + row) * 16 + (tid & 15)), __ATOMIC_RELAXED, __HIP_MEMORY_SCOPE_AGENT));
                tq += __shfl_xor(tq, 1); tq += __shfl_xor(tq, 2); tq += __shfl_xor(tq, 4); tq += __shfl_xor(tq, 8);
                nf(m0 + row, n0 + c4, x1, 1.0f / sqrtf(tq * (1.0f / (float)N) + EPS));
            } }
        __syncthreads();
    }
}
__device__ __forceinline__ float xbcf(const bf16* proj, const float* sconv, int s, int i, int ch) {
    if (i < 3) return s < NP ? 0.f : sconv[((size_t)(s - NP) * 3 + i) * CONVD + ch];
    const int row = s < NP ? s * LP + (i - 3) : MP + (s - NP) * LS + (i - 3);
    return bf2f(proj[(size_t)row * NPROJ + O1 + ch]);
}
__global__ void nv_convnew(const bf16* proj, const float* sconv, float* out) {
    const int s = blockIdx.x, L = s < NP ? LP : LS;
    float* o = s < NP ? out + OUT_CONVP + (size_t)s * 3 * CONVD : out + OUT_CONVS + (size_t)(s - NP) * 3 * CONVD;
    for (int e = threadIdx.x; e < 3 * CONVD; e += blockDim.x) o[e] = xbcf(proj, sconv, s, L + e / CONVD, e % CONVD);
}
__global__ void __launch_bounds__(512) nv_ssd(const bf16* proj, const float* dtraw, const float* sconv, const float* sssd, const float* convw, const float* convb, const float* dtb, const float* Alog,
                                              const float* Dsk, float* yssd, float* out) {
    const int s = blockIdx.x / H, h = blockIdx.x % H, g = h / (H / NG), tid = threadIdx.x, p = tid / 8, nq = tid % 8;
    const int L = s < NP ? LP : LS, row0 = s < NP ? s * LP : MP + (s - NP) * LS;
    __shared__ float sx[PD], sB[NST], sC[NST];
    float st[16];
    for (int j = 0; j < 16; ++j) st[j] = s < NP ? 0.f : sssd[(((size_t)(s - NP) * H + h) * PD + p) * NST + nq * 16 + j];
    const float A = -expf(Alog[h]), Dh = Dsk[h], bias = dtb[h];
    for (int t = 0; t < L; ++t) {
        if (tid < PD + 2 * NST) {
            const int ch = tid < PD ? h * PD + tid : (tid < PD + NST ? DSSD + g * NST + (tid - PD) : DSSD + NG * NST + g * NST + (tid - PD - NST));
            float c = convb[ch];
            for (int k = 0; k < 4; ++k) c += xbcf(proj, sconv, s, t + k, ch) * convw[k * CONVD + ch];
            c = siluf(c);
            if (tid < PD) sx[tid] = c; else if (tid < PD + NST) sB[tid - PD] = c; else sC[tid - PD - NST] = c;
        }
        __syncthreads();
        const float dt = softplusf(dtraw[(size_t)(row0 + t) * 8 + h] + bias), dA = expf(dt * A), xv = sx[p], dx = dt * xv;
        float y = 0.f;
        for (int j = 0; j < 16; ++j) { st[j] = st[j] * dA + dx * sB[nq * 16 + j]; y += sC[nq * 16 + j] * st[j]; }
        y += __shfl_xor(y, 1); y += __shfl_xor(y, 2); y += __shfl_xor(y, 4);
        if (nq == 0) yssd[(size_t)(row0 + t) * DSSD + h * PD + p] = y + Dh * xv;
        __syncthreads();
    }
    float* o = s < NP ? out + OUT_SSDP + (((size_t)s * H + h) * PD + p) * NST : out + OUT_SSDS + (((size_t)(s - NP) * H + h) * PD + p) * NST;
    for (int j = 0; j < 16; ++j) o[nq * 16 + j] = st[j];
}
__global__ void nv_ssdnorm(const float* yssd, const bf16* proj, const float* ng, bf16* mix) {
    const int row = blockIdx.x, t = threadIdx.x;
    __shared__ float red[2][256];
    float v[2];
    for (int gi = 0; gi < 2; ++gi) { const int c = gi * 256 + t; v[gi] = yssd[(size_t)row * DSSD + c] * siluf(bf2f(proj[(size_t)row * NPROJ + c])); red[gi][t] = v[gi] * v[gi]; }
    __syncthreads();
    for (int o = 128; o > 0; o >>= 1) { if (t < o) { red[0][t] += red[0][t + o]; red[1][t] += red[1][t + o]; } __syncthreads(); }
    for (int gi = 0; gi < 2; ++gi) { const int c = gi * 256 + t; mix[(size_t)row * D + c] = (bf16)f2bf(v[gi] * rsqrtf(red[gi][0] / 256.f + EPS) * ng[c]); }
}
__global__ void nv_s5(const bf16* proj, const float* s0re, const float* s0im, const float* Are, const float* Aim, const float* lstep, const float* Bre, const float* Bim,
                      const float* Cre, const float* Cim, const float* Dsk, bf16* gy, float* out) {
    const int s = blockIdx.x / G5, g = blockIdx.x % G5, p = threadIdx.x;
    const int L = s < NP ? LP : LS, row0 = s < NP ? s * LP : MP + (s - NP) * LS;
    const float lr = Are[g * P5 + p], li = Aim[g * P5 + p], step = expf(lstep[g]);
    const float mag = expf(lr * step), abr = mag * cosf(li * step), abi = mag * sinf(li * step);
    const float nr = abr - 1.f, ni = abi, den = lr * lr + li * li, fr = (nr * lr + ni * li) / den, fi = (ni * lr - nr * li) / den;
    float bbr[CH5], bbi[CH5], cr[CH5], ci[CH5];
    for (int c = 0; c < CH5; ++c) { const float br = Bre[((size_t)g * P5 + p) * CH5 + c], bi = Bim[((size_t)g * P5 + p) * CH5 + c];
        bbr[c] = fr * br - fi * bi; bbi[c] = fr * bi + fi * br; cr[c] = Cre[((size_t)g * CH5 + c) * P5 + p]; ci[c] = Cim[((size_t)g * CH5 + c) * P5 + p]; }
    float hr = s < NP ? 0.f : s0re[((size_t)(s - NP) * G5 + g) * P5 + p], hi = s < NP ? 0.f : s0im[((size_t)(s - NP) * G5 + g) * P5 + p];
    for (int t = 0; t < L; ++t) {
        const bf16* u = proj + (size_t)(row0 + t) * NPROJ + 1536 + g * CH5;
        float br = 0.f, bi = 0.f, uv[CH5];
        for (int c = 0; c < CH5; ++c) { uv[c] = bf2f(u[c]); br += bbr[c] * uv[c]; bi += bbi[c] * uv[c]; }
        const float nhr = abr * hr - abi * hi + br, nhi = abr * hi + abi * hr + bi; hr = nhr; hi = nhi;
        float mine = 0.f;
        for (int c = 0; c < CH5; ++c) { float v = cr[c] * hr - ci[c] * hi;
            for (int o = 1; o < 64; o <<= 1) v += __shfl_xor(v, o);
            if (p == c) mine = v + Dsk[g * CH5 + c] * uv[c]; }
        if (p < CH5) gy[(size_t)(row0 + t) * DS5 + g * CH5 + p] = (bf16)f2bf(0.5f * mine * (1.f + erff(mine * 0.70710678118654752f)));
    }
    float* ore = s < NP ? out + OUT_REP + ((size_t)s * G5 + g) * P5 : out + OUT_RES + ((size_t)(s - NP) * G5 + g) * P5;
    float* oim = s < NP ? out + OUT_IMP + ((size_t)s * G5 + g) * P5 : out + OUT_IMS + ((size_t)(s - NP) * G5 + g) * P5;
    ore[p] = hr; oim[p] = hi;
}
__global__ void nv_ada(const float* cp, const float* cs, const float* w, const float* b, float* mod, int N, int off) {
    const int j = blockIdx.x * 256 + threadIdx.x, s = blockIdx.y;
    const float* c = s < NP ? cp + (size_t)s * D : cs + (size_t)(s - NP) * D;
    float acc = 0.f;
    for (int k = 0; k < D; ++k) acc += siluf(c[k]) * w[(size_t)k * N + j];
    mod[(size_t)s * NMOD + off + j] = acc + b[j];
}

constexpr int NPHASE = 12;
__global__ void __launch_bounds__(NTHR, 2) fwd_mega(Args a) {
    extern __shared__ __attribute__((aligned(16))) unsigned char lds_raw[];
    LAS unsigned char* lds = (LAS unsigned char*)lds_raw;
    const int tid = threadIdx.x, lane = tid & 63, wave = __builtin_amdgcn_readfirstlane(tid >> 6);
    unsigned char* ws = a.ws;
    const int lo = a.ph_lo, hi = a.ph_hi, G = gridDim.x;
    volatile LAS unsigned* MISC = (volatile LAS unsigned*)(lds + LDS_BYTES - 64);
    if (tid < 16) MISC[tid] = 0u;
    __syncthreads();
    const XcdBarrier bar = xcd_barrier_post((unsigned*)(ws + WS_CTL), MISC);
#define IN(k) (lo <= (k) && (k) < hi)
#if PROBE_PH >= 0
    volatile LAS unsigned long long* stamps = (volatile LAS unsigned long long*)(lds + (LDS_BYTES - 512));
    const bool stamper = blockIdx.x == 0 && tid == 0;
    if (stamper) stamps[0] = __builtin_amdgcn_s_memrealtime();
#define SEAM(k) do { if (IN(k) && IN((k) + 1)) xcd_barrier(bar); if (stamper) stamps[(k) + 1] = __builtin_amdgcn_s_memrealtime(); } while (0)
#else
#if USE_CG_SYNC
#define SEAM(k) do { if (IN(k) && IN((k) + 1)) cg::this_grid().sync(); } while (0)
#else
#define SEAM(k) do { if (IN(k) && IN((k) + 1)) xcd_barrier(bar); } while (0)
#endif
#endif
#define REPF(k) ((a.flags >> (4 + (k))) & 1)

#define P0_BODY phase_prep(a, lds, tid, lane, wave);
#define P1_BODY phase_modnorm<0>(a, lds, tid, lane, wave);
#define P2_TAIL { bf16* PR = (bf16*)(ws + WS_PROJ); tail_gemm<false>(lds, (const bf16*)(ws + WS_U), (const bf16*)(ws + WS_WIN), NPROJ, D, tid, lane, wave, [=](int row, int col, f32x4 v) { \
                      u32x2 w; w.x = pk2(v[0], v[1]); w.y = pk2(v[2], v[3]); *(u32x2*)(PR + (size_t)row * NPROJ + col) = w; return v; }, (unsigned*)nullptr, (unsigned*)nullptr, [](int, int, f32x4, float) {}); }
#define P2_MAIN { pg8::Gemm g{(const bf16*)(ws + WS_U), (const bf16*)(ws + WS_WIN), MP, NPROJ, D}; pg8::StaticOrder S; S.init(MP, NPROJ, G, (int)blockIdx.x); \
                  pg8::EpiBf16 E{(bf16*)(ws + WS_PROJ), NPROJ}; pg8::gemm_phase<pg8::EpiBf16, pg8::StaticOrder, true, true>(lds, g, S, E); }
#if TAIL_FIRST_P2
#define P2_BODY { P2_TAIL P2_MAIN }
#else
#define P2_BODY { P2_MAIN P2_TAIL }
#endif
#define P3_BODY phase_mix1(a, lds, tid, lane, wave);
#define P5_BODY phase_mix2(a, lds, tid, lane, wave);
#define P6_BODY { pg8::Gemm g{(const bf16*)(ws + WS_GY), (const bf16*)(ws + WS_WGLU), M, DS5, DS5}; pg8::StaticOrder S; S.init(M, DS5, G, (int)blockIdx.x); \
                  pg8::EpiGlu E{(const bf16*)(ws + WS_GY), (bf16*)(ws + WS_MIX), a.in[I_BGLU]}; pg8::gemm_phase<pg8::EpiGlu, pg8::StaticOrder, true, true>(lds, g, S, E); }
#define P7_TAIL { const float* xs = a.in[I_XS]; bf16* X1 = (bf16*)(ws + WS_X1B); const float* md = (const float*)(ws + WS_MOD); const float* gm = a.in[I_N2G]; bf16* V = (bf16*)(ws + WS_U); \
                    tail_gemm<true>(lds, (const bf16*)(ws + WS_MIX), (const bf16*)(ws + WS_WOUT), D, D, tid, lane, wave, [=](int row, int col, f32x4 v) { \
                      const f32x4 r = *(const f32x4*)(xs + (size_t)(row - MP) * D + col), g = *(const f32x4*)(md + (size_t)(NP + (row - MP) / LS) * NMOD + 2048 + col); const f32x4 x1 = r + g * v; u32x2 xw; xw.x = pk2(x1[0], x1[1]); xw.y = pk2(x1[2], x1[3]); *(u32x2*)(X1 + (size_t)row * D + col) = xw; return x1; }, \
                      (unsigned*)(ws + WS_CTL) + CW_T7, (unsigned*)(ws + WS_XT7), [=](int row, int col, f32x4 x1, float rs) { const float* ms = md + (size_t)(NP + (row - MP) / LS) * NMOD; \
                      const f32x4 o = x1 * rs * (*(const f32x4*)(gm + col)) * (*(const f32x4*)(ms + 4096 + col) + 1.f) + *(const f32x4*)(ms + 3072 + col); u32x2 w; w.x = pk2(o[0], o[1]); w.y = pk2(o[2], o[3]); *(u32x2*)(V + (size_t)row * D + col) = w; }); }
#define P7_MAIN { pg8::Gemm g{(const bf16*)(ws + WS_MIX), (const bf16*)(ws + WS_WOUT), MP, D, D}; pg8::StaticOrder S; S.init(MP, D, G, (int)blockIdx.x); \
                  pg8::EpiResNorm<0> E{a.in[I_XP], (const float*)(ws + WS_MOD), 2048, 3072, 4096, a.in[I_N2G], (bf16*)(ws + WS_X1B), (bf16*)(ws + WS_U), nullptr, (unsigned*)(ws + WS_XB7), (unsigned*)(ws + WS_CTL) + CW_P7, EPS}; \
                  pg8::gemm_phase<pg8::EpiResNorm<0>, pg8::StaticOrder, false, true>(lds, g, S, E); }
#if TAIL_FIRST_P7
#define P7_BODY { P7_TAIL P7_MAIN }
#else
#define P7_BODY { P7_MAIN P7_TAIL }
#endif
#define P8_BODY phase_modnorm<1>(a, lds, tid, lane, wave);
#define P9_BODY { pg8::Gemm g{(const bf16*)(ws + WS_U), (const bf16*)(ws + WS_WUP), M, 2 * DFF, D}; pg8::StaticOrder S; S.init(M, 2 * DFF, G, (int)blockIdx.x); \
                  pg8::EpiSwiglu E{(bf16*)(ws + WS_HFF), DFF}; pg8::gemm_phase<pg8::EpiSwiglu, pg8::StaticOrder, true, true>(lds, g, S, E); }
#define P10_TAIL { const bf16* X1 = (const bf16*)(ws + WS_X1B); float* Y = a.out + OUT_Y; const float* md = (const float*)(ws + WS_MOD); const float* gm = a.in[I_NFG]; \
                    tail_gemm<true>(lds, (const bf16*)(ws + WS_HFF), (const bf16*)(ws + WS_WDOWN), D, DFF, tid, lane, wave, [=](int row, int col, f32x4 v) { \
                      const u32x2 rb = *(const u32x2*)(X1 + (size_t)row * D + col); const f32x4 r = (f32x4){bflo(rb.x), bfhi(rb.x), bflo(rb.y), bfhi(rb.y)}, g = *(const f32x4*)(md + (size_t)(NP + (row - MP) / LS) * NMOD + 5120 + col); return r + g * v; }, \
                      (unsigned*)(ws + WS_CTL) + CW_T10, (unsigned*)(ws + WS_XT10), [=](int row, int col, f32x4 x2, float rs) { const float* ms = md + (size_t)(NP + (row - MP) / LS) * NMOD; \
                      *(f32x4*)(Y + (size_t)row * D + col) = x2 * rs * (*(const f32x4*)(gm + col)) * (*(const f32x4*)(ms + 7168 + col) + 1.f) + *(const f32x4*)(ms + 6144 + col); }); }
#define P10_MAIN { pg8::Gemm g{(const bf16*)(ws + WS_HFF), (const bf16*)(ws + WS_WDOWN), MP, D, DFF}; pg8::StaticOrder S; S.init(MP, D, G, (int)blockIdx.x); \
                  pg8::EpiResNorm<1> E{(const bf16*)(ws + WS_X1B), (const float*)(ws + WS_MOD), 5120, 6144, 7168, a.in[I_NFG], nullptr, nullptr, a.out + OUT_Y, (unsigned*)(ws + WS_XB10), (unsigned*)(ws + WS_CTL) + CW_P10, EPS}; \
                  pg8::gemm_phase<pg8::EpiResNorm<1>, pg8::StaticOrder, false, true>(lds, g, S, E); }
#if TAIL_FIRST_P10
#define P10_BODY(OUTP) { P10_TAIL P10_MAIN }
#else
#define P10_BODY(OUTP) { P10_MAIN P10_TAIL }
#endif
#if PROBE_REP
#define RUNP(k, BODY) if (IN(k)) { if (REPF(k)) { BODY } BODY }
#else
#define RUNP(k, BODY) if (IN(k)) { BODY }
#endif
    RUNP(0, P0_BODY)
#if PROBE_PH >= 0
    if (stamper) { stamps[14] = stamps[0]; stamps[15] = __builtin_amdgcn_s_memrealtime(); }
#endif
    SEAM(0);
    RUNP(1, P1_BODY) SEAM(1);
    RUNP(2, P2_BODY) SEAM(2);
#if EXTRA_BAR2
    xcd_barrier(bar);
#endif
    RUNP(3, P3_BODY) SEAM(3);
    if (IN(4)) phase_chunkscan(a, tid);
    SEAM(4);
#if DELAY_AFTER4
    { const unsigned long long t0 = __builtin_amdgcn_s_memrealtime(); while (__builtin_amdgcn_s_memrealtime() - t0 < DELAY_AFTER4) __builtin_amdgcn_s_sleep(4); }
#endif
    RUNP(5, P5_BODY) SEAM(5);
    RUNP(6, P6_BODY) SEAM(6);
    RUNP(7, P7_BODY) SEAM(7);
#if PROBE_PH >= 0
    if (stamper) stamps[9] = stamps[8];
#endif
    RUNP(9, P9_BODY) SEAM(9);
    if (IN(10)) P10_BODY(a.out + OUT_Y)
#if PROBE_PH >= 0
    if (stamper) { __builtin_amdgcn_s_waitcnt(0); stamps[11] = __builtin_amdgcn_s_memrealtime(); }
#endif
#if PROBE_PH >= 0
    if (stamper) { __builtin_amdgcn_s_waitcnt(0); stamps[12] = __builtin_amdgcn_s_memrealtime();
        const unsigned long long span = stamps[PROBE_PH + 1] - stamps[PROBE_PH], until = stamps[12] + 4ull * span;
        while (__builtin_amdgcn_s_memrealtime() < until) __builtin_amdgcn_s_sleep(8); }
#endif
#undef IN
#undef SEAM
}

extern "C" void kernel_launch(void* const* d_in, const int* in_sizes, int n_in, void* d_out, int out_size, void* d_ws, size_t ws_size, hipStream_t stream) {
    static int grid = 0;
    if (grid == 0) {
        int dev = 0, cus = 0, per_cu = 0;
        (void)hipGetDevice(&dev); (void)hipDeviceGetAttribute(&cus, hipDeviceAttributeMultiprocessorCount, dev);
        (void)hipFuncSetAttribute((const void*)fwd_mega, hipFuncAttributeMaxDynamicSharedMemorySize, LDS_BYTES);
        (void)hipOccupancyMaxActiveBlocksPerMultiprocessor(&per_cu, (const void*)fwd_mega, NTHR, LDS_BYTES);
        grid = cus * (per_cu < 1 ? 1 : 1);
        if (n_in != 36 || ws_size < WS_END || out_size != (int)OUT_END) fprintf(stderr, "kernel_launch: unexpected sizes n_in %d ws %zu out %d\n", n_in, ws_size, out_size);
    }
    Args a{};
    for (int i = 0; i < 36; ++i) a.in[i] = (const float*)d_in[i];
    a.out = (float*)d_out; a.ws = (unsigned char*)d_ws;
    const float* const* in = a.in; unsigned char* ws = a.ws; float* out = a.out;
    (void)hipMemsetAsync((char*)d_ws + WS_CTL, 0, 65536, stream);
    a.flags = 3 | (PROBE_REP << 4);
#if DIAG_NAIVE
    { auto run = [&](int lo, int hi) { Args b = a; b.ph_lo = lo; b.ph_hi = hi; void* ka[] = {&b}; (void)hipLaunchCooperativeKernel((const void*)fwd_mega, dim3(grid), dim3(NTHR), ka, LDS_BYTES, stream); };
      run(0, 6);
#if DIAG_NAIVE == 1
      nv_s5<<<NSEQ * G5, 64, 0, stream>>>((const bf16*)(ws + WS_PROJ), in[I_SRE], in[I_SIM], in[I_ARE], in[I_AIM], in[I_LSTEP], in[I_BRE], in[I_BIM], in[I_CRE], in[I_CIM], in[I_S5D], (bf16*)(ws + WS_GY), out);
#else
      { float* yssd = (float*)(ws + WS_XC);
        nv_ssd<<<NSEQ * H, 512, 0, stream>>>((const bf16*)(ws + WS_PROJ), (const float*)(ws + WS_DT), in[I_SCONV], in[I_SSSD], in[I_CONVW], in[I_CONVB], in[I_DTB], in[I_ALOG], in[I_SSDD], yssd, out);
        nv_ssdnorm<<<M, 256, 0, stream>>>(yssd, (const bf16*)(ws + WS_PROJ), in[I_SSDNG], (bf16*)(ws + WS_MIX)); }
#endif
      (void)hipMemsetAsync((char*)d_ws + WS_CTL, 0, 16384, stream);
      run(6, NPHASE); }
#else
    a.ph_lo = 0; a.ph_hi = NPHASE;
    void* kargs[] = {&a};
    const hipError_t e = hipLaunchCooperativeKernel((const void*)fwd_mega, dim3(grid), dim3(NTHR), kargs, LDS_BYTES, stream);
    if (e != hipSuccess) fprintf(stderr, "kernel_launch: cooperative launch failed: %s (grid %d)\n", hipGetErrorString(e), grid);
#endif
    (void)in; (void)ws; (void)out;
}
```

```cpp
#include <hip/hip_runtime.h>
#include <hip/hip_cooperative_groups.h>
#include <cstdio>
#include <cstdint>
namespace cg = cooperative_groups;
#ifndef PROBE_REP
#define PROBE_REP 0
#endif
#ifndef PROBE_PH
#define PROBE_PH -1
#endif
#define EXTRA_BAR2 0
#define DIAG_NAIVE 0
#define USE_CG_SYNC 0
#define DELAY_AFTER4 0
#define BARRIER_WG_RELEASE 0
#define TAIL_FIRST_P2 1
#define TAIL_FIRST_P7 0
#define TAIL_FIRST_P10 0
#ifndef DBG_FLAGS
#define DBG_FLAGS 3
#endif

constexpr int D = 1024, NP = 8, LP = 2048, NS = 128, LS = 4, NSEQ = NP + NS;
constexpr int MP = NP * LP, MS = NS * LS, M = MP + MS;
constexpr int H = 8, PD = 64, NST = 128, NG = 2, DSSD = 512, CONVD = 1024;
constexpr int G5 = 32, CH5 = 16, P5 = 64, DS5 = 512;
constexpr int DFF = 2816, INP = 2056, O1 = 512, O2 = 1536, O3 = 1544;
constexpr int NPROJ = 2048;
constexpr int NMOD = 8192;
constexpr float EPS = 1e-6f;
constexpr size_t OUT_Y = 0, OUT_SSDP = (size_t)M * D, OUT_SSDS = OUT_SSDP + (size_t)NP * H * PD * NST, OUT_CONVP = OUT_SSDS + (size_t)NS * H * PD * NST,
                 OUT_CONVS = OUT_CONVP + (size_t)NP * 3 * CONVD, OUT_REP = OUT_CONVS + (size_t)NS * 3 * CONVD, OUT_RES = OUT_REP + (size_t)NP * G5 * P5,
                 OUT_IMP = OUT_RES + (size_t)NS * G5 * P5, OUT_IMS = OUT_IMP + (size_t)NP * G5 * P5, OUT_END = OUT_IMS + (size_t)NS * G5 * P5;
constexpr size_t MiB = 1u << 20;
constexpr size_t WS_CTL = 0, WS_MOD = 1 * MiB, WS_DT = 6 * MiB, WS_BB = 7 * MiB, WS_CC = WS_BB + 256 * 1024, WS_AB = WS_CC + 256 * 1024, WS_SC = 6 * MiB + 640 * 1024  , WS_ACS = 8 * MiB, WS_S5E = 9 * MiB, WS_SCL = 11 * MiB  ,
                 WS_WIN = 12 * MiB, WS_WGLU = 16 * MiB, WS_WOUT = 17 * MiB, WS_WUP = 19 * MiB, WS_WDOWN = 30 * MiB,
                 WS_U = 36 * MiB, WS_CS = 36 * MiB, WS_PROJ = 69 * MiB, WS_XC = 135 * MiB, WS_HFF = 69 * MiB, WS_MIX = 168 * MiB, WS_GY = 201 * MiB, WS_G = 218 * MiB, WS_X1B = 201 * MiB  , WS_INIT = 234 * MiB  , WS_END = 256 * MiB;
constexpr int CW_P7 = 4096, CW_P10 = 8192, CW_T7 = 12288, CW_T10 = 13312;
constexpr size_t WS_XB7 = 256 * 1024, WS_XB10 = 512 * 1024, WS_XT7 = 768 * 1024, WS_XT10 = 832 * 1024;
static_assert(WS_MOD + (size_t)NSEQ * NMOD * 4 <= WS_DT && WS_DT + (size_t)M * 8 * 4 <= WS_BB && WS_WDOWN + (size_t)D * DFF * 2 <= WS_U && WS_U + (size_t)M * D * 2 <= WS_PROJ, "ws map 1");
static_assert(WS_X1B + (size_t)M * D * 2 <= WS_END, "ws map 3");
static_assert(WS_PROJ + (size_t)M * NPROJ * 2 <= WS_XC && WS_XC + (size_t)M * CONVD * 2 <= WS_MIX && WS_HFF + (size_t)M * DFF * 2 <= WS_MIX && WS_MIX + (size_t)M * D * 2 <= WS_GY && WS_GY + (size_t)M * DS5 * 2 <= WS_G, "ws map 2");

typedef unsigned short bf16;
__device__ __host__ __forceinline__ int seq_of_row(int r) { return r < MP ? r / LP : NP + (r - MP) / LS; }
__device__ __forceinline__ float siluf(float v) { return v / (1.f + expf(-v)); }
__device__ __forceinline__ float softplusf(float v) { return v > 20.f ? v : log1pf(expf(v)); }
__device__ __forceinline__ float bf2f(bf16 b) { return __uint_as_float(((unsigned)b) << 16); }
__device__ __forceinline__ unsigned f2bf(float f) { unsigned u = __float_as_uint(f); return (u + 0x7fffu + ((u >> 16) & 1u)) >> 16; }
typedef __bf16 bf16x2_t __attribute__((ext_vector_type(2)));
__device__ __forceinline__ unsigned pk2(float lo, float hi) { const bf16x2_t r = __builtin_convertvector((__attribute__((ext_vector_type(2))) float){lo, hi}, bf16x2_t); return __builtin_bit_cast(unsigned, r); }
__device__ __forceinline__ float bflo(unsigned w) { return __uint_as_float(w << 16); }
__device__ __forceinline__ float bfhi(unsigned w) { return __uint_as_float(w & 0xffff0000u); }
__device__ __forceinline__ float sigm(float v) { return __builtin_amdgcn_rcpf(1.f + __expf(-v)); }

namespace pg8 {
#define PG8_LAS __attribute__((address_space(3)))
typedef unsigned short bf16_t;
typedef short bf16x8 __attribute__((ext_vector_type(8)));
typedef float f32x4 __attribute__((ext_vector_type(4)));
typedef unsigned u32x4 __attribute__((ext_vector_type(4)));
constexpr int BM = 256, BK = 64, HALF = 128, HTB = HALF * BK * 2  , STAGE_BYTES = 8 * HTB, NXCD = 8, WGM = 8;

__host__ __device__ __forceinline__ int lds_byte(int r, int c) { const int st = (r >> 4) * 2 + (c >> 5), rr = r & 15, cc = c & 31, ob = rr * 64 + cc * 2; return st * 1024 + (ob ^ (((ob >> 9) & 1) << 5)); }
__host__ __device__ __forceinline__ void stage_rc(int b, int& R, int& C) { const int st = b / 1024, sb = b % 1024, swz = sb ^ (((sb >> 9) & 1) << 5); R = (st >> 1) * 16 + swz / 64; C = (st & 1) * 32 + (swz % 64) / 2; }
__host__ __device__ __forceinline__ int perm32(int rho) { const int n = rho >> 4, i = rho & 15; return 8 * (i >> 2) + 4 * n + (i & 3); }

struct Unit { int pm, pn; };
struct Gemm { const bf16_t* A; const bf16_t* Bt; int M, N, K; };

struct StaticOrder {
    int nM, nN, nwg, G, c;
    __host__ __device__ void init(int M, int N, int G_, int c_) { nM = M / BM; nN = N / BM; nwg = nM * nN; G = G_; c = c_; }
    __host__ __device__ bool next(int i, Unit& u) const {
        const long L = (long)i * G + c; if (L >= nwg) return false;
        int wgid = (int)L; { const int q = nwg / NXCD, r = nwg % NXCD, xcd = wgid % NXCD, off = wgid / NXCD; wgid = (xcd < r ? xcd * (q + 1) : r * (q + 1) + (xcd - r) * q) + off; }
        const int nig = WGM * nN, gid = wgid / nig, fm = gid * WGM, gsz = (nM - fm) < WGM ? (nM - fm) : WGM;
        u.pm = fm + ((wgid % nig) % gsz); u.pn = (wgid % nig) / gsz; return true;
    }
    __device__ __forceinline__ void a_ready(const Unit&) const {}
    __device__ __forceinline__ void done(const Unit&) const {}
};
__device__ __forceinline__ unsigned cvt_pk_bf16(float lo, float hi) { unsigned r; asm volatile("v_cvt_pk_bf16_f32 %0, %1, %2" : "=v"(r) : "v"(lo), "v"(hi)); return r; }
struct EpiBf16 {
    static constexpr bool PERM = true, AFTER_DRAIN = false;
    bf16_t* O; int ldc;
    __device__ __forceinline__ void operator()(const f32x4 (&acc)[2][2][4][2], const Unit& u, int wr, int wc, int fr, int fq) const {
        const int row0 = u.pm * BM + wr * 64 + fr, col0 = u.pn * BM + wc * 32 + 8 * fq;
#pragma unroll
        for (int ai = 0; ai < 2; ++ai)
#pragma unroll
            for (int m = 0; m < 4; ++m) { bf16_t* rowp = O + (size_t)(row0 + ai * HALF + m * 16) * ldc + col0;
#pragma unroll
                for (int bj = 0; bj < 2; ++bj) { const f32x4 v0 = acc[ai][bj][m][0], v1 = acc[ai][bj][m][1];
                    u32x4 w; w.x = cvt_pk_bf16(v0[0], v0[1]); w.y = cvt_pk_bf16(v0[2], v0[3]); w.z = cvt_pk_bf16(v1[0], v1[1]); w.w = cvt_pk_bf16(v1[2], v1[3]);
                    *(u32x4*)(rowp + bj * HALF) = w; } }
    }
};
struct EpiGlu {
    static constexpr bool PERM = true, AFTER_DRAIN = false;
    const bf16_t* GY; bf16_t* MIX; const float* bias;
    __device__ __forceinline__ void operator()(const f32x4 (&acc)[2][2][4][2], const Unit& u, int wr, int wc, int fr, int fq) const {
        const int row0 = u.pm * BM + wr * 64 + fr, col0 = u.pn * BM + wc * 32 + 8 * fq;
#pragma unroll
        for (int bj = 0; bj < 2; ++bj) { const int col = col0 + bj * HALF; const f32x4 b0 = *(const f32x4*)(bias + col), b1 = *(const f32x4*)(bias + col + 4);
#pragma unroll
            for (int ai = 0; ai < 2; ++ai)
#pragma unroll
                for (int m = 0; m < 4; ++m) { const size_t row = (size_t)(row0 + ai * HALF + m * 16);
                    const u32x4 g = *(const u32x4*)(GY + row * 512 + col); const f32x4 v0 = acc[ai][bj][m][0] + b0, v1 = acc[ai][bj][m][1] + b1;
                    u32x4 w; w.x = cvt_pk_bf16(bflo(g.x) * sigm(v0[0]), bfhi(g.x) * sigm(v0[1])); w.y = cvt_pk_bf16(bflo(g.y) * sigm(v0[2]), bfhi(g.y) * sigm(v0[3]));
                             w.z = cvt_pk_bf16(bflo(g.z) * sigm(v1[0]), bfhi(g.z) * sigm(v1[1])); w.w = cvt_pk_bf16(bflo(g.w) * sigm(v1[2]), bfhi(g.w) * sigm(v1[3]));
                    *(u32x4*)(MIX + row * 1024 + 512 + col) = w; } }
    }
};
struct EpiResid {
    static constexpr bool PERM = false, AFTER_DRAIN = false;
    const float* xa; const float* xb; float* out; const float* gate;
    static constexpr int MPROWS = 16384, NMODS = 8192;
    __device__ __forceinline__ void operator()(const f32x4 (&acc)[2][2][4][2], const Unit& u, int wr, int wc, int fr, int fq) const {
        const int row0 = u.pm * BM + wr * 64 + fr, col0 = u.pn * BM + wc * 32 + 4 * fq;
#pragma unroll
        for (int ai = 0; ai < 2; ++ai)
#pragma unroll
            for (int m = 0; m < 4; ++m) { const int row = row0 + ai * HALF + m * 16; const int s = row < MPROWS ? row / 2048 : 8 + (row - MPROWS) / 4;
                const float* res = row < MPROWS ? xa + (size_t)row * 1024 : xb + (size_t)(row - MPROWS) * 1024; const float* gp = gate + (size_t)s * NMODS; float* op = out + (size_t)row * 1024;
#pragma unroll
                for (int bj = 0; bj < 2; ++bj)
#pragma unroll
                    for (int n = 0; n < 2; ++n) { const int col = col0 + bj * HALF + n * 16; const f32x4 r = *(const f32x4*)(res + col), g = *(const f32x4*)(gp + col);
                        *(f32x4*)(op + col) = r + g * acc[ai][bj][m][n]; } }
    }
};
struct EpiSwiglu {
    static constexpr bool PERM = true, AFTER_DRAIN = false;
    bf16_t* Hf; int ldc;
    __device__ __forceinline__ void operator()(const f32x4 (&acc)[2][2][4][2], const Unit& u, int wr, int wc, int fr, int fq) const {
        const int row0 = u.pm * BM + wr * 64 + fr, col0 = u.pn * HALF + wc * 32 + 8 * fq;
#pragma unroll
        for (int ai = 0; ai < 2; ++ai)
#pragma unroll
            for (int m = 0; m < 4; ++m) { const f32x4 g0 = acc[ai][0][m][0], g1 = acc[ai][0][m][1], u0 = acc[ai][1][m][0], u1 = acc[ai][1][m][1];
                u32x4 w; w.x = cvt_pk_bf16(g0[0] * sigm(g0[0]) * u0[0], g0[1] * sigm(g0[1]) * u0[1]); w.y = cvt_pk_bf16(g0[2] * sigm(g0[2]) * u0[2], g0[3] * sigm(g0[3]) * u0[3]);
                         w.z = cvt_pk_bf16(g1[0] * sigm(g1[0]) * u1[0], g1[1] * sigm(g1[1]) * u1[1]); w.w = cvt_pk_bf16(g1[2] * sigm(g1[2]) * u1[2], g1[3] * sigm(g1[3]) * u1[3]);
                *(u32x4*)(Hf + (size_t)(row0 + ai * HALF + m * 16) * ldc + col0) = w; }
    }
};


template <int MODE> struct EpiResNorm {
    static constexpr bool PERM = false, AFTER_DRAIN = true;
    const void* res; const float* mod; int gate_off, sh_off, sc_off; const float* gam;
    bf16_t* xout; bf16_t* vout; float* yout;
    unsigned* xbuf; unsigned* cnt; float eps;
    __device__ __forceinline__ void fused(f32x4 (&acc)[2][2][4][2], const Unit& u, int wr, int wc, int fr, int fq, PG8_LAS unsigned char* lds, int wid, int lane) const {
        PG8_LAS float* P = (PG8_LAS float*)lds;
        PG8_LAS float* S = (PG8_LAS float*)(lds + 8192);
        const int col0 = u.pn * BM + wc * 32 + 4 * fq, s = (u.pm * BM) / 2048;
        const float* ms = mod + (size_t)s * 8192;
        {   f32x4 gt[2][2];
#pragma unroll
            for (int bj = 0; bj < 2; ++bj)
#pragma unroll
                for (int n = 0; n < 2; ++n) gt[bj][n] = *(const f32x4*)(ms + gate_off + col0 + bj * HALF + n * 16);
#pragma unroll
            for (int ai = 0; ai < 2; ++ai)
#pragma unroll
                for (int m = 0; m < 4; ++m) { const int rl = ai * HALF + wr * 64 + m * 16 + fr; const size_t ro = (size_t)(u.pm * BM + rl) * 1024 + col0; float q = 0.f;
#pragma unroll
                    for (int bj = 0; bj < 2; ++bj)
#pragma unroll
                        for (int n = 0; n < 2; ++n) { f32x4 r; if (MODE == 0) r = *(const f32x4*)((const float*)res + ro + bj * HALF + n * 16);
                            else { typedef unsigned u32x2w __attribute__((ext_vector_type(2))); const u32x2w rb = *(const u32x2w*)((const bf16_t*)res + ro + bj * HALF + n * 16); r = (f32x4){bflo(rb.x), bfhi(rb.x), bflo(rb.y), bfhi(rb.y)}; }
                            const f32x4 x1 = r + gt[bj][n] * acc[ai][bj][m][n]; acc[ai][bj][m][n] = x1;
                            q += (x1[0] * x1[0] + x1[1] * x1[1]) + (x1[2] * x1[2] + x1[3] * x1[3]); }
                    q += __shfl_xor(q, 16); q += __shfl_xor(q, 32);
                    if (fq == 0) P[rl * 4 + wc] = q;
                    if (m & 1) asm volatile("" ::: "memory"); }
        }
        asm volatile("s_waitcnt lgkmcnt(0)" ::: "memory"); __builtin_amdgcn_s_barrier(); asm volatile("" ::: "memory");
        const int row = wid * 32 + (lane & 31);
        if (lane < 32) { const f32x4 p = *(const PG8_LAS f32x4*)(P + row * 4); const float t = (p[0] + p[1]) + (p[2] + p[3]);
            __hip_atomic_store(xbuf + ((size_t)(u.pm * BM + row) * 4 + u.pn), __float_as_uint(t), __ATOMIC_RELAXED, __HIP_MEMORY_SCOPE_AGENT); }
        asm volatile("s_waitcnt vmcnt(0)" ::: "memory");
        if (lane == 0) __hip_atomic_fetch_add(cnt + 64 * u.pm, 1u, __ATOMIC_RELAXED, __HIP_MEMORY_SCOPE_AGENT);
        if (wid == 0) { unsigned sp = 0;
            while ((unsigned)__builtin_amdgcn_readfirstlane(__hip_atomic_load(cnt + 64 * u.pm, __ATOMIC_RELAXED, __HIP_MEMORY_SCOPE_AGENT)) < 32u) { __builtin_amdgcn_s_sleep(2); if (++sp > (1u << 22)) break; }
            __builtin_amdgcn_fence(__ATOMIC_ACQUIRE, "agent"); }
        asm volatile("s_waitcnt vmcnt(0) lgkmcnt(0)" ::: "memory"); __builtin_amdgcn_s_barrier(); asm volatile("" ::: "memory");
        if (lane < 32) { const unsigned* sl = xbuf + (size_t)(u.pm * BM + row) * 4; float t = 0.f;
#pragma unroll
            for (int k = 0; k < 4; ++k) t += __uint_as_float(__hip_atomic_load(sl + k, __ATOMIC_RELAXED, __HIP_MEMORY_SCOPE_AGENT));
            S[row] = 1.0f / sqrtf(t * (1.0f / 1024.0f) + eps); }
        asm volatile("s_waitcnt lgkmcnt(0)" ::: "memory"); __builtin_amdgcn_s_barrier(); asm volatile("" ::: "memory");
        f32x4 scl[2][2], shf[2][2];
#pragma unroll
        for (int bj = 0; bj < 2; ++bj)
#pragma unroll
            for (int n = 0; n < 2; ++n) { const int c = col0 + bj * HALF + n * 16; scl[bj][n] = *(const f32x4*)(gam + c) * (*(const f32x4*)(ms + sc_off + c) + 1.0f); shf[bj][n] = *(const f32x4*)(ms + sh_off + c); }
#pragma unroll
        for (int ai = 0; ai < 2; ++ai)
#pragma unroll
            for (int m = 0; m < 4; ++m) { const int rl = ai * HALF + wr * 64 + m * 16 + fr; const float rs = S[rl]; const size_t off = (size_t)(u.pm * BM + rl) * 1024 + col0;
#pragma unroll
                for (int bj = 0; bj < 2; ++bj)
#pragma unroll
                    for (int n = 0; n < 2; ++n) { const f32x4 x1 = acc[ai][bj][m][n]; const f32x4 v = x1 * rs * scl[bj][n] + shf[bj][n];
                        if (MODE == 0) { typedef unsigned u32x2v __attribute__((ext_vector_type(2))); u32x2v xw; xw.x = cvt_pk_bf16(x1[0], x1[1]); xw.y = cvt_pk_bf16(x1[2], x1[3]); *(u32x2v*)(xout + off + bj * HALF + n * 16) = xw;
                            u32x2v w; w.x = cvt_pk_bf16(v[0], v[1]); w.y = cvt_pk_bf16(v[2], v[3]); *(u32x2v*)(vout + off + bj * HALF + n * 16) = w; }
                        else *(f32x4*)(yout + off + bj * HALF + n * 16) = v; } }
    }
};
template <class Epi, class Sched, bool ALIGN_EPI = false, bool SP2 = false>
__device__ __forceinline__ void gemm_phase(PG8_LAS unsigned char* lds, const Gemm g, const Sched& S, const Epi& E) {
    const int tid = threadIdx.x, wid = __builtin_amdgcn_readfirstlane(tid >> 6), lane = tid & 63, wr = wid >> 2, wc = wid & 3, fr = lane & 15, fq = lane >> 4;
    const int K = g.K, nt = K / BK;
    unsigned voffA[2], voffB[2];
#pragma unroll
    for (int i = 0; i < 2; ++i) { int R, C; stage_rc(tid * 16 + i * 8192, R, C); const int Rb = Epi::PERM ? ((R & ~31) + perm32(R & 31)) : R;
        voffA[i] = (unsigned)(R * K + C) * 2u; voffB[i] = (unsigned)(Rb * K + C) * 2u; }
    const size_t kstep = (size_t)(BK * 2);
    const size_t hstep = (size_t)HALF * K * 2;
    const size_t tstep = 2 * hstep;
    const unsigned ldsw = (unsigned)wid * 1024u;
    const int aoff = lds_byte(wr * 64 + fr, fq * 8), boff = lds_byte(wc * 32 + fr, fq * 8);
#define PG8_SA(b, h) (((b) * 2 + (h)) * HTB)
#define PG8_SB(b, h) ((4 + (b) * 2 + (h)) * HTB)
#define PG8_STAGE(bufoff, gbase, voff) do { _Pragma("unroll") for (int _i = 0; _i < 2; ++_i) \
        __builtin_amdgcn_global_load_lds((const unsigned*)((const char*)(gbase) + (voff)[_i]), (PG8_LAS unsigned*)(lds + (bufoff) + ldsw + _i * 8192), 16, 0, 0); } while (0)
#define PG8_LDA(dst, b, h) do { _Pragma("unroll") for (int m = 0; m < 4; ++m) _Pragma("unroll") for (int k = 0; k < 2; ++k) dst[m][k] = *(const PG8_LAS bf16x8*)(lds + PG8_SA(b, h) + aoff + m * 2048 + k * 1024); } while (0)
#define PG8_LDB(dst, b, h) do { _Pragma("unroll") for (int n = 0; n < 2; ++n) _Pragma("unroll") for (int k = 0; k < 2; ++k) dst[n][k] = *(const PG8_LAS bf16x8*)(lds + PG8_SB(b, h) + boff + n * 2048 + k * 1024); } while (0)
#define PG8_MMA(ai, bj, At, Bt) do { __builtin_amdgcn_s_setprio(1); _Pragma("unroll") for (int m = 0; m < 4; ++m) _Pragma("unroll") for (int n = 0; n < 2; ++n) _Pragma("unroll") for (int k = 0; k < 2; ++k) \
        acc[ai][bj][m][n] = __builtin_amdgcn_mfma_f32_16x16x32_bf16(Bt[n][k], At[m][k], acc[ai][bj][m][n], 0, 0, 0); __builtin_amdgcn_s_setprio(0); } while (0)
#define PG8_WAIT_V(n) asm volatile("s_waitcnt vmcnt(" #n ")" ::: "memory")
#define PG8_WAIT_L(n) asm volatile("s_waitcnt lgkmcnt(" #n ")" ::: "memory")
#define PG8_BAR __builtin_amdgcn_s_barrier()
#define PG8_SCHED __builtin_amdgcn_sched_barrier(0)
    Unit cur, nxt; int ui = 0;
    if (!S.next(0, cur)) return;
    f32x4 acc[2][2][4][2];
#pragma unroll
    for (int a = 0; a < 2; ++a)
#pragma unroll
        for (int b = 0; b < 2; ++b)
#pragma unroll
            for (int m = 0; m < 4; ++m)
#pragma unroll
                for (int n = 0; n < 2; ++n) acc[a][b][m][n] = (f32x4){0.f, 0.f, 0.f, 0.f};
    bf16x8 At[4][2], B0[2][2], B1[2][2];
    const char* cA = (const char*)g.A + (size_t)cur.pm * tstep; const char* cB = (const char*)g.Bt + (size_t)cur.pn * tstep;
    S.a_ready(cur);
    if constexpr (SP2) {
        PG8_STAGE(PG8_SB(0, 0), cB, voffB); PG8_STAGE(PG8_SB(0, 1), cB + hstep, voffB); PG8_STAGE(PG8_SA(0, 0), cA, voffA); PG8_STAGE(PG8_SA(0, 1), cA + hstep, voffA);
        if (wr == 1) PG8_BAR;
        PG8_WAIT_V(2); PG8_BAR;
        PG8_STAGE(PG8_SB(1, 0), cB + kstep, voffB); PG8_STAGE(PG8_SA(1, 0), cA + kstep, voffA); PG8_STAGE(PG8_SB(1, 1), cB + hstep + kstep, voffB);
        PG8_WAIT_V(6); PG8_BAR;
    } else {
        PG8_STAGE(PG8_SB(0, 0), cB, voffB); PG8_STAGE(PG8_SA(0, 0), cA, voffA); PG8_STAGE(PG8_SB(0, 1), cB + hstep, voffB); PG8_STAGE(PG8_SA(0, 1), cA + hstep, voffA);
        if (wr == 1) PG8_BAR;
        PG8_WAIT_V(4); PG8_BAR;
        PG8_STAGE(PG8_SB(1, 0), cB + kstep, voffB); PG8_STAGE(PG8_SA(1, 0), cA + kstep, voffA); PG8_STAGE(PG8_SB(1, 1), cB + hstep + kstep, voffB);
        PG8_WAIT_V(6); PG8_BAR;
    }
    for (;;) {
        const bool has_next = S.next(ui + 1, nxt);
        const char* nA = has_next ? (const char*)g.A + (size_t)nxt.pm * tstep : cA; const char* nB = has_next ? (const char*)g.Bt + (size_t)nxt.pn * tstep : cB;
        for (int t = 0; t < nt; t += 2) {
            const bool last = (t == nt - 2);
            const char* a1 = cA + (size_t)(t + 1) * kstep;
            const char* a2 = last ? nA : cA + (size_t)(t + 2) * kstep; const char* b2 = last ? nB : cB + (size_t)(t + 2) * kstep;
            const char* a3 = a2 + kstep; const char* b3 = b2 + kstep;
            if (last && has_next) S.a_ready(nxt);
            if constexpr (SP2) {
            PG8_LDB(B0, 0, 0); PG8_LDB(B1, 0, 1); PG8_SCHED; PG8_LDA(At, 0, 0); PG8_STAGE(PG8_SA(1, 1), a1 + hstep, voffA);
            PG8_WAIT_V(8); PG8_WAIT_L(0); PG8_BAR; PG8_MMA(0, 0, At, B0); PG8_MMA(0, 1, At, B1); PG8_BAR; PG8_SCHED;
            PG8_LDA(At, 0, 1); PG8_STAGE(PG8_SB(0, 0), b2, voffB); PG8_STAGE(PG8_SB(0, 1), b2 + hstep, voffB); PG8_STAGE(PG8_SA(0, 0), a2, voffA);
            PG8_WAIT_V(8); PG8_WAIT_L(0); PG8_BAR; PG8_MMA(1, 0, At, B0); PG8_MMA(1, 1, At, B1); PG8_BAR; PG8_SCHED;
            PG8_LDB(B0, 1, 0); PG8_LDB(B1, 1, 1); PG8_SCHED; PG8_LDA(At, 1, 0); PG8_STAGE(PG8_SA(0, 1), a2 + hstep, voffA);
            PG8_WAIT_V(8); PG8_WAIT_L(0); PG8_BAR; PG8_MMA(0, 0, At, B0); PG8_MMA(0, 1, At, B1); PG8_BAR; PG8_SCHED;
            PG8_LDA(At, 1, 1); PG8_STAGE(PG8_SB(1, 0), b3, voffB); PG8_STAGE(PG8_SB(1, 1), b3 + hstep, voffB); PG8_STAGE(PG8_SA(1, 0), a3, voffA);
            PG8_WAIT_V(8); PG8_WAIT_L(0); PG8_BAR; PG8_MMA(1, 0, At, B0); PG8_MMA(1, 1, At, B1); PG8_BAR; PG8_SCHED;
            } else {
            PG8_LDB(B0, 0, 0); PG8_SCHED; PG8_LDA(At, 0, 0); PG8_STAGE(PG8_SA(1, 1), a1 + hstep, voffA);
            PG8_WAIT_L(8); PG8_BAR; PG8_WAIT_L(0); PG8_MMA(0, 0, At, B0); PG8_BAR; PG8_SCHED;
            PG8_LDB(B1, 0, 1); PG8_STAGE(PG8_SB(0, 0), b2, voffB);
            PG8_BAR; PG8_WAIT_L(0); PG8_MMA(0, 1, At, B1); PG8_BAR;
            PG8_LDA(At, 0, 1); PG8_STAGE(PG8_SA(0, 0), a2, voffA);
            PG8_BAR; PG8_WAIT_L(0); PG8_MMA(1, 0, At, B0); PG8_BAR; PG8_SCHED;
            PG8_STAGE(PG8_SB(0, 1), b2 + hstep, voffB);
            PG8_WAIT_V(6); PG8_BAR; PG8_MMA(1, 1, At, B1); PG8_BAR;
            PG8_LDB(B0, 1, 0); PG8_SCHED; PG8_LDA(At, 1, 0); PG8_STAGE(PG8_SA(0, 1), a2 + hstep, voffA);
            PG8_WAIT_L(8); PG8_BAR; PG8_WAIT_L(0); PG8_MMA(0, 0, At, B0); PG8_BAR; PG8_SCHED;
            PG8_LDB(B1, 1, 1); PG8_STAGE(PG8_SB(1, 0), b3, voffB);
            PG8_BAR; PG8_WAIT_L(0); PG8_MMA(0, 1, At, B1); PG8_BAR;
            PG8_LDA(At, 1, 1); PG8_STAGE(PG8_SA(1, 0), a3, voffA);
            PG8_BAR; PG8_WAIT_L(0); PG8_MMA(1, 0, At, B0); PG8_BAR; PG8_SCHED;
            PG8_STAGE(PG8_SB(1, 1), b3 + hstep, voffB);
            PG8_WAIT_V(6); PG8_BAR; PG8_MMA(1, 1, At, B1); PG8_BAR;
            }
        }
        if constexpr (ALIGN_EPI) { if (wr == 0) PG8_BAR; }
        if constexpr (!Epi::AFTER_DRAIN) { E(acc, cur, wr, wc, fr, fq); S.done(cur); }
        if (!has_next) break;
#pragma unroll
        for (int a = 0; a < 2; ++a)
#pragma unroll
            for (int b = 0; b < 2; ++b)
#pragma unroll
                for (int m = 0; m < 4; ++m)
#pragma unroll
                    for (int n = 0; n < 2; ++n) acc[a][b][m][n] = (f32x4){0.f, 0.f, 0.f, 0.f};
        cur = nxt; cA = nA; cB = nB; ++ui;
        if constexpr (ALIGN_EPI) { if (wr == 1) PG8_BAR; }
    }
    PG8_WAIT_V(0);
    if constexpr (!ALIGN_EPI) { if (wr == 0) PG8_BAR; }
    PG8_BAR;
    if constexpr (Epi::AFTER_DRAIN) { E.fused(acc, cur, wr, wc, fr, fq, lds, wid, lane); S.done(cur); }
#undef PG8_SA
#undef PG8_SB
#undef PG8_STAGE
#undef PG8_LDA
#undef PG8_LDB
#undef PG8_MMA
#undef PG8_WAIT_V
#undef PG8_WAIT_L
#undef PG8_BAR
#undef PG8_SCHED
}
}
#define LAS __attribute__((address_space(3)))
typedef unsigned v4u __attribute__((ext_vector_type(4)));
typedef float f32x4 __attribute__((ext_vector_type(4)));
typedef float f32x2 __attribute__((ext_vector_type(2)));
typedef unsigned u32x2 __attribute__((ext_vector_type(2)));
typedef short bf16x8 __attribute__((ext_vector_type(8)));
constexpr int NWAVES = 8, NTHR = 512;
constexpr int LDS_BYTES = 147456;
#define LDS_WAIT() asm volatile("s_waitcnt lgkmcnt(0)" ::: "memory")

#define XB_TMO      128
#define XB_XCNT(j)  (256  + 64 * (j))
#define XB_XSUB(j)  (1280 + 64 * (j))
#define XB_XGEN(j)  (2304 + 64 * (j))
#define XB_TOP      3328
#define XB_TOPGEN   3392
#define XCD_BAR_WORDS 3456
#define XB_SPIN_CAP (1u << 18)

__device__ __forceinline__ unsigned xb_ld(unsigned* p)              { return __hip_atomic_load(p, __ATOMIC_RELAXED, __HIP_MEMORY_SCOPE_AGENT); }
__device__ __forceinline__ unsigned xb_add(unsigned* p, unsigned v) { return __hip_atomic_fetch_add(p, v, __ATOMIC_RELAXED, __HIP_MEMORY_SCOPE_AGENT); }
__device__ __forceinline__ unsigned xb_xcc_id() { return (unsigned)__builtin_amdgcn_s_getreg((3 << 11) | 20) & 0xFu; }
#define XB_SPIN(cond, bar) do { unsigned _sp = 0; while (cond) { __builtin_amdgcn_s_sleep(1); \
    if ((++_sp & 255u) == 0u) { if (xb_ld(&(bar)[XB_TMO])) break; if (_sp > XB_SPIN_CAP) { atomicAdd(&(bar)[XB_TMO], 1u); break; } } } } while (0)

struct XcdBarrier {
    unsigned* bar; unsigned x;
    volatile LAS unsigned* st;
};

__device__ __forceinline__ XcdBarrier xcd_barrier_post(unsigned* bar, volatile LAS unsigned* st) {
    XcdBarrier b; b.bar = bar; b.x = xb_xcc_id(); b.st = st;
    if (threadIdx.x == 0) (void)xb_add(&bar[XB_XCNT(b.x)], 1u);
    return b;
}
__device__ __forceinline__ void xcd_barrier_complete(unsigned* bar, unsigned x, unsigned& nloc, unsigned& nx) {
    const unsigned G = gridDim.x * gridDim.y * gridDim.z;
    unsigned sum, cnt, mine, sp = 0u;
    for (;;) {
        sum = 0u; cnt = 0u; mine = 0u;
#pragma unroll
        for (unsigned j = 0; j < 16; ++j) { const unsigned c = xb_ld(&bar[XB_XCNT(j)]); sum += c; cnt += (c > 0u) ? 1u : 0u; mine = (j == x) ? c : mine; }
        if (sum == G) break;
        __builtin_amdgcn_s_sleep(1);
        if ((++sp & 255u) == 0u) { if (xb_ld(&bar[XB_TMO])) break; if (sp > XB_SPIN_CAP) { atomicAdd(&bar[XB_TMO], 1u); break; } }
    }
    nloc = mine > 0u ? mine : 1u; nx = cnt > 0u ? cnt : 1u;
}

__device__ __forceinline__ void xcd_barrier(const XcdBarrier& b) {
    asm volatile("s_waitcnt vmcnt(0)" ::: "memory");
    __syncthreads();
    if (threadIdx.x == 0) {
        unsigned* bar = b.bar;
        __builtin_amdgcn_s_waitcnt(0);
        unsigned nloc = b.st[0], nx = b.st[1];
        if (nloc == 0u) { xcd_barrier_complete(bar, b.x, nloc, nx); b.st[0] = nloc; b.st[1] = nx; }
#if BARRIER_WG_RELEASE
        __builtin_amdgcn_fence(__ATOMIC_RELEASE, "agent");
        asm volatile("s_waitcnt vmcnt(0)" ::: "memory");
#endif
        const unsigned old = xb_add(&bar[XB_XSUB(b.x)], 1u);
        const unsigned gen = old / nloc;
        if (old + 1u == (gen + 1u) * nloc) {
            __builtin_amdgcn_fence(__ATOMIC_RELEASE, "agent");
            asm volatile("s_waitcnt vmcnt(0)" ::: "memory");
            const unsigned og = xb_add(&bar[XB_TOP], 1u);
            const unsigned tg = og / nx;
            if (og + 1u == (tg + 1u) * nx) xb_add(&bar[XB_TOPGEN], 1u);
            else XB_SPIN(xb_ld(&bar[XB_TOPGEN]) == tg, bar);
            __builtin_amdgcn_fence(__ATOMIC_ACQUIRE, "agent");
            xb_add(&bar[XB_XGEN(b.x)], 1u);
            asm volatile("s_waitcnt vmcnt(0)" ::: "memory");
        } else {
            XB_SPIN(xb_ld(&bar[XB_XGEN(b.x)]) == gen, bar);
            __builtin_amdgcn_fence(__ATOMIC_ACQUIRE, "agent");
            asm volatile("s_waitcnt vmcnt(0)" ::: "memory");
        }
    }
    __syncthreads();
}

__device__ __forceinline__ f32x4 mfma16(bf16x8 a, bf16x8 b, f32x4 c) { return __builtin_amdgcn_mfma_f32_16x16x32_bf16(a, b, c, 0, 0, 0); }
struct Args { const float* in[36]; float* out; unsigned char* ws; int ph_lo, ph_hi, flags, pad; };
enum { I_XP = 0, I_XS, I_CP, I_CS, I_SSSD, I_SCONV, I_SRE, I_SIM, I_WADA, I_BADA, I_N1G, I_WIN, I_CONVW, I_CONVB, I_DTB, I_ALOG, I_SSDD, I_SSDNG, I_ARE, I_AIM, I_LSTEP, I_BRE, I_BIM,
       I_CRE, I_CIM, I_S5D, I_WGLU, I_BGLU, I_WOUT, I_N2G, I_WGATE, I_WUP, I_WDOWN, I_WADAF, I_BADAF, I_NFG };

__device__ __forceinline__ float wave_sum(float v) {
#pragma unroll
    for (int o = 1; o < 64; o <<= 1) v += __shfl_xor(v, o);
    return v;
}
__device__ __forceinline__ float fsilu0(float v) { return v * __builtin_amdgcn_rcpf(1.f + __expf(-v)); }
__device__ __forceinline__ void transpose_item(const float* src, int ldw, bf16* dst, int K) {
    f32x4 v[32];
#pragma unroll
    for (int i = 0; i < 32; ++i) v[i] = __builtin_nontemporal_load((const f32x4*)(src + (size_t)i * ldw));
#pragma unroll
    for (int j = 0; j < 4; ++j)
#pragma unroll
        for (int q = 0; q < 4; ++q) { v4u o; o.x = pk2(v[8 * q][j], v[8 * q + 1][j]); o.y = pk2(v[8 * q + 2][j], v[8 * q + 3][j]); o.z = pk2(v[8 * q + 4][j], v[8 * q + 5][j]); o.w = pk2(v[8 * q + 6][j], v[8 * q + 7][j]);
            *(v4u*)(dst + (size_t)j * K + 8 * q) = o; }
}

__device__ __forceinline__ unsigned cvtpk(float lo, float hi) { return pk2(lo, hi); }
#if PROBE_PH >= 0
#define PSTAMP(i) do { if (blockIdx.x == 0 && tid == 0) ((volatile LAS unsigned long long*)(lds + 140000))[i] = __builtin_amdgcn_s_memrealtime(); } while (0)
#else
#define PSTAMP(i) do { } while (0)
#endif
__device__ __forceinline__ void phase_prep(const Args& a, LAS unsigned char* lds, int tid, int lane, int wave) {
    unsigned char* ws = a.ws;
    PSTAMP(26);
    constexpr int NA = 128;
    if ((int)blockIdx.x >= NA) {   constexpr int I0 = 32 * 8, I1 = 16 * 2, I2 = 32 * 4, I3 = 32 * 22, I4 = 88 * 4, NIT = I0 + I1 + I2 + I3 + I4;
        const int wg = (int)blockIdx.x - NA, nwg = (int)gridDim.x - NA;
        for (int it = wave * nwg + wg; it < NIT; it += nwg * NWAVES) {
            int r = it;
            if (r < I0) { const int kb = r >> 3, nb = r & 7; transpose_item(a.in[I_WIN] + (size_t)(32 * kb) * INP + 256 * nb + (nb >= 6 ? 8 : 0) + 4 * lane, INP, (bf16*)(ws + WS_WIN) + (size_t)(256 * nb + 4 * lane) * 1024 + 32 * kb, 1024); continue; } r -= I0;
            if (r < I1) { const int kb = r >> 1, nb = r & 1; transpose_item(a.in[I_WGLU] + (size_t)(32 * kb) * 512 + 256 * nb + 4 * lane, 512, (bf16*)(ws + WS_WGLU) + (size_t)(256 * nb + 4 * lane) * 512 + 32 * kb, 512); continue; } r -= I1;
            if (r < I2) { const int kb = r >> 2, nb = r & 3; transpose_item(a.in[I_WOUT] + (size_t)(32 * kb) * 1024 + 256 * nb + 4 * lane, 1024, (bf16*)(ws + WS_WOUT) + (size_t)(256 * nb + 4 * lane) * 1024 + 32 * kb, 1024); continue; } r -= I2;
            if (r < I3) { const int kb = r / 22, pn = r % 22; transpose_item((lane < 32 ? a.in[I_WGATE] : a.in[I_WUP]) + (size_t)(32 * kb) * DFF + 128 * pn + 4 * (lane & 31), DFF, (bf16*)(ws + WS_WUP) + (size_t)(256 * pn + 4 * lane) * 1024 + 32 * kb, 1024); continue; } r -= I3;
            { const int kb = r >> 2, nb = r & 3; transpose_item(a.in[I_WDOWN] + (size_t)(32 * kb) * 1024 + 256 * nb + 4 * lane, 1024, (bf16*)(ws + WS_WDOWN) + (size_t)(256 * nb + 4 * lane) * DFF + 32 * kb, DFF); }
        }
        __syncthreads(); PSTAMP(27);
        for (int itx = tid * nwg + wg; itx < G5 * P5 * 4; itx += NTHR * nwg) { const int gp = itx >> 2, c0 = (itx & 3) * 4, g = gp / P5, p = gp % P5;
            const float lr = a.in[I_ARE][gp], li = a.in[I_AIM][gp], step = expf(a.in[I_LSTEP][g]);
            const float mag = expf(lr * step), abr = mag * cosf(li * step), abi = mag * sinf(li * step);
            const float nr = abr - 1.f, ni = abi, den = lr * lr + li * li, fr = (nr * lr + ni * li) / den, fi = (ni * lr - nr * li) / den;
            if (c0 == 0) { float* AB = (float*)(ws + WS_AB); AB[2 * gp] = abr; AB[2 * gp + 1] = abi;
                float pr = abr, pi = abi;
#pragma unroll
                for (int q = 0; q < 7; ++q) { const float t = pr * pr - pi * pi; pi = 2.f * pr * pi; pr = t; }
                AB[2 * G5 * P5 + 2 * gp] = pr; AB[2 * G5 * P5 + 2 * gp + 1] = pi; }
            bf16* BB = (bf16*)(ws + WS_BB) + ((size_t)g * 128 + 2 * p) * 16; bf16* CC = (bf16*)(ws + WS_CC) + (size_t)g * 16 * 128 + 2 * p;
            float brv[4], biv[4], crv[4], civ[4];
#pragma unroll
            for (int c = 0; c < 4; ++c) { brv[c] = a.in[I_BRE][(size_t)gp * CH5 + c0 + c]; biv[c] = a.in[I_BIM][(size_t)gp * CH5 + c0 + c]; crv[c] = a.in[I_CRE][((size_t)g * CH5 + c0 + c) * P5 + p]; civ[c] = a.in[I_CIM][((size_t)g * CH5 + c0 + c) * P5 + p]; }
#pragma unroll
            for (int c = 0; c < 4; ++c) { BB[c0 + c] = (bf16)f2bf(fr * brv[c] - fi * biv[c]); BB[16 + c0 + c] = (bf16)f2bf(fr * biv[c] + fi * brv[c]); CC[(c0 + c) * 128] = (bf16)f2bf(crv[c]); CC[(c0 + c) * 128 + 1] = (bf16)f2bf(-civ[c]); } }
    }
    __syncthreads(); PSTAMP(28);
    if ((int)blockIdx.x >= NA) return;
    constexpr int SCP = 264;
    LAS bf16* SC = (LAS bf16*)lds;
    for (int e = tid; e < 8 * SCP / 2; e += NTHR) ((LAS unsigned*)(SC + 136 * SCP))[e] = 0u;
    for (int wb = blockIdx.x; wb < NMOD / 64; wb += NA) {
        const int j0 = 64 * wb; const bool fin = j0 >= 6144; const float* W = fin ? a.in[I_WADAF] : a.in[I_WADA]; const int ldw = fin ? 2048 : 6144, jc = fin ? j0 - 6144 : j0;
        const float* bias = (fin ? a.in[I_BADAF] : a.in[I_BADA]) + jc;
        const int nt = wave & 3, mg = wave >> 2, fr = lane & 15, fq = lane >> 4;
        f32x4 acc[5];
#pragma unroll
        for (int i = 0; i < 5; ++i) acc[i] = (f32x4){0.f, 0.f, 0.f, 0.f};
#pragma unroll 1
        for (int q = 0; q < 4; ++q) {
            float wv[8][8];
            const float* wp = W + (size_t)(256 * q + 8 * fq) * ldw + jc + 16 * nt + fr;
#pragma unroll
            for (int kk = 0; kk < 8; ++kk)
#pragma unroll
                for (int j = 0; j < 8; ++j) wv[kk][j] = wp[(size_t)(32 * kk + j) * ldw];
            {   f32x4 cv[17];
#pragma unroll
                for (int i = 0; i < 17; ++i) { const int e = tid + NTHR * i, s = e >> 6, k4 = (e & 63) * 4;
                    cv[i] = *(const f32x4*)((s < NP ? a.in[I_CP] + (size_t)s * D : a.in[I_CS] + (size_t)(s - NP) * D) + 256 * q + k4); }
#pragma unroll
                for (int i = 0; i < 17; ++i) { const int e = tid + NTHR * i, s = e >> 6, k4 = (e & 63) * 4;
                    u32x2 w; w.x = cvtpk(fsilu0(cv[i][0]), fsilu0(cv[i][1])); w.y = cvtpk(fsilu0(cv[i][2]), fsilu0(cv[i][3])); *(LAS u32x2*)(SC + s * SCP + k4) = w; } }
            __syncthreads();
#pragma unroll
            for (int kk = 0; kk < 8; ++kk) { v4u bw;
#pragma unroll
                for (int j = 0; j < 4; ++j) bw[j] = cvtpk(wv[kk][2 * j], wv[kk][2 * j + 1]);
                bf16x8 bfr = __builtin_bit_cast(bf16x8, bw);
                asm volatile("s_nop 7" : "+v"(bfr));
#pragma unroll
                for (int i = 0; i < 5; ++i) if (i < 4 || mg == 0) { const bf16x8 afr = *(const LAS bf16x8*)(SC + (16 * (mg + 2 * i) + fr) * SCP + 32 * kk + 8 * fq);
                    acc[i] = __builtin_amdgcn_mfma_f32_16x16x32_bf16(afr, bfr, acc[i], 0, 0, 0); } }
            __syncthreads();
        }
        asm volatile("s_nop 15\n\ts_nop 15" : "+v"(acc[0]), "+v"(acc[1]), "+v"(acc[2]), "+v"(acc[3]), "+v"(acc[4]));
        const float bv = bias[16 * nt + fr];
#pragma unroll
        for (int i = 0; i < 5; ++i) if (i < 4 || mg == 0)
#pragma unroll
            for (int r = 0; r < 4; ++r) { const int s = 16 * (mg + 2 * i) + 4 * fq + r; if (s < NSEQ) ((float*)(ws + WS_MOD))[(size_t)s * NMOD + j0 + 16 * nt + fr] = acc[i][r] + bv; }
    }
    __syncthreads();
}

template <int MODE> __device__ __forceinline__ const float* modnorm_src(const Args& a, int row) {
    return MODE == 0 ? (row < MP ? a.in[I_XP] + (size_t)row * D : a.in[I_XS] + (size_t)(row - MP) * D) : a.out + OUT_Y + (size_t)row * D; }
template <int MODE> __device__ __forceinline__ void modnorm_apply(const Args& a, int row, int lane, const LAS float* wdt, f32x4 (&v)[4]) {
    unsigned char* ws = a.ws; const float* mod = (const float*)(ws + WS_MOD);
    const int sh_off = MODE == 0 ? 0 : (MODE == 1 ? 3072 : 6144), sc_off = sh_off + 1024;
    const float* gam = a.in[MODE == 0 ? I_N1G : (MODE == 1 ? I_N2G : I_NFG)];
    const int s = seq_of_row(row);
    float ss = 0.f;
#pragma unroll
    for (int j = 0; j < 4; ++j) ss += (v[j][0] * v[j][0] + v[j][1] * v[j][1]) + (v[j][2] * v[j][2] + v[j][3] * v[j][3]);
    const float inv = rsqrtf(wave_sum(ss) * (1.f / D) + EPS);
    const float* ms = mod + (size_t)s * NMOD;
#pragma unroll
    for (int j = 0; j < 4; ++j) { const int c = 4 * lane + 256 * j; const f32x4 g = *(const f32x4*)(gam + c), sc = *(const f32x4*)(ms + sc_off + c), sh = *(const f32x4*)(ms + sh_off + c);
        v[j] = v[j] * inv * g * (sc + 1.f) + sh; }
    if (MODE == 2) {
#pragma unroll
        for (int j = 0; j < 4; ++j) *(f32x4*)(a.out + OUT_Y + (size_t)row * D + 4 * lane + 256 * j) = v[j];
    } else {
        bf16* o = (bf16*)(ws + WS_U) + (size_t)row * D;
#pragma unroll
        for (int j = 0; j < 4; ++j) { u32x2 w; w.x = pk2(v[j][0], v[j][1]); w.y = pk2(v[j][2], v[j][3]); *(u32x2*)(o + 4 * lane + 256 * j) = w; }
    }
    if (MODE == 0) {
        float d[8];
#pragma unroll
        for (int h = 0; h < 8; ++h) { float t = 0.f;
#pragma unroll
            for (int j = 0; j < 4; ++j) { const f32x4 w = *(const LAS f32x4*)(wdt + h * 1024 + 4 * lane + 256 * j); t += (v[j][0] * w[0] + v[j][1] * w[1]) + (v[j][2] * w[2] + v[j][3] * w[3]); }
            d[h] = t; }
        const bool b0 = lane & 1, b1 = lane & 2, b2 = lane & 4;
        float k4[4];
#pragma unroll
        for (int i = 0; i < 4; ++i) { const float keep = b0 ? d[i + 4] : d[i], send = b0 ? d[i] : d[i + 4]; k4[i] = keep + __shfl_xor(send, 1); }
        float k2[2];
#pragma unroll
        for (int i = 0; i < 2; ++i) { const float keep = b1 ? k4[i + 2] : k4[i], send = b1 ? k4[i] : k4[i + 2]; k2[i] = keep + __shfl_xor(send, 2); }
        float k1 = (b2 ? k2[1] : k2[0]) + __shfl_xor(b2 ? k2[0] : k2[1], 4);
        k1 += __shfl_xor(k1, 8); k1 += __shfl_xor(k1, 16); k1 += __shfl_xor(k1, 32);
        if (lane < 8) ((float*)(ws + WS_DT))[(size_t)row * 8 + 4 * (lane & 1) + (lane & 2) + ((lane >> 2) & 1)] = k1;
    }
}
template <int MODE> __device__ __forceinline__ void modnorm_row(const Args& a, int row, int lane, const LAS float* wdt) {
    const float* x = modnorm_src<MODE>(a, row); f32x4 v[4];
#pragma unroll
    for (int j = 0; j < 4; ++j) v[j] = *(const f32x4*)(x + 4 * lane + 256 * j);
    modnorm_apply<MODE>(a, row, lane, wdt, v);
}
template <int MODE> __device__ __forceinline__ void phase_modnorm(const Args& a, LAS unsigned char* lds, int tid, int lane, int wave) {
    LAS float* wdt = (LAS float*)lds;
    if (MODE == 0) { for (int e = tid; e < 8192; e += NTHR) { const int k = e >> 3, h = e & 7; wdt[h * 1024 + k] = a.in[I_WIN][(size_t)k * INP + O2 + h]; } __syncthreads(); }
    const int gw = blockIdx.x * NWAVES + wave, NGW = gridDim.x * NWAVES;
    for (int row = gw; row < M; row += NGW) modnorm_row<MODE>(a, row, lane, wdt);
}

#if PROBE_PH >= 0
#define SUBSTAMP(i) do { if (blockIdx.x == 0 && threadIdx.x == 0) ((volatile LAS unsigned long long*)((LAS unsigned char*)lds + (LDS_BYTES - 512)))[i] = __builtin_amdgcn_s_memrealtime(); } while (0)
#else
#define SUBSTAMP(i) do { } while (0)
#endif
#define MFMA_SETTLE(x) asm volatile("s_nop 15\n\ts_nop 15" : "+v"(x))
constexpr int PT = 136;
typedef float f32x16 __attribute__((ext_vector_type(16)));
__device__ __forceinline__ bf16x8 ldfrag(const LAS bf16* base, int row, int k) { return *(const LAS bf16x8*)(base + row * PT + k); }
__device__ __forceinline__ float fsilu(float v) { return v * __builtin_amdgcn_rcpf(1.f + __expf(-v)); }

typedef float f32x2 __attribute__((ext_vector_type(2)));
__device__ __forceinline__ f32x2 gelu_pk(f32x2 v) {
    const f32x2 av = __builtin_elementwise_abs(v), d = av * 0.2316418882f + 1.0f;
    f32x2 t; t.x = __builtin_amdgcn_rcpf(d.x); t.y = __builtin_amdgcn_rcpf(d.y);
    f32x2 q = t * 0.5307027145f + (-0.7265760135f); q = q * t + 0.7107068705f; q = q * t + (-0.142248368f); q = q * t + 0.127414796f; q = q * t;
    const f32x2 s = (v * v) * (-0.72134752044f);
    f32x2 e; e.x = __builtin_amdgcn_exp2f(s.x); e.y = __builtin_amdgcn_exp2f(s.y);
    const f32x2 m = v * (q * e), r = v - m;
    f32x2 o; o.x = v.x < 0.f ? m.x : r.x; o.y = v.y < 0.f ? m.y : r.y; return o;
}

struct ConvPair {
    float w0[4], w1[4], b0, b1, h0[3], h1[3];
    __device__ __forceinline__ void init(const Args& a, int ch) {
#pragma unroll
        for (int k = 0; k < 4; ++k) { const f32x2 w = *(const f32x2*)(a.in[I_CONVW] + k * CONVD + ch); w0[k] = w.x; w1[k] = w.y; }
        const f32x2 b = *(const f32x2*)(a.in[I_CONVB] + ch); b0 = b.x; b1 = b.y;
    }
    __device__ __forceinline__ void hist(int i, unsigned pr) { h0[i] = bflo(pr); h1[i] = bfhi(pr); }
    __device__ __forceinline__ void step(unsigned pr, float& o0, float& o1) {
        const float x0 = bflo(pr), x1 = bfhi(pr);
        o0 = fsilu(b0 + w0[0] * h0[0] + w0[1] * h0[1] + w0[2] * h0[2] + w0[3] * x0);
        o1 = fsilu(b1 + w1[0] * h1[0] + w1[1] * h1[1] + w1[2] * h1[2] + w1[3] * x1);
        h0[0] = h0[1]; h0[1] = h0[2]; h0[2] = x0; h1[0] = h1[1]; h1[1] = h1[2]; h1[2] = x1;
    }
};

__device__ __forceinline__ void ssd_pass1_unit(const Args& a, LAS unsigned char* lds, int tid, int lane, int wave, int b, int c, int g) {
    unsigned char* ws = a.ws;
    const bf16* PROJ = (const bf16*)(ws + WS_PROJ); bf16* XC = (bf16*)(ws + WS_XC);
    const int r0 = b * LP + c * 128, fr = lane & 15, fq = lane >> 4;
    LAS bf16* Bn = (LAS bf16*)lds;
    LAS bf16* Cn = Bn + 128 * PT;
    LAS bf16* Xt = (LAS bf16*)lds;
    LAS bf16* Bt = (LAS bf16*)(lds + 69632);
    LAS float* sAcs = (LAS float*)(lds + 104448);
    LAS float* sW = sAcs + 512;
    SUBSTAMP(40);
    if (wave < 4) {
        const int h = 4 * g + wave; const float A = -expf(a.in[I_ALOG][h]), bias = a.in[I_DTB][h];
        const float* dtr = (const float*)(ws + WS_DT);
        const float d0 = softplusf(dtr[(size_t)(r0 + lane) * 8 + h] + bias), d1 = softplusf(dtr[(size_t)(r0 + 64 + lane) * 8 + h] + bias);
        float s0 = d0 * A, s1 = d1 * A;
#pragma unroll
        for (int o = 1; o < 64; o <<= 1) { const float t0 = __shfl_up(s0, o), t1 = __shfl_up(s1, o); if (lane >= o) { s0 += t0; s1 += t1; } }
        s1 += __shfl(s0, 63); const float last = __shfl(s1, 63);
        sAcs[wave * 128 + lane] = s0; sAcs[wave * 128 + 64 + lane] = s1;
        sW[wave * 128 + lane] = d0 * expf(last - s0); sW[wave * 128 + 64 + lane] = d1 * expf(last - s1);
        float* rec = (float*)(ws + WS_ACS) + ((size_t)(b * 16 + c) * H + h) * 256;
        rec[lane] = s0; rec[64 + lane] = s1; rec[128 + lane] = d0; rec[192 + lane] = d1;
    }
    {
        const int cp = tid & 127, tr = tid >> 7, c2 = 2 * cp;
        const int ch = c2 < 128 ? DSSD + NST * g + c2 : DSSD + NG * NST + NST * g + (c2 - 128);
        ConvPair cv; cv.init(a, ch);
        const bf16* src = PROJ + (size_t)(r0 + 32 * tr) * NPROJ + O1 + ch;
        if (c == 0 && tr == 0) { cv.hist(0, 0u); cv.hist(1, 0u); cv.hist(2, 0u); }
        else {
#pragma unroll
            for (int i = 0; i < 3; ++i) cv.hist(i, *(const unsigned*)(src + (ptrdiff_t)(i - 3) * NPROJ)); }
        LAS bf16* nat = c2 < 128 ? Bn + c2 : Cn + (c2 - 128);
        for (int blk = 0; blk < 4; ++blk) {
            unsigned pr[8]; float o0[8], o1[8];
#pragma unroll
            for (int i = 0; i < 8; ++i) pr[i] = *(const unsigned*)(src + (size_t)(8 * blk + i) * NPROJ);
#pragma unroll
            for (int i = 0; i < 8; ++i) cv.step(pr[i], o0[i], o1[i]);
            const int l0 = 32 * tr + 8 * blk;
#pragma unroll
            for (int i = 0; i < 8; ++i) *(LAS unsigned*)(nat + (l0 + i) * PT) = pk2(o0[i], o1[i]);
            if (c2 >= 128) {
#pragma unroll
                for (int i = 0; i < 8; ++i) *(unsigned*)(XC + (size_t)(r0 + l0 + i) * CONVD + ch) = pk2(o0[i], o1[i]);
            } else {
                v4u t0, t1; t0.x = pk2(o0[0], o0[1]); t0.y = pk2(o0[2], o0[3]); t0.z = pk2(o0[4], o0[5]); t0.w = pk2(o0[6], o0[7]);
                t1.x = pk2(o1[0], o1[1]); t1.y = pk2(o1[2], o1[3]); t1.z = pk2(o1[4], o1[5]); t1.w = pk2(o1[6], o1[7]);
                *(LAS v4u*)(Bt + c2 * PT + l0) = t0; *(LAS v4u*)(Bt + (c2 + 1) * PT + l0) = t1;
            }
        }
    }
    __syncthreads(); SUBSTAMP(41);
    {
        bf16x8 cf[4];
#pragma unroll
        for (int kk = 0; kk < 4; ++kk) cf[kk] = ldfrag(Cn, 16 * wave + fr, 32 * kk + 8 * fq);
        bf16* Gg = (bf16*)(ws + WS_G) + (size_t)((b * 16 + c) * NG + g) * 128 * 128;
        for (int st = 0; st <= wave; ++st) {
            f32x4 acc = (f32x4){0.f, 0.f, 0.f, 0.f};
#pragma unroll
            for (int kk = 0; kk < 4; ++kk) acc = mfma16(ldfrag(Bn, 16 * st + fr, 32 * kk + 8 * fq), cf[kk], acc);
            MFMA_SETTLE(acc);
            u32x2 w; w.x = pk2(acc[0], acc[1]); w.y = pk2(acc[2], acc[3]);
            *(u32x2*)(Gg + (size_t)(16 * wave + fr) * 128 + 16 * st + 4 * fq) = w;
        }
    }
    __syncthreads(); SUBSTAMP(42);
    {
        const int cp = tid & 127, tr = tid >> 7, c2 = 2 * cp, ch = 256 * g + c2, hh = c2 >> 6;
        ConvPair cv; cv.init(a, ch);
        const bf16* src = PROJ + (size_t)(r0 + 32 * tr) * NPROJ + O1 + ch;
        if (c == 0 && tr == 0) { cv.hist(0, 0u); cv.hist(1, 0u); cv.hist(2, 0u); }
        else {
#pragma unroll
            for (int i = 0; i < 3; ++i) cv.hist(i, *(const unsigned*)(src + (ptrdiff_t)(i - 3) * NPROJ)); }
        for (int blk = 0; blk < 4; ++blk) {
            unsigned pr[8]; float o0[8], o1[8];
#pragma unroll
            for (int i = 0; i < 8; ++i) pr[i] = *(const unsigned*)(src + (size_t)(8 * blk + i) * NPROJ);
#pragma unroll
            for (int i = 0; i < 8; ++i) cv.step(pr[i], o0[i], o1[i]);
            const int l0 = 32 * tr + 8 * blk;
#pragma unroll
            for (int i = 0; i < 8; ++i) *(unsigned*)(XC + (size_t)(r0 + l0 + i) * CONVD + ch) = pk2(o0[i], o1[i]);
            const f32x4 wa = *(const LAS f32x4*)(sW + hh * 128 + l0), wb = *(const LAS f32x4*)(sW + hh * 128 + l0 + 4);
            v4u t0, t1; t0.x = pk2(o0[0] * wa[0], o0[1] * wa[1]); t0.y = pk2(o0[2] * wa[2], o0[3] * wa[3]); t0.z = pk2(o0[4] * wb[0], o0[5] * wb[1]); t0.w = pk2(o0[6] * wb[2], o0[7] * wb[3]);
            t1.x = pk2(o1[0] * wa[0], o1[1] * wa[1]); t1.y = pk2(o1[2] * wa[2], o1[3] * wa[3]); t1.z = pk2(o1[4] * wb[0], o1[5] * wb[1]); t1.w = pk2(o1[6] * wb[2], o1[7] * wb[3]);
            *(LAS v4u*)(Xt + c2 * PT + l0) = t0; *(LAS v4u*)(Xt + (c2 + 1) * PT + l0) = t1;
        }
    }
    __syncthreads(); SUBSTAMP(43);
    {
        const int hh = wave >> 1, nt0 = 4 * (wave & 1);
        f32x4 acc[4][4];
#pragma unroll
        for (int i = 0; i < 4; ++i)
#pragma unroll
            for (int j = 0; j < 4; ++j) acc[i][j] = (f32x4){0.f, 0.f, 0.f, 0.f};
#pragma unroll
        for (int kk = 0; kk < 4; ++kk) { bf16x8 bfr[4], xfr[4];
#pragma unroll
            for (int i = 0; i < 4; ++i) { bfr[i] = ldfrag(Bt, 16 * (nt0 + i) + fr, 32 * kk + 8 * fq); xfr[i] = ldfrag(Xt, 64 * hh + 16 * i + fr, 32 * kk + 8 * fq); }
#pragma unroll
            for (int i = 0; i < 4; ++i)
#pragma unroll
                for (int j = 0; j < 4; ++j) acc[i][j] = mfma16(bfr[i], xfr[j], acc[i][j]); }
        MFMA_SETTLE(acc[3][3]);
        bf16* CSp = (bf16*)(ws + WS_CS) + ((size_t)((b * 16 + c) * H + 4 * g + hh)) * PD * NST;
#pragma unroll
        for (int i = 0; i < 4; ++i)
#pragma unroll
            for (int j = 0; j < 4; ++j) { u32x2 w; w.x = pk2(acc[i][j][0], acc[i][j][1]); w.y = pk2(acc[i][j][2], acc[i][j][3]); *(u32x2*)(CSp + (size_t)(16 * j + fr) * NST + 16 * (nt0 + i) + 4 * fq) = w; }
    }
    __syncthreads(); SUBSTAMP(44);
}

__device__ __forceinline__ void ssd_sample_unit(const Args& a, LAS unsigned char* lds, int tid, int lane, int wave, int bs, int g) {
    unsigned char* ws = a.ws; const bf16* PROJ = (const bf16*)(ws + WS_PROJ);
    const int r0 = MP + 4 * bs;
    LAS float* sx = (LAS float*)lds;
    LAS float* sB = sx + 1024;
    LAS float* sC = sB + 512;
    LAS float* sdt = sC + 512;
    LAS float* yp = sdt + 32;
    LAS float* red = yp + 2048;
    {   const int idx = tid, ch = idx < 256 ? 256 * g + idx : (idx < 384 ? DSSD + NST * g + (idx - 256) : DSSD + NG * NST + NST * g + (idx - 384));
        float w[4], hs[7];
#pragma unroll
        for (int k = 0; k < 4; ++k) w[k] = a.in[I_CONVW][k * CONVD + ch];
        const float bb = a.in[I_CONVB][ch];
#pragma unroll
        for (int i = 0; i < 3; ++i) hs[i] = a.in[I_SCONV][((size_t)bs * 3 + i) * CONVD + ch];
#pragma unroll
        for (int i = 0; i < 4; ++i) hs[3 + i] = bf2f(PROJ[(size_t)(r0 + i) * NPROJ + O1 + ch]);
#pragma unroll
        for (int t = 0; t < 4; ++t) { const float v = fsilu(bb + w[0] * hs[t] + w[1] * hs[t + 1] + w[2] * hs[t + 2] + w[3] * hs[t + 3]);
            if (idx < 256) sx[t * 256 + idx] = v; else if (idx < 384) sB[t * 128 + idx - 256] = v; else sC[t * 128 + idx - 384] = v; }
    }
    if (tid < 16) { const int t = tid >> 2, hh = tid & 3, h = 4 * g + hh; const float dt = softplusf(((const float*)(ws + WS_DT))[(size_t)(r0 + t) * 8 + h] + a.in[I_DTB][h]);
        sdt[t * 4 + hh] = dt; sdt[16 + t * 4 + hh] = expf(-dt * expf(a.in[I_ALOG][h])); }
    __syncthreads();
    {   const int hh = wave >> 1, nh = wave & 1, h = 4 * g + hh, p = lane;
        const float* s0 = a.in[I_SSSD] + (((size_t)bs * H + h) * PD + p) * NST + 64 * nh;
        f32x4 st[16];
#pragma unroll
        for (int j = 0; j < 16; ++j) st[j] = *(const f32x4*)(s0 + 4 * j);
#pragma unroll
        for (int t = 0; t < 4; ++t) { const float dA = sdt[16 + t * 4 + hh], dx = sdt[t * 4 + hh] * sx[t * 256 + 64 * hh + p]; float y = 0.f;
#pragma unroll
            for (int j = 0; j < 16; ++j) { const f32x4 Bv = *(const LAS f32x4*)(sB + t * 128 + 64 * nh + 4 * j), Cv = *(const LAS f32x4*)(sC + t * 128 + 64 * nh + 4 * j);
                st[j] = st[j] * dA + Bv * dx; y += (Cv[0] * st[j][0] + Cv[1] * st[j][1]) + (Cv[2] * st[j][2] + Cv[3] * st[j][3]); }
            yp[(nh * 4 + t) * 256 + 64 * hh + p] = y; }
        float* o = a.out + OUT_SSDS + (((size_t)bs * H + h) * PD + p) * NST + 64 * nh;
#pragma unroll
        for (int j = 0; j < 16; ++j) *(f32x4*)(o + 4 * j) = st[j];
    }
    __syncthreads();
    {   const int ch = tid & 255, t0 = tid >> 8; float v[2];
#pragma unroll
        for (int i = 0; i < 2; ++i) { const int t = t0 + 2 * i; const float y = yp[t * 256 + ch] + yp[(4 + t) * 256 + ch] + a.in[I_SSDD][4 * g + (ch >> 6)] * sx[t * 256 + ch];
            v[i] = y * fsilu(bf2f(PROJ[(size_t)(r0 + t) * NPROJ + 256 * g + ch])); }
        const float q0 = wave_sum(v[0] * v[0]), q1 = wave_sum(v[1] * v[1]);
        if (lane == 0) { red[wave * 2] = q0; red[wave * 2 + 1] = q1; }
        __syncthreads();
        const int wb = (wave >> 2) * 4; const float ngv = a.in[I_SSDNG][256 * g + ch];
#pragma unroll
        for (int i = 0; i < 2; ++i) { const float tot = (red[(wb + 0) * 2 + i] + red[(wb + 1) * 2 + i]) + (red[(wb + 2) * 2 + i] + red[(wb + 3) * 2 + i]);
            ((bf16*)(ws + WS_MIX))[(size_t)(r0 + t0 + 2 * i) * D + 256 * g + ch] = (bf16)f2bf(v[i] * rsqrtf(tot * (1.f / 256.f) + EPS) * ngv); }
    }
    __syncthreads();
}

template <int MODE> __device__ __forceinline__ void s5_unit(const Args& a, LAS unsigned char* ldsw, int lane, int unit) {
    unsigned char* ws = a.ws; const bf16* PROJ = (const bf16*)(ws + WS_PROJ);
    const int g = unit & 31, q = unit >> 5;
    const int b = q >> 4, c = q & 15;
    const int row0 = MODE == 2 ? MP + 32 * q : b * LP + 128 * c, nsub = MODE == 2 ? 1 : 4;
    const float* AB = (const float*)(ws + WS_AB);
    const float abr = AB[2 * (g * P5 + lane)], abi = AB[2 * (g * P5 + lane) + 1];
    LAS float* BUs = (LAS float*)ldsw;
    bf16x8 bfr[4];
#pragma unroll
    for (int cb = 0; cb < 4; ++cb) bfr[cb] = *(const bf16x8*)((const bf16*)(ws + WS_BB) + ((size_t)g * 128 + 32 * cb + (lane & 31)) * 16 + 8 * (lane >> 5));
    bf16x8 cfr[4];
    if (MODE >= 1) {
#pragma unroll
        for (int kk = 0; kk < 4; ++kk) cfr[kk] = *(const bf16x8*)((const bf16*)(ws + WS_CC) + ((size_t)g * 16 + (lane & 15)) * 128 + 32 * kk + 8 * (lane >> 4)); }
    float hr = 0.f, hi = 0.f;
    if (MODE == 1) { const float pr = AB[2 * G5 * P5 + 2 * (g * P5 + lane)], pi = AB[2 * G5 * P5 + 2 * (g * P5 + lane) + 1];
        f32x2 ev[15];
#pragma unroll
        for (int cc = 0; cc < 15; ++cc) ev[cc] = cc < c ? *(const f32x2*)((const float*)(ws + WS_S5E) + ((size_t)((b * 16 + cc) * G5 + g)) * 128 + 2 * lane) : (f32x2){0.f, 0.f};
#pragma unroll
        for (int cc = 0; cc < 15; ++cc) if (cc < c) { const float nr = pr * hr - pi * hi + ev[cc].x, ni = pr * hi + pi * hr + ev[cc].y; hr = nr; hi = ni; } }
    const bf16* aptr = PROJ + (size_t)(row0 + (lane & 31)) * NPROJ + 1536 + 16 * g + 8 * (lane >> 5);
    bf16x8 afr_nx = *(const bf16x8*)aptr;
#pragma unroll 1
    for (int sub = 0; sub < nsub; ++sub) {
        const int rb = row0 + 32 * sub;
        bf16x8 afr = afr_nx;
        asm volatile("s_nop 7" : "+v"(afr));
        if (sub + 1 < nsub) afr_nx = *(const bf16x8*)(aptr + (size_t)(32 * (sub + 1)) * NPROJ);
        {   f32x16 dd[4];
#pragma unroll
            for (int cb = 0; cb < 4; ++cb) {
#pragma unroll
                for (int i = 0; i < 16; ++i) dd[cb][i] = 0.f;
                dd[cb] = __builtin_amdgcn_mfma_f32_32x32x16_bf16(afr, bfr[cb], dd[cb], 0, 0, 0); }
            asm volatile("s_nop 15\n\ts_nop 15\n\ts_nop 15\n\ts_nop 15" : "+v"(dd[0]), "+v"(dd[1]), "+v"(dd[2]), "+v"(dd[3]));
#pragma unroll
            for (int cb = 0; cb < 4; ++cb)
#pragma unroll
                for (int i = 0; i < 16; ++i) BUs[((i & 3) + 8 * (i >> 2) + 4 * (lane >> 5)) * 132 + 32 * cb + (lane & 31)] = dd[cb][i]; }
        LDS_WAIT();
        float h0r[8], h0i[8];
        if (MODE == 2) {
#pragma unroll
            for (int i = 0; i < 8; ++i) { const int bs = ((rb - MP) >> 2) + i; h0r[i] = a.in[I_SRE][((size_t)bs * G5 + g) * P5 + lane]; h0i[i] = a.in[I_SIM][((size_t)bs * G5 + g) * P5 + lane]; } }
#pragma unroll
        for (int t0 = 0; t0 < 32; t0 += 8) {
            f32x2 bu[8];
#pragma unroll
            for (int i = 0; i < 8; ++i) bu[i] = *(const LAS f32x2*)(BUs + (t0 + i) * 132 + 2 * lane);
#pragma unroll
            for (int i = 0; i < 8; ++i) { const int t = t0 + i;
                if (MODE == 2 && (t & 3) == 0) { hr = h0r[t >> 2]; hi = h0i[t >> 2]; }
                const float nr = abr * hr - abi * hi + bu[i].x, ni = abr * hi + abi * hr + bu[i].y; hr = nr; hi = ni;
                if (MODE >= 1) *(LAS unsigned*)((LAS bf16*)(BUs + t * 132) + 2 * lane) = pk2(hr, hi);
                if (MODE == 2 && (t & 3) == 3) { const int bs = (rb - MP + t) >> 2; a.out[OUT_RES + ((size_t)bs * G5 + g) * P5 + lane] = hr; a.out[OUT_IMS + ((size_t)bs * G5 + g) * P5 + lane] = hi; } }
        }
        if (MODE >= 1) {
            LDS_WAIT();
            const int fr = lane & 15, fq = lane >> 4;
#pragma unroll
            for (int tt = 0; tt < 2; ++tt) { f32x4 y = (f32x4){0.f, 0.f, 0.f, 0.f};
#pragma unroll
                for (int kk = 0; kk < 4; ++kk) y = mfma16(cfr[kk], *(const LAS bf16x8*)((const LAS bf16*)(BUs + (16 * tt + fr) * 132) + 32 * kk + 8 * fq), y);
                MFMA_SETTLE(y);
                const int row = rb + 16 * tt + fr, co = 16 * g + 4 * fq;
                const u32x2 uu = *(const u32x2*)(PROJ + (size_t)row * NPROJ + 1536 + co); const f32x4 dk = *(const f32x4*)(a.in[I_S5D] + co);
                const f32x2 g0 = gelu_pk((f32x2){y[0] + dk[0] * bflo(uu.x), y[1] + dk[1] * bfhi(uu.x)}), g1 = gelu_pk((f32x2){y[2] + dk[2] * bflo(uu.y), y[3] + dk[3] * bfhi(uu.y)});
                u32x2 w; w.x = pk2(g0.x, g0.y); w.y = pk2(g1.x, g1.y);
                *(u32x2*)((bf16*)(ws + WS_GY) + (size_t)row * DS5 + co) = w; }
            LDS_WAIT();
        }
    }
    if (MODE == 0) { f32x2 e; e.x = hr; e.y = hi; *(f32x2*)((float*)(ws + WS_S5E) + ((size_t)((b * 16 + c) * G5 + g)) * 128 + 2 * lane) = e; }
    if (MODE == 1 && c == 15) { a.out[OUT_REP + ((size_t)b * G5 + g) * P5 + lane] = hr; a.out[OUT_IMP + ((size_t)b * G5 + g) * P5 + lane] = hi; }
}

__device__ __forceinline__ void phase_mix1(const Args& a, LAS unsigned char* lds, int tid, int lane, int wave) {
    unsigned char* ws = a.ws;
    SUBSTAMP(16);
    if (a.flags & 1) {
    for (int u = blockIdx.x; u < NP * 16 * NG; u += gridDim.x) ssd_pass1_unit(a, lds, tid, lane, wave, u >> 5, (u >> 1) & 15, u & 1);
    SUBSTAMP(17);
    for (int u = blockIdx.x; u < NS * NG; u += gridDim.x) ssd_sample_unit(a, lds, tid, lane, wave, u >> 1, u & 1);
    }
    SUBSTAMP(18);
    const int gw = blockIdx.x * NWAVES + wave, NGW = gridDim.x * NWAVES;
    LAS unsigned char* ldsw = lds + wave * 16896;
    if (a.flags & 2) {
    for (int u = gw; u < NP * 16 * G5; u += NGW) s5_unit<0>(a, ldsw, lane, u);
    for (int u = gw; u < (MS / 32) * G5; u += NGW) s5_unit<2>(a, ldsw, lane, u);
    }
    __syncthreads(); SUBSTAMP(19);
    const bf16* PROJ = (const bf16*)(ws + WS_PROJ);
    for (int e = blockIdx.x * NTHR + tid; e < NSEQ * 3 * CONVD; e += gridDim.x * NTHR) {
        const int s = e / (3 * CONVD), i = (e / CONVD) % 3, ch = e % CONVD;
        const int row = s < NP ? s * LP + LP - 3 + i : MP + (s - NP) * LS + 1 + i;
        a.out[OUT_CONVP + e] = bf2f(PROJ[(size_t)row * NPROJ + O1 + ch]); }
    __syncthreads();
}
__device__ __forceinline__ void phase_chunkscan(const Args& a, int tid) {
    unsigned char* ws = a.ws; bf16* CS = (bf16*)(ws + WS_CS); const float* ACS = (const float*)(ws + WS_ACS);
    if (!(a.flags & 1)) return;
    for (int e = blockIdx.x * NTHR + tid; e < NP * H * PD * NST / 4; e += gridDim.x * NTHR) {
        const int b = e >> 14, h = (e >> 11) & 7, pn = e & 2047;
        u32x2 v[16]; float dec[16];
#pragma unroll
        for (int c = 0; c < 16; ++c) { v[c] = *(const u32x2*)(CS + ((size_t)((b * 16 + c) * H + h)) * 8192 + 4 * pn); dec[c] = expf(ACS[((size_t)(b * 16 + c) * H + h) * 256 + 127]); }
        f32x4 run = (f32x4){0.f, 0.f, 0.f, 0.f};
#pragma unroll
        for (int c = 0; c < 16; ++c) { u32x2 w; w.x = pk2(run[0], run[1]); w.y = pk2(run[2], run[3]); *(u32x2*)((bf16*)(ws + WS_INIT) + ((size_t)((b * 16 + c) * H + h)) * 8192 + 4 * pn) = w;
            run = run * dec[c] + (f32x4){bflo(v[c].x), bfhi(v[c].x), bflo(v[c].y), bfhi(v[c].y)}; }
        *(f32x4*)(a.out + OUT_SSDP + ((size_t)(b * H + h)) * 8192 + 4 * pn) = run;
    }
}
__device__ __forceinline__ void ssd_pass2_unit(const Args& a, LAS unsigned char* lds, int tid, int lane, int wave, int b, int c, int g) {
    unsigned char* ws = a.ws; const bf16* PROJ = (const bf16*)(ws + WS_PROJ); const bf16* XC = (const bf16*)(ws + WS_XC);
    const int r0 = b * LP + c * 128, fr = lane & 15, fq = lane >> 4;
    LAS bf16* Cn = (LAS bf16*)lds;
    LAS bf16* Gs = Cn + 128 * PT;
    LAS bf16* Xt = Gs + 128 * PT;
    LAS bf16* Ib = Xt + 64 * PT;
    LAS float* sAcs = (LAS float*)(Ib + 64 * PT);
    LAS float* sDt = sAcs + 512;
    const bf16* Gg = (const bf16*)(ws + WS_G) + (size_t)((b * 16 + c) * NG + g) * 128 * 128;
    for (int e = tid; e < 128 * 16; e += NTHR) { const int l = e >> 4, k8 = (e & 15) * 8;
        *(LAS v4u*)(Cn + l * PT + k8) = *(const v4u*)(XC + (size_t)(r0 + l) * CONVD + DSSD + NG * NST + NST * g + k8);
        *(LAS v4u*)(Gs + l * PT + k8) = *(const v4u*)(Gg + (size_t)l * 128 + k8); }
    for (int e = tid; e < 1024; e += NTHR) { const int hh = e >> 8, i = e & 255; sAcs[(i >> 7) * 512 + hh * 128 + (i & 127)] = ((const float*)(ws + WS_ACS))[((size_t)(b * 16 + c) * H + 4 * g + hh) * 256 + i]; }
    SUBSTAMP(46);
    float ssq = 0.f;
    const int l = 16 * wave + fr, row = r0 + l;
    bf16* mixrow = (bf16*)(ws + WS_MIX) + (size_t)row * D + 256 * g;
    LAS unsigned* keep = (LAS unsigned*)(lds + 108544) + tid * 8;
    u32x2 k2[4], k3[4];
#pragma unroll
    for (int pt = 0; pt < 4; ++pt) { k2[pt].x = 0u; k2[pt].y = 0u; k3[pt].x = 0u; k3[pt].y = 0u; }
#pragma unroll 1
    for (int hh = 0; hh < 4; ++hh) {
        __syncthreads(); if (hh == 0) SUBSTAMP(48); if (hh == 1) SUBSTAMP(50);
        {   const int pp = tid & 31, sb = tid >> 5, chl = 64 * hh + 2 * pp; unsigned pr[8];
#pragma unroll
            for (int i = 0; i < 8; ++i) pr[i] = *(const unsigned*)(XC + (size_t)(r0 + 8 * sb + i) * CONVD + 256 * g + chl);
            const f32x4 da = *(const LAS f32x4*)(sDt + hh * 128 + 8 * sb), db = *(const LAS f32x4*)(sDt + hh * 128 + 8 * sb + 4);
            v4u t0, t1; t0.x = pk2(bflo(pr[0]) * da[0], bflo(pr[1]) * da[1]); t0.y = pk2(bflo(pr[2]) * da[2], bflo(pr[3]) * da[3]); t0.z = pk2(bflo(pr[4]) * db[0], bflo(pr[5]) * db[1]); t0.w = pk2(bflo(pr[6]) * db[2], bflo(pr[7]) * db[3]);
            t1.x = pk2(bfhi(pr[0]) * da[0], bfhi(pr[1]) * da[1]); t1.y = pk2(bfhi(pr[2]) * da[2], bfhi(pr[3]) * da[3]); t1.z = pk2(bfhi(pr[4]) * db[0], bfhi(pr[5]) * db[1]); t1.w = pk2(bfhi(pr[6]) * db[2], bfhi(pr[7]) * db[3]);
            *(LAS v4u*)(Xt + (2 * pp) * PT + 8 * sb) = t0; *(LAS v4u*)(Xt + (2 * pp + 1) * PT + 8 * sb) = t1;
            const bf16* CSp = (const bf16*)(ws + WS_INIT) + ((size_t)((b * 16 + c) * H + 4 * g + hh)) * PD * NST;
#pragma unroll
            for (int i = 0; i < 2; ++i) { const int e = tid + NTHR * i, p = e >> 4, n8 = (e & 15) * 8; *(LAS v4u*)(Ib + p * PT + n8) = *(const v4u*)(CSp + (size_t)p * NST + n8); }
        }
        __syncthreads(); if (hh == 0) SUBSTAMP(49);
        f32x4 ad[4], ao[4];
#pragma unroll
        for (int pt = 0; pt < 4; ++pt) { ad[pt] = (f32x4){0.f, 0.f, 0.f, 0.f}; ao[pt] = (f32x4){0.f, 0.f, 0.f, 0.f}; }
        const float acl = sAcs[hh * 128 + l];
        for (int kk = 0; kk <= (wave >> 1); ++kk) {
            const bf16x8 gf = ldfrag(Gs, l, 32 * kk + 8 * fq);
            const f32x4 a0 = *(const LAS f32x4*)(sAcs + hh * 128 + 32 * kk + 8 * fq), a1 = *(const LAS f32x4*)(sAcs + hh * 128 + 32 * kk + 8 * fq + 4);
            v4u pw; float pv[8];
#pragma unroll
            for (int j = 0; j < 8; ++j) { const int s = 32 * kk + 8 * fq + j; const float as = j < 4 ? a0[j & 3] : a1[j & 3];
                pv[j] = s <= l ? bf2f((bf16)gf[j]) * __expf(acl - as) : 0.f; }
#pragma unroll
            for (int j = 0; j < 4; ++j) pw[j] = pk2(pv[2 * j], pv[2 * j + 1]);
            bf16x8 pf = __builtin_bit_cast(bf16x8, pw);
            asm volatile("s_nop 7" : "+v"(pf));
#pragma unroll
            for (int pt = 0; pt < 4; ++pt) ad[pt] = mfma16(ldfrag(Xt, 16 * pt + fr, 32 * kk + 8 * fq), pf, ad[pt]);
        }
#pragma unroll
        for (int kk = 0; kk < 4; ++kk) { const bf16x8 cf = ldfrag(Cn, l, 32 * kk + 8 * fq);
#pragma unroll
            for (int pt = 0; pt < 4; ++pt) ao[pt] = mfma16(ldfrag(Ib, 16 * pt + fr, 32 * kk + 8 * fq), cf, ao[pt]); }
        MFMA_SETTLE(ad[3]); MFMA_SETTLE(ao[3]);
        const float el = __expf(acl), Dh = a.in[I_SSDD][4 * g + hh];
#pragma unroll
        for (int pt = 0; pt < 4; ++pt) { const int chl = 64 * hh + 16 * pt + 4 * fq;
            const u32x2 xx = *(const u32x2*)(XC + (size_t)row * CONVD + 256 * g + chl), zz = *(const u32x2*)(PROJ + (size_t)row * NPROJ + 256 * g + chl);
            const float xv[4] = {bflo(xx.x), bfhi(xx.x), bflo(xx.y), bfhi(xx.y)}, zv[4] = {bflo(zz.x), bfhi(zz.x), bflo(zz.y), bfhi(zz.y)};
            float v[4];
#pragma unroll
            for (int r = 0; r < 4; ++r) { const float y = ad[pt][r] + el * ao[pt][r] + Dh * xv[r]; v[r] = y * fsilu(zv[r]); ssq += v[r] * v[r]; }
            u32x2 w; w.x = pk2(v[0], v[1]); w.y = pk2(v[2], v[3]);
            if (hh < 2) *(LAS u32x2*)(keep + hh * 4096 + 2 * pt) = w;
            k2[pt].x = hh == 2 ? w.x : k2[pt].x; k2[pt].y = hh == 2 ? w.y : k2[pt].y; k3[pt].x = hh == 3 ? w.x : k3[pt].x; k3[pt].y = hh == 3 ? w.y : k3[pt].y; }
    }
    SUBSTAMP(47);
    ssq += __shfl_xor(ssq, 16); ssq += __shfl_xor(ssq, 32);
    const float scale = rsqrtf(ssq * (1.f / 256.f) + EPS);
#pragma unroll
    for (int hh = 0; hh < 4; ++hh)
#pragma unroll
        for (int pt = 0; pt < 4; ++pt) { const int chl = 64 * hh + 16 * pt + 4 * fq; const f32x4 ng = *(const f32x4*)(a.in[I_SSDNG] + 256 * g + chl);
            const u32x2 vv = hh < 2 ? *(const LAS u32x2*)(keep + hh * 4096 + 2 * pt) : (hh == 2 ? k2[pt] : k3[pt]);
            u32x2 w; w.x = pk2(bflo(vv.x) * scale * ng[0], bfhi(vv.x) * scale * ng[1]); w.y = pk2(bflo(vv.y) * scale * ng[2], bfhi(vv.y) * scale * ng[3]);
            *(u32x2*)(mixrow + chl) = w; }
    __syncthreads();
}
__device__ __forceinline__ void ssd_rescale(const Args& a, int tid, int first_wg) {
    unsigned char* ws = a.ws; bf16* MIXp = (bf16*)(ws + WS_MIX); const float* SCL = (const float*)(ws + WS_SCL);
    const int nwg = (int)gridDim.x - first_wg; if ((int)blockIdx.x < first_wg || nwg <= 0) return;
    for (int i = ((int)blockIdx.x - first_wg) * NTHR + tid; i < MP * 64; i += nwg * NTHR) { const int row = i >> 6, c8 = (i & 63) * 8; const float s = SCL[(size_t)row * 2 + (c8 >> 8)];
        v4u x = *(const v4u*)(MIXp + (size_t)row * D + c8);
        x.x = pk2(bflo(x.x) * s, bfhi(x.x) * s); x.y = pk2(bflo(x.y) * s, bfhi(x.y) * s); x.z = pk2(bflo(x.z) * s, bfhi(x.z) * s); x.w = pk2(bflo(x.w) * s, bfhi(x.w) * s);
        *(v4u*)(MIXp + (size_t)row * D + c8) = x; }
}
__device__ __forceinline__ void phase_mix2(const Args& a, LAS unsigned char* lds, int tid, int lane, int wave) {
    SUBSTAMP(22);
    if (a.flags & 1) for (int u = blockIdx.x; u < NP * 16 * NG; u += gridDim.x) ssd_pass2_unit(a, lds, tid, lane, wave, u >> 5, (u >> 1) & 15, u & 1);
    SUBSTAMP(23);
    const int gw = blockIdx.x * NWAVES + wave, NGW = gridDim.x * NWAVES;
    LAS unsigned char* ldsw = lds + wave * 16896;
    if (a.flags & 2) for (int u = gw; u < NP * 16 * G5; u += NGW) s5_unit<1>(a, ldsw, lane, u);
    __syncthreads(); SUBSTAMP(24);
}


template <bool NORM, class F, class NF> __device__ __forceinline__ void tail_gemm(LAS unsigned char* lds, const bf16* A, const bf16* Bt, int N, int K, int tid, int lane, int wave, const F& f, unsigned* cntT, unsigned* slotT, const NF& nf) {
    const int fr = lane & 15, fq = lane >> 4, ntn = N / 64, ntiles = (MS / 32) * ntn, kw = K / 8;
    LAS float* part = (LAS float*)lds;
    __syncthreads();
    for (int t = blockIdx.x; t < ntiles; t += gridDim.x) {
        const int m0 = MP + 32 * (t / ntn), n0 = 64 * (t % ntn);
        const bf16* ap = A + (size_t)(m0 + fr) * K + wave * kw + 8 * fq; const bf16* bp = Bt + (size_t)(n0 + fr) * K + wave * kw + 8 * fq;
        f32x4 acc[2][4];
#pragma unroll
        for (int i = 0; i < 2; ++i)
#pragma unroll
            for (int j = 0; j < 4; ++j) acc[i][j] = (f32x4){0.f, 0.f, 0.f, 0.f};
#pragma unroll 4
        for (int k = 0; k < kw; k += 32) {
            bf16x8 af[2], bf[4];
#pragma unroll
            for (int i = 0; i < 2; ++i) af[i] = *(const bf16x8*)(ap + (size_t)(16 * i) * K + k);
#pragma unroll
            for (int j = 0; j < 4; ++j) bf[j] = *(const bf16x8*)(bp + (size_t)(16 * j) * K + k);
#pragma unroll
            for (int i = 0; i < 2; ++i)
#pragma unroll
                for (int j = 0; j < 4; ++j) acc[i][j] = mfma16(bf[j], af[i], acc[i][j]);
        }
#pragma unroll
        for (int i = 0; i < 2; ++i)
#pragma unroll
            for (int j = 0; j < 4; ++j) { if (i == 0 && j == 0) MFMA_SETTLE(acc[1][3]); *(LAS f32x4*)(part + (wave * 32 + 16 * i + fr) * 68 + 16 * j + 4 * fq) = acc[i][j]; }
        __syncthreads();
        {   const int row = tid >> 4, c4 = (tid & 15) * 4; f32x4 v = (f32x4){0.f, 0.f, 0.f, 0.f};
#pragma unroll
            for (int w = 0; w < 8; ++w) v += *(const LAS f32x4*)(part + (w * 32 + row) * 68 + c4);
            const f32x4 x1 = f(m0 + row, n0 + c4, v);
            if (NORM) {
                const int rb = t / ntn, cb = t % ntn;
                float q = (x1[0] * x1[0] + x1[1] * x1[1]) + (x1[2] * x1[2] + x1[3] * x1[3]);
                q += __shfl_xor(q, 1); q += __shfl_xor(q, 2); q += __shfl_xor(q, 4); q += __shfl_xor(q, 8);
                if ((tid & 15) == 0) __hip_atomic_store(slotT + ((size_t)(rb * 32 + row) * 16 + cb), __float_as_uint(q), __ATOMIC_RELAXED, __HIP_MEMORY_SCOPE_AGENT);
                asm volatile("s_waitcnt vmcnt(0)" ::: "memory");
                __syncthreads();
                if (tid == 0) { __hip_atomic_fetch_add(cntT + 64 * rb, 1u, __ATOMIC_RELAXED, __HIP_MEMORY_SCOPE_AGENT); unsigned sp = 0;
                    while (__hip_atomic_load(cntT + 64 * rb, __ATOMIC_RELAXED, __HIP_MEMORY_SCOPE_AGENT) < (unsigned)ntn) { __builtin_amdgcn_s_sleep(2); if (++sp > (1u << 22)) break; }
                    __builtin_amdgcn_fence(__ATOMIC_ACQUIRE, "agent"); asm volatile("s_waitcnt vmcnt(0)" ::: "memory"); }
                __syncthreads();
                float tq = __uint_as_float(__hip_atomic_load(slotT + ((size_t)(rb * 32 + row) * 16 + (tid & 15)), __ATOMIC_RELAXED, __HIP_MEMORY_SCOPE_AGENT));
                tq += __shfl_xor(tq, 1); tq += __shfl_xor(tq, 2); tq += __shfl_xor(tq, 4); tq += __shfl_xor(tq, 8);
                nf(m0 + row, n0 + c4, x1, 1.0f / sqrtf(tq * (1.0f / (float)N) + EPS));
            } }
        __syncthreads();
    }
}
__device__ __forceinline__ float xbcf(const bf16* proj, const float* sconv, int s, int i, int ch) {
    if (i < 3) return s < NP ? 0.f : sconv[((size_t)(s - NP) * 3 + i) * CONVD + ch];
    const int row = s < NP ? s * LP + (i - 3) : MP + (s - NP) * LS + (i - 3);
    return bf2f(proj[(size_t)row * NPROJ + O1 + ch]);
}
__global__ void nv_convnew(const bf16* proj, const float* sconv, float* out) {
    const int s = blockIdx.x, L = s < NP ? LP : LS;
    float* o = s < NP ? out + OUT_CONVP + (size_t)s * 3 * CONVD : out + OUT_CONVS + (size_t)(s - NP) * 3 * CONVD;
    for (int e = threadIdx.x; e < 3 * CONVD; e += blockDim.x) o[e] = xbcf(proj, sconv, s, L + e / CONVD, e % CONVD);
}
__global__ void __launch_bounds__(512) nv_ssd(const bf16* proj, const float* dtraw, const float* sconv, const float* sssd, const float* convw, const float* convb, const float* dtb, const float* Alog,
                                              const float* Dsk, float* yssd, float* out) {
    const int s = blockIdx.x / H, h = blockIdx.x % H, g = h / (H / NG), tid = threadIdx.x, p = tid / 8, nq = tid % 8;
    const int L = s < NP ? LP : LS, row0 = s < NP ? s * LP : MP + (s - NP) * LS;
    __shared__ float sx[PD], sB[NST], sC[NST];
    float st[16];
    for (int j = 0; j < 16; ++j) st[j] = s < NP ? 0.f : sssd[(((size_t)(s - NP) * H + h) * PD + p) * NST + nq * 16 + j];
    const float A = -expf(Alog[h]), Dh = Dsk[h], bias = dtb[h];
    for (int t = 0; t < L; ++t) {
        if (tid < PD + 2 * NST) {
            const int ch = tid < PD ? h * PD + tid : (tid < PD + NST ? DSSD + g * NST + (tid - PD) : DSSD + NG * NST + g * NST + (tid - PD - NST));
            float c = convb[ch];
            for (int k = 0; k < 4; ++k) c += xbcf(proj, sconv, s, t + k, ch) * convw[k * CONVD + ch];
            c = siluf(c);
            if (tid < PD) sx[tid] = c; else if (tid < PD + NST) sB[tid - PD] = c; else sC[tid - PD - NST] = c;
        }
        __syncthreads();
        const float dt = softplusf(dtraw[(size_t)(row0 + t) * 8 + h] + bias), dA = expf(dt * A), xv = sx[p], dx = dt * xv;
        float y = 0.f;
        for (int j = 0; j < 16; ++j) { st[j] = st[j] * dA + dx * sB[nq * 16 + j]; y += sC[nq * 16 + j] * st[j]; }
        y += __shfl_xor(y, 1); y += __shfl_xor(y, 2); y += __shfl_xor(y, 4);
        if (nq == 0) yssd[(size_t)(row0 + t) * DSSD + h * PD + p] = y + Dh * xv;
        __syncthreads();
    }
    float* o = s < NP ? out + OUT_SSDP + (((size_t)s * H + h) * PD + p) * NST : out + OUT_SSDS + (((size_t)(s - NP) * H + h) * PD + p) * NST;
    for (int j = 0; j < 16; ++j) o[nq * 16 + j] = st[j];
}
__global__ void nv_ssdnorm(const float* yssd, const bf16* proj, const float* ng, bf16* mix) {
    const int row = blockIdx.x, t = threadIdx.x;
    __shared__ float red[2][256];
    float v[2];
    for (int gi = 0; gi < 2; ++gi) { const int c = gi * 256 + t; v[gi] = yssd[(size_t)row * DSSD + c] * siluf(bf2f(proj[(size_t)row * NPROJ + c])); red[gi][t] = v[gi] * v[gi]; }
    __syncthreads();
    for (int o = 128; o > 0; o >>= 1) { if (t < o) { red[0][t] += red[0][t + o]; red[1][t] += red[1][t + o]; } __syncthreads(); }
    for (int gi = 0; gi < 2; ++gi) { const int c = gi * 256 + t; mix[(size_t)row * D + c] = (bf16)f2bf(v[gi] * rsqrtf(red[gi][0] / 256.f + EPS) * ng[c]); }
}
__global__ void nv_s5(const bf16* proj, const float* s0re, const float* s0im, const float* Are, const float* Aim, const float* lstep, const float* Bre, const float* Bim,
                      const float* Cre, const float* Cim, const float* Dsk, bf16* gy, float* out) {
    const int s = blockIdx.x / G5, g = blockIdx.x % G5, p = threadIdx.x;
    const int L = s < NP ? LP : LS, row0 = s < NP ? s * LP : MP + (s - NP) * LS;
    const float lr = Are[g * P5 + p], li = Aim[g * P5 + p], step = expf(lstep[g]);
    const float mag = expf(lr * step), abr = mag * cosf(li * step), abi = mag * sinf(li * step);
    const float nr = abr - 1.f, ni = abi, den = lr * lr + li * li, fr = (nr * lr + ni * li) / den, fi = (ni * lr - nr * li) / den;
    float bbr[CH5], bbi[CH5], cr[CH5], ci[CH5];
    for (int c = 0; c < CH5; ++c) { const float br = Bre[((size_t)g * P5 + p) * CH5 + c], bi = Bim[((size_t)g * P5 + p) * CH5 + c];
        bbr[c] = fr * br - fi * bi; bbi[c] = fr * bi + fi * br; cr[c] = Cre[((size_t)g * CH5 + c) * P5 + p]; ci[c] = Cim[((size_t)g * CH5 + c) * P5 + p]; }
    float hr = s < NP ? 0.f : s0re[((size_t)(s - NP) * G5 + g) * P5 + p], hi = s < NP ? 0.f : s0im[((size_t)(s - NP) * G5 + g) * P5 + p];
    for (int t = 0; t < L; ++t) {
        const bf16* u = proj + (size_t)(row0 + t) * NPROJ + 1536 + g * CH5;
        float br = 0.f, bi = 0.f, uv[CH5];
        for (int c = 0; c < CH5; ++c) { uv[c] = bf2f(u[c]); br += bbr[c] * uv[c]; bi += bbi[c] * uv[c]; }
        const float nhr = abr * hr - abi * hi + br, nhi = abr * hi + abi * hr + bi; hr = nhr; hi = nhi;
        float mine = 0.f;
        for (int c = 0; c < CH5; ++c) { float v = cr[c] * hr - ci[c] * hi;
            for (int o = 1; o < 64; o <<= 1) v += __shfl_xor(v, o);
            if (p == c) mine = v + Dsk[g * CH5 + c] * uv[c]; }
        if (p < CH5) gy[(size_t)(row0 + t) * DS5 + g * CH5 + p] = (bf16)f2bf(0.5f * mine * (1.f + erff(mine * 0.70710678118654752f)));
    }
    float* ore = s < NP ? out + OUT_REP + ((size_t)s * G5 + g) * P5 : out + OUT_RES + ((size_t)(s - NP) * G5 + g) * P5;
    float* oim = s < NP ? out + OUT_IMP + ((size_t)s * G5 + g) * P5 : out + OUT_IMS + ((size_t)(s - NP) * G5 + g) * P5;
    ore[p] = hr; oim[p] = hi;
}
__global__ void nv_ada(const float* cp, const float* cs, const float* w, const float* b, float* mod, int N, int off) {
    const int j = blockIdx.x * 256 + threadIdx.x, s = blockIdx.y;
    const float* c = s < NP ? cp + (size_t)s * D : cs + (size_t)(s - NP) * D;
    float acc = 0.f;
    for (int k = 0; k < D; ++k) acc += siluf(c[k]) * w[(size_t)k * N + j];
    mod[(size_t)s * NMOD + off + j] = acc + b[j];
}

constexpr int NPHASE = 12;
__global__ void __launch_bounds__(NTHR, 2) fwd_mega(Args a) {
    extern __shared__ __attribute__((aligned(16))) unsigned char lds_raw[];
    LAS unsigned char* lds = (LAS unsigned char*)lds_raw;
    const int tid = threadIdx.x, lane = tid & 63, wave = __builtin_amdgcn_readfirstlane(tid >> 6);
    unsigned char* ws = a.ws;
    const int lo = a.ph_lo, hi = a.ph_hi, G = gridDim.x;
    volatile LAS unsigned* MISC = (volatile LAS unsigned*)(lds + LDS_BYTES - 64);
    if (tid < 16) MISC[tid] = 0u;
    __syncthreads();
    const XcdBarrier bar = xcd_barrier_post((unsigned*)(ws + WS_CTL), MISC);
#define IN(k) (lo <= (k) && (k) < hi)
#if PROBE_PH >= 0
    volatile LAS unsigned long long* stamps = (volatile LAS unsigned long long*)(lds + (LDS_BYTES - 512));
    const bool stamper = blockIdx.x == 0 && tid == 0;
    if (stamper) stamps[0] = __builtin_amdgcn_s_memrealtime();
#define SEAM(k) do { if (IN(k) && IN((k) + 1)) xcd_barrier(bar); if (stamper) stamps[(k) + 1] = __builtin_amdgcn_s_memrealtime(); } while (0)
#else
#if USE_CG_SYNC
#define SEAM(k) do { if (IN(k) && IN((k) + 1)) cg::this_grid().sync(); } while (0)
#else
#define SEAM(k) do { if (IN(k) && IN((k) + 1)) xcd_barrier(bar); } while (0)
#endif
#endif
#define REPF(k) ((a.flags >> (4 + (k))) & 1)

#define P0_BODY phase_prep(a, lds, tid, lane, wave);
#define P1_BODY phase_modnorm<0>(a, lds, tid, lane, wave);
#define P2_TAIL { bf16* PR = (bf16*)(ws + WS_PROJ); tail_gemm<false>(lds, (const bf16*)(ws + WS_U), (const bf16*)(ws + WS_WIN), NPROJ, D, tid, lane, wave, [=](int row, int col, f32x4 v) { \
                      u32x2 w; w.x = pk2(v[0], v[1]); w.y = pk2(v[2], v[3]); *(u32x2*)(PR + (size_t)row * NPROJ + col) = w; return v; }, (unsigned*)nullptr, (unsigned*)nullptr, [](int, int, f32x4, float) {}); }
#define P2_MAIN { pg8::Gemm g{(const bf16*)(ws + WS_U), (const bf16*)(ws + WS_WIN), MP, NPROJ, D}; pg8::StaticOrder S; S.init(MP, NPROJ, G, (int)blockIdx.x); \
                  pg8::EpiBf16 E{(bf16*)(ws + WS_PROJ), NPROJ}; pg8::gemm_phase<pg8::EpiBf16, pg8::StaticOrder, true, true>(lds, g, S, E); }
#if TAIL_FIRST_P2
#define P2_BODY { P2_TAIL P2_MAIN }
#else
#define P2_BODY { P2_MAIN P2_TAIL }
#endif
#define P3_BODY phase_mix1(a, lds, tid, lane, wave);
#define P5_BODY phase_mix2(a, lds, tid, lane, wave);
#define P6_BODY { pg8::Gemm g{(const bf16*)(ws + WS_GY), (const bf16*)(ws + WS_WGLU), M, DS5, DS5}; pg8::StaticOrder S; S.init(M, DS5, G, (int)blockIdx.x); \
                  pg8::EpiGlu E{(const bf16*)(ws + WS_GY), (bf16*)(ws + WS_MIX), a.in[I_BGLU]}; pg8::gemm_phase<pg8::EpiGlu, pg8::StaticOrder, true, true>(lds, g, S, E); }
#define P7_TAIL { const float* xs = a.in[I_XS]; bf16* X1 = (bf16*)(ws + WS_X1B); const float* md = (const float*)(ws + WS_MOD); const float* gm = a.in[I_N2G]; bf16* V = (bf16*)(ws + WS_U); \
                    tail_gemm<true>(lds, (const bf16*)(ws + WS_MIX), (const bf16*)(ws + WS_WOUT), D, D, tid, lane, wave, [=](int row, int col, f32x4 v) { \
                      const f32x4 r = *(const f32x4*)(xs + (size_t)(row - MP) * D + col), g = *(const f32x4*)(md + (size_t)(NP + (row - MP) / LS) * NMOD + 2048 + col); const f32x4 x1 = r + g * v; u32x2 xw; xw.x = pk2(x1[0], x1[1]); xw.y = pk2(x1[2], x1[3]); *(u32x2*)(X1 + (size_t)row * D + col) = xw; return x1; }, \
                      (unsigned*)(ws + WS_CTL) + CW_T7, (unsigned*)(ws + WS_XT7), [=](int row, int col, f32x4 x1, float rs) { const float* ms = md + (size_t)(NP + (row - MP) / LS) * NMOD; \
                      const f32x4 o = x1 * rs * (*(const f32x4*)(gm + col)) * (*(const f32x4*)(ms + 4096 + col) + 1.f) + *(const f32x4*)(ms + 3072 + col); u32x2 w; w.x = pk2(o[0], o[1]); w.y = pk2(o[2], o[3]); *(u32x2*)(V + (size_t)row * D + col) = w; }); }
#define P7_MAIN { pg8::Gemm g{(const bf16*)(ws + WS_MIX), (const bf16*)(ws + WS_WOUT), MP, D, D}; pg8::StaticOrder S; S.init(MP, D, G, (int)blockIdx.x); \
                  pg8::EpiResNorm<0> E{a.in[I_XP], (const float*)(ws + WS_MOD), 2048, 3072, 4096, a.in[I_N2G], (bf16*)(ws + WS_X1B), (bf16*)(ws + WS_U), nullptr, (unsigned*)(ws + WS_XB7), (unsigned*)(ws + WS_CTL) + CW_P7, EPS}; \
                  pg8::gemm_phase<pg8::EpiResNorm<0>, pg8::StaticOrder, false, true>(lds, g, S, E); }
#if TAIL_FIRST_P7
#define P7_BODY { P7_TAIL P7_MAIN }
#else
#define P7_BODY { P7_MAIN P7_TAIL }
#endif
#define P8_BODY phase_modnorm<1>(a, lds, tid, lane, wave);
#define P9_BODY { pg8::Gemm g{(const bf16*)(ws + WS_U), (const bf16*)(ws + WS_WUP), M, 2 * DFF, D}; pg8::StaticOrder S; S.init(M, 2 * DFF, G, (int)blockIdx.x); \
                  pg8::EpiSwiglu E{(bf16*)(ws + WS_HFF), DFF}; pg8::gemm_phase<pg8::EpiSwiglu, pg8::StaticOrder, true, true>(lds, g, S, E); }
#define P10_TAIL { const bf16* X1 = (const bf16*)(ws + WS_X1B); float* Y = a.out + OUT_Y; const float* md = (const float*)(ws + WS_MOD); const float* gm = a.in[I_NFG]; \
                    tail_gemm<true>(lds, (const bf16*)(ws + WS_HFF), (const bf16*)(ws + WS_WDOWN), D, DFF, tid, lane, wave, [=](int row, int col, f32x4 v) { \
                      const u32x2 rb = *(const u32x2*)(X1 + (size_t)row * D + col); const f32x4 r = (f32x4){bflo(rb.x), bfhi(rb.x), bflo(rb.y), bfhi(rb.y)}, g = *(const f32x4*)(md + (size_t)(NP + (row - MP) / LS) * NMOD + 5120 + col); return r + g * v; }, \
                      (unsigned*)(ws + WS_CTL) + CW_T10, (unsigned*)(ws + WS_XT10), [=](int row, int col, f32x4 x2, float rs) { const float* ms = md + (size_t)(NP + (row - MP) / LS) * NMOD; \
                      *(f32x4*)(Y + (size_t)row * D + col) = x2 * rs * (*(const f32x4*)(gm + col)) * (*(const f32x4*)(ms + 7168 + col) + 1.f) + *(const f32x4*)(ms + 6144 + col); }); }
#define P10_MAIN { pg8::Gemm g{(const bf16*)(ws + WS_HFF), (const bf16*)(ws + WS_WDOWN), MP, D, DFF}; pg8::StaticOrder S; S.init(MP, D, G, (int)blockIdx.x); \
                  pg8::EpiResNorm<1> E{(const bf16*)(ws + WS_X1B), (const float*)(ws + WS_MOD), 5120, 6144, 7168, a.in[I_NFG], nullptr, nullptr, a.out + OUT_Y, (unsigned*)(ws + WS_XB10), (unsigned*)(ws + WS_CTL) + CW_P10, EPS}; \
                  pg8::gemm_phase<pg8::EpiResNorm<1>, pg8::StaticOrder, false, true>(lds, g, S, E); }
#if TAIL_FIRST_P10
#define P10_BODY(OUTP) { P10_TAIL P10_MAIN }
#else
#define P10_BODY(OUTP) { P10_MAIN P10_TAIL }
#endif
#if PROBE_REP
#define RUNP(k, BODY) if (IN(k)) { if (REPF(k)) { BODY } BODY }
#else
#define RUNP(k, BODY) if (IN(k)) { BODY }
#endif
    RUNP(0, P0_BODY)
#if PROBE_PH >= 0
    if (stamper) { stamps[14] = stamps[0]; stamps[15] = __builtin_amdgcn_s_memrealtime(); }
#endif
    SEAM(0);
    RUNP(1, P1_BODY) SEAM(1);
    RUNP(2, P2_BODY) SEAM(2);
#if EXTRA_BAR2
    xcd_barrier(bar);
#endif
    RUNP(3, P3_BODY) SEAM(3);
    if (IN(4)) phase_chunkscan(a, tid);
    SEAM(4);
#if DELAY_AFTER4
    { const unsigned long long t0 = __builtin_amdgcn_s_memrealtime(); while (__builtin_amdgcn_s_memrealtime() - t0 < DELAY_AFTER4) __builtin_amdgcn_s_sleep(4); }
#endif
    RUNP(5, P5_BODY) SEAM(5);
    RUNP(6, P6_BODY) SEAM(6);
    RUNP(7, P7_BODY) SEAM(7);
#if PROBE_PH >= 0
    if (stamper) stamps[9] = stamps[8];
#endif
    RUNP(9, P9_BODY) SEAM(9);
    if (IN(10)) P10_BODY(a.out + OUT_Y)
#if PROBE_PH >= 0
    if (stamper) { __builtin_amdgcn_s_waitcnt(0); stamps[11] = __builtin_amdgcn_s_memrealtime(); }
#endif
#if PROBE_PH >= 0
    if (stamper) { __builtin_amdgcn_s_waitcnt(0); stamps[12] = __builtin_amdgcn_s_memrealtime();
        const unsigned long long span = stamps[PROBE_PH + 1] - stamps[PROBE_PH], until = stamps[12] + 4ull * span;
        while (__builtin_amdgcn_s_memrealtime() < until) __builtin_amdgcn_s_sleep(8); }
#endif
#undef IN
#undef SEAM
}

extern "C" void kernel_launch(void* const* d_in, const int* in_sizes, int n_in, void* d_out, int out_size, void* d_ws, size_t ws_size, hipStream_t stream) {
    static int grid = 0;
    if (grid == 0) {
        int dev = 0, cus = 0, per_cu = 0;
        (void)hipGetDevice(&dev); (void)hipDeviceGetAttribute(&cus, hipDeviceAttributeMultiprocessorCount, dev);
        (void)hipFuncSetAttribute((const void*)fwd_mega, hipFuncAttributeMaxDynamicSharedMemorySize, LDS_BYTES);
        (void)hipOccupancyMaxActiveBlocksPerMultiprocessor(&per_cu, (const void*)fwd_mega, NTHR, LDS_BYTES);
        grid = cus * (per_cu < 1 ? 1 : 1);
        if (n_in != 36 || ws_size < WS_END || out_size != (int)OUT_END) fprintf(stderr, "kernel_launch: unexpected sizes n_in %d ws %zu out %d\n", n_in, ws_size, out_size);
    }
    Args a{};
    for (int i = 0; i < 36; ++i) a.in[i] = (const float*)d_in[i];
    a.out = (float*)d_out; a.ws = (unsigned char*)d_ws;
    const float* const* in = a.in; unsigned char* ws = a.ws; float* out = a.out;
    (void)hipMemsetAsync((char*)d_ws + WS_CTL, 0, 65536, stream);
    a.flags = 3 | (PROBE_REP << 4);
#if DIAG_NAIVE
    { auto run = [&](int lo, int hi) { Args b = a; b.ph_lo = lo; b.ph_hi = hi; void* ka[] = {&b}; (void)hipLaunchCooperativeKernel((const void*)fwd_mega, dim3(grid), dim3(NTHR), ka, LDS_BYTES, stream); };
      run(0, 6);
#if DIAG_NAIVE == 1
      nv_s5<<<NSEQ * G5, 64, 0, stream>>>((const bf16*)(ws + WS_PROJ), in[I_SRE], in[I_SIM], in[I_ARE], in[I_AIM], in[I_LSTEP], in[I_BRE], in[I_BIM], in[I_CRE], in[I_CIM], in[I_S5D], (bf16*)(ws + WS_GY), out);
#else
      { float* yssd = (float*)(ws + WS_XC);
        nv_ssd<<<NSEQ * H, 512, 0, stream>>>((const bf16*)(ws + WS_PROJ), (const float*)(ws + WS_DT), in[I_SCONV], in[I_SSSD], in[I_CONVW], in[I_CONVB], in[I_DTB], in[I_ALOG], in[I_SSDD], yssd, out);
        nv_ssdnorm<<<M, 256, 0, stream>>>(yssd, (const bf16*)(ws + WS_PROJ), in[I_SSDNG], (bf16*)(ws + WS_MIX)); }
#endif
      (void)hipMemsetAsync((char*)d_ws + WS_CTL, 0, 16384, stream);
      run(6, NPHASE); }
#else
    a.ph_lo = 0; a.ph_hi = NPHASE;
    void* kargs[] = {&a};
    const hipError_t e = hipLaunchCooperativeKernel((const void*)fwd_mega, dim3(grid), dim3(NTHR), kargs, LDS_BYTES, stream);
    if (e != hipSuccess) fprintf(stderr, "kernel_launch: cooperative launch failed: %s (grid %d)\n", hipGetErrorString(e), grid);
#endif
    (void)in; (void)ws; (void)out;
}
```
